# Optimizing an MI355X kernel written in HIP

```python
import jax, jax.numpy as jnp
from jax import lax
import numpy as np

D_MODEL = 1024
BATCH = 8
SEQ = 2048
DEPTH = 1

HG_HEADS = 4
HG_HD = 128
HG_WIDTH = HG_HEADS * HG_HD
HG_CHUNK = 64
NSA_HEADS = 8
NSA_KV_HEADS = 2
NSA_HD = 64
NSA_GROUP = NSA_HEADS // NSA_KV_HEADS
NSA_WIDTH = NSA_HEADS * NSA_HD
NSA_KV_WIDTH = NSA_KV_HEADS * NSA_HD
N_BRANCH = 3
CMP_BLOCK = 32
CMP_STRIDE = 16
CMP_HIDDEN = 256
SLC_BLOCK = 64
SLC_TOPK = 16
SLC_Q_CHUNK = 64
WIN = 512
WIN_Q_BLOCK = 128
MIX_WIDTH = HG_WIDTH + NSA_WIDTH
ROPE_DIM = NSA_HD // 4
ROPE_THETA = 500000.0
D_FF = 2816
CONV_W = 3
EPS = 1e-6
NEG = -1e30
IN_SIZES = [HG_WIDTH] * 4 + [NSA_WIDTH] + [NSA_KV_WIDTH] * 6 + [N_BRANCH * NSA_HEADS]
IN_COLS = sum(IN_SIZES)

kernel_name = "hymba_hgrn2_nsa_convffn_adaln"


def rmsnorm(x, g):
    xf = x.astype(jnp.float32)
    y = xf * lax.rsqrt(jnp.mean(xf * xf, axis=-1, keepdims=True) + EPS)
    return (y * g.astype(jnp.float32)).astype(x.dtype)


def rope_partial(x, pos):
    half = ROPE_DIM // 2
    inv = ROPE_THETA ** (-jnp.arange(half, dtype=jnp.float32) * 2.0 / ROPE_DIM)
    ang = pos.astype(jnp.float32)[:, None, :, None] * inv
    cos, sin = jnp.cos(ang), jnp.sin(ang)
    xf = x.astype(jnp.float32)
    x1, x2, rest = xf[..., :half], xf[..., half:ROPE_DIM], xf[..., ROPE_DIM:]
    out = jnp.concatenate([x1 * cos - x2 * sin, x2 * cos + x1 * sin, rest], axis=-1)
    return out.astype(x.dtype)


def to_heads(z, n, hd):
    B, T, _ = z.shape
    return z.reshape(B, T, n, hd).transpose(0, 2, 1, 3)


def hgrn2(q_pre, f_pre, i_pre, g_pre, lb, norm_g):
    B, T, _ = q_pre.shape
    f32 = jnp.float32
    nc = T // HG_CHUNK
    zf = f_pre.astype(f32)
    lbf = lb.astype(f32)
    logf = jnp.logaddexp(jnp.log(lbf), jnp.log1p(-lbf) + jax.nn.log_sigmoid(zf))
    k = (1.0 - lbf) * jax.nn.sigmoid(-zf)
    q = jax.nn.silu(q_pre.astype(f32))
    v = i_pre.astype(f32)

    def chunked(z):
        return z.reshape(B, nc, HG_CHUNK, HG_HEADS, HG_HD).transpose(1, 0, 3, 2, 4)

    qc, kc, vc = chunked(q), chunked(k), chunked(v)
    bc = jnp.cumsum(chunked(logf), axis=-2)
    causal = jnp.tril(jnp.ones((HG_CHUNK, HG_CHUNK), dtype=bool))

    def step(S, inp):
        qi, ki, vi, bi = inp
        o_inter = jnp.einsum('bhtk,bhkv->bhtv', qi * jnp.exp(bi), S)
        diff = bi[:, :, :, None, :] - bi[:, :, None, :, :]
        dec = jnp.where(causal[:, :, None], jnp.exp(jnp.minimum(diff, 0.0)), 0.0)
        A = jnp.einsum('bhtsk,bhsk->bhts', dec * qi[:, :, :, None, :], ki)
        o = o_inter + jnp.einsum('bhts,bhsv->bhtv', A, vi)
        bl = bi[:, :, -1:, :]
        S = jnp.exp(bl[:, :, 0, :])[..., None] * S + jnp.einsum('bhsk,bhsv->bhkv', ki * jnp.exp(bl - bi), vi)
        return S, o

    S0 = jnp.zeros((B, HG_HEADS, HG_HD, HG_HD), f32)
    _, o = lax.scan(step, S0, (qc, kc, vc, bc))
    o = o.transpose(1, 0, 3, 2, 4).reshape(B, T, HG_HEADS, HG_HD)
    g = jax.nn.silu(g_pre.astype(f32)).reshape(B, T, HG_HEADS, HG_HD)
    o = rmsnorm(o, norm_g) * g
    return o.reshape(B, T, HG_WIDTH).astype(q_pre.dtype)


def compress(blocks, pe, w1, w2):
    B, G, n, L, hd = blocks.shape
    flat = (blocks + pe).reshape(B, G, n, L * hd)
    return jax.nn.silu(flat @ w1) @ w2


def nsa(q_pre, kc_pre, vc_pre, ks_pre, vs_pre, kw_pre, vw_pre, g_pre, pos, q_g, k_g, pe, w1, w2):
    B, T, _ = q_pre.shape
    f32 = jnp.float32
    G, R, hd = NSA_KV_HEADS, NSA_GROUP, NSA_HD
    scale = NSA_HD ** -0.5
    tpos = jnp.arange(T)

    q = rope_partial(rmsnorm(to_heads(q_pre, NSA_HEADS, hd), q_g), pos).reshape(B, G, R, T, hd)
    k_c = rope_partial(rmsnorm(to_heads(kc_pre, G, hd), k_g[0]), pos)
    k_s = rope_partial(rmsnorm(to_heads(ks_pre, G, hd), k_g[1]), pos)
    k_w = rope_partial(rmsnorm(to_heads(kw_pre, G, hd), k_g[2]), pos)
    v_c, v_s, v_w = to_heads(vc_pre, G, hd), to_heads(vs_pre, G, hd), to_heads(vw_pre, G, hd)

    n_cmp = (T - CMP_BLOCK) // CMP_STRIDE + 1
    cidx = np.arange(n_cmp)[:, None] * CMP_STRIDE + np.arange(CMP_BLOCK)[None]
    k_cmp = compress(k_c[:, :, cidx], pe[0], w1[0], w2[0])
    v_cmp = compress(v_c[:, :, cidx], pe[1], w1[1], w2[1])
    s = jnp.einsum('bgrtd,bgnd->bgrtn', q, k_cmp).astype(f32) * scale
    cvalid = jnp.asarray(cidx[:, -1])[None, :] <= tpos[:, None]
    any_valid = jnp.any(cvalid, axis=-1, keepdims=True)
    p_cmp = jax.nn.softmax(jnp.where(cvalid, s, NEG), axis=-1) * any_valid
    o_cmp = jnp.einsum('bgrtn,bgnd->bgrtd', p_cmp.astype(v_cmp.dtype), v_cmp)

    nb = T // SLC_BLOCK
    n_sel = min(SLC_TOPK, nb)
    cst = np.arange(n_cmp) * CMP_STRIDE
    sst = np.arange(nb) * SLC_BLOCK
    ovl = np.clip(np.minimum(cst[:, None] + CMP_BLOCK, sst[None] + SLC_BLOCK)
                  - np.maximum(cst[:, None], sst[None]), 0, None) / CMP_BLOCK
    M = jnp.asarray(ovl, dtype=f32)
    imp = jnp.einsum('bgtn,nj->bgtj', p_cmp.sum(axis=2), M)
    cur = tpos // SLC_BLOCK
    j = jnp.arange(nb)
    forced = (j[None] == 0) | (j[None] == cur[:, None]) | (j[None] == cur[:, None] - 1)
    blk_causal = j[None] <= cur[:, None]
    imp = jnp.where(blk_causal, jnp.where(forced, jnp.inf, imp), -1.0)
    _, sel = lax.top_k(imp, n_sel)

    kb = k_s.reshape(B, G, nb, SLC_BLOCK, hd)
    vb = v_s.reshape(B, G, nb, SLC_BLOCK, hd)
    nq = T // SLC_Q_CHUNK
    q_ch = q.reshape(B, G, R, nq, SLC_Q_CHUNK, hd).transpose(3, 0, 1, 2, 4, 5)
    sel_ch = sel.reshape(B, G, nq, SLC_Q_CHUNK, n_sel).transpose(2, 0, 1, 3, 4)
    t_ch = tpos.reshape(nq, SLC_Q_CHUNK)
    gather = jax.vmap(jax.vmap(lambda blocks, ix: blocks[ix]))
    offs = jnp.arange(SLC_BLOCK)

    def sel_chunk(args):
        qc, ic, tc = args
        kg = gather(kb, ic)
        vg = gather(vb, ic)
        sc = jnp.einsum('bgrqd,bgqnld->bgrqnl', qc, kg).astype(f32) * scale
        kpos = ic[..., None] * SLC_BLOCK + offs
        m = kpos <= tc[None, None, :, None, None]
        sc = jnp.where(m[:, :, None], sc, NEG)
        shp = sc.shape
        p = jax.nn.softmax(sc.reshape(shp[:-2] + (shp[-2] * shp[-1],)), axis=-1).reshape(shp)
        return jnp.einsum('bgrqnl,bgqnld->bgrqd', p.astype(vg.dtype), vg)

    o_slc = lax.map(sel_chunk, (q_ch, sel_ch, t_ch))
    o_slc = o_slc.transpose(1, 2, 3, 0, 4, 5).reshape(B, G, R, T, hd)

    nwb = T // WIN_Q_BLOCK
    span = WIN + WIN_Q_BLOCK
    widx = np.arange(nwb)[:, None] * WIN_Q_BLOCK + np.arange(span)[None]
    padw = ((0, 0), (0, 0), (WIN, 0), (0, 0))
    kwin = jnp.pad(k_w, padw)[:, :, widx]
    vwin = jnp.pad(v_w, padw)[:, :, widx]
    qw = q.reshape(B, G, R, nwb, WIN_Q_BLOCK, hd)
    sw = jnp.einsum('bgrnqd,bgnkd->bgrnqk', qw, kwin).astype(f32) * scale
    kpos = jnp.asarray(widx - WIN)[:, None, :]
    qpos = (jnp.arange(nwb)[:, None] * WIN_Q_BLOCK + jnp.arange(WIN_Q_BLOCK)[None])[:, :, None]
    mw = (kpos <= qpos) & (qpos - kpos < WIN) & (kpos >= 0)
    pw = jax.nn.softmax(jnp.where(mw, sw, NEG), axis=-1)
    o_win = jnp.einsum('bgrnqk,bgnkd->bgrnqd', pw.astype(vwin.dtype), vwin).reshape(B, G, R, T, hd)

    gates = jax.nn.sigmoid(g_pre.astype(f32)).reshape(B, T, NSA_HEADS, N_BRANCH)
    gates = gates.transpose(0, 2, 1, 3).reshape(B, G, R, T, N_BRANCH)
    o = (gates[..., 0:1] * o_cmp.astype(f32) + gates[..., 1:2] * o_slc.astype(f32)
         + gates[..., 2:3] * o_win.astype(f32))
    o = o.reshape(B, NSA_HEADS, T, hd).transpose(0, 2, 1, 3).reshape(B, T, NSA_WIDTH)
    return o.astype(q_pre.dtype)


def causal_dwconv(u, w, b):
    T = u.shape[1]
    up = jnp.pad(u, ((0, 0), (CONV_W - 1, 0), (0, 0)))
    y = b
    for j in range(CONV_W):
        y = y + up[:, j:j + T] * w[j]
    return y


def setup_inputs(seed: int = 0) -> dict:
    key = jax.random.key(seed)
    ks = jax.random.split(key, 24)
    f32 = jnp.float32

    def nrm(k, shape, s):
        return jax.random.normal(k, shape, f32) * s

    return {
        "x": nrm(ks[0], (BATCH, SEQ, D_MODEL), 1.0),
        "c": nrm(ks[1], (BATCH, D_MODEL), 1.0),
        "positions": (jnp.arange(SEQ, dtype=jnp.int32)[None]
                      + jax.random.randint(ks[2], (BATCH, 1), 0, 4096, dtype=jnp.int32)),
        "w_ada": nrm(ks[3], (DEPTH, D_MODEL, 6 * D_MODEL), D_MODEL ** -0.5),
        "b_ada": nrm(ks[4], (DEPTH, 6 * D_MODEL), 0.02),
        "norm1_g": 1.0 + nrm(ks[5], (DEPTH, D_MODEL), 0.02),
        "w_in": nrm(ks[6], (DEPTH, D_MODEL, IN_COLS), D_MODEL ** -0.5),
        "lb_logits": nrm(ks[7], (DEPTH + 1, HG_WIDTH), 1.0),
        "hg_norm_g": 1.0 + nrm(ks[8], (DEPTH, HG_HD), 0.02),
        "q_norm_g": 1.0 + nrm(ks[9], (DEPTH, NSA_HD), 0.02),
        "k_norm_g": 1.0 + nrm(ks[10], (DEPTH, N_BRANCH, NSA_HD), 0.02),
        "pe_cmp": nrm(ks[11], (DEPTH, 2, CMP_BLOCK, NSA_HD), 0.02),
        "w_cmp1": nrm(ks[12], (DEPTH, 2, CMP_BLOCK * NSA_HD, CMP_HIDDEN), (CMP_BLOCK * NSA_HD) ** -0.5),
        "w_cmp2": nrm(ks[13], (DEPTH, 2, CMP_HIDDEN, NSA_HD), CMP_HIDDEN ** -0.5),
        "w_out": nrm(ks[14], (DEPTH, MIX_WIDTH, D_MODEL), MIX_WIDTH ** -0.5),
        "norm2_g": 1.0 + nrm(ks[15], (DEPTH, D_MODEL), 0.02),
        "w_up": nrm(ks[16], (DEPTH, D_MODEL, 2 * D_FF), D_MODEL ** -0.5),
        "conv_w": nrm(ks[17], (DEPTH, CONV_W, 2 * D_FF), CONV_W ** -0.5),
        "conv_b": nrm(ks[18], (DEPTH, 2 * D_FF), 0.02),
        "w_down": nrm(ks[19], (DEPTH, D_FF, D_MODEL), D_FF ** -0.5),
    }


def reference(x, c, positions, w_ada, b_ada, norm1_g, w_in, lb_logits, hg_norm_g, q_norm_g,
              k_norm_g, pe_cmp, w_cmp1, w_cmp2, w_out, norm2_g, w_up, conv_w, conv_b, w_down):
    offsets = np.cumsum(IN_SIZES)[:-1].tolist()
    lbs = jnp.cumsum(jax.nn.softmax(lb_logits.astype(jnp.float32), axis=0), axis=0)
    cs = jax.nn.silu(c)
    for l in range(DEPTH):
        mod = cs @ w_ada[l] + b_ada[l]
        sh1, sc1, gt1, sh2, sc2, gt2 = [m[:, None, :] for m in jnp.split(mod, 6, axis=-1)]

        h = rmsnorm(x, norm1_g[l]) * (1.0 + sc1) + sh1
        z = h @ w_in[l]
        (hq, hf, hi, hgt, nq_, kc_, vc_, ks_, vs_, kw_, vw_, ng_) = jnp.split(z, offsets, axis=-1)
        o_hg = hgrn2(hq, hf, hi, hgt, lbs[l], hg_norm_g[l])
        o_nsa = nsa(nq_, kc_, vc_, ks_, vs_, kw_, vw_, ng_, positions, q_norm_g[l], k_norm_g[l],
                    pe_cmp[l], w_cmp1[l], w_cmp2[l])
        mix = jnp.concatenate([o_hg, o_nsa], axis=-1) @ w_out[l]
        x = x + gt1 * mix

        h2 = rmsnorm(x, norm2_g[l]) * (1.0 + sc2) + sh2
        u = causal_dwconv(h2 @ w_up[l], conv_w[l], conv_b[l])
        a, v = jnp.split(u, 2, axis=-1)
        x = x + gt2 * ((jax.nn.silu(a) * v) @ w_down[l])
    return x
```

```cpp
#include <hip/hip_runtime.h>
#include <hip/hip_cooperative_groups.h>
#include <cstdio>
#include <cstdint>
namespace cg = cooperative_groups;

__device__ __forceinline__ int opaque_lane() { unsigned ones = ~0u; asm volatile("" : "+s"(ones)); return (int)__builtin_amdgcn_mbcnt_hi(ones, __builtin_amdgcn_mbcnt_lo(ones, 0u)); }
namespace pg8 {
#define PG8_LAS __attribute__((address_space(3)))
typedef unsigned short bf16_t;
typedef short bf16x8 __attribute__((ext_vector_type(8)));
typedef float f32x4 __attribute__((ext_vector_type(4)));
typedef unsigned u32x4 __attribute__((ext_vector_type(4)));
constexpr int BM = 256, BK = 64, HALF = 128, HTB = HALF * BK * 2, STAGE_BYTES = 8 * HTB, NXCD = 8, WGM = 8;

__host__ __device__ __forceinline__ int lds_byte(int r, int c) { const int st = (r >> 4) * 2 + (c >> 5), rr = r & 15, cc = c & 31, ob = rr * 64 + cc * 2; return st * 1024 + (ob ^ (((ob >> 9) & 1) << 5)); }
__host__ __device__ __forceinline__ void stage_rc(int b, int& R, int& C) { const int st = b / 1024, sb = b % 1024, swz = sb ^ (((sb >> 9) & 1) << 5); R = (st >> 1) * 16 + swz / 64; C = (st & 1) * 32 + (swz % 64) / 2; }
__host__ __device__ __forceinline__ int perm32(int rho) { const int n = rho >> 4, i = rho & 15; return 8 * (i >> 2) + 4 * n + (i & 3); }

struct Unit { int pm, pn, z, pad; size_t aoff, boff; };
struct Gemm { const bf16_t* A; const bf16_t* Bt; int K, lda, ldb, pad; };

struct StaticOrder {
    int nM, nN, nwg, G, c; size_t tsA, tsB;
    __device__ void init(int nM_, int nN_, int G_, int c_, size_t tsA_, size_t tsB_) { nM = nM_; nN = nN_; nwg = nM * nN; G = G_; c = c_; tsA = tsA_; tsB = tsB_; }
    __device__ bool next(int i, Unit& u) const {
        const long L = (long)i * G + c; if (L >= nwg) return false;
        int wgid = (int)L; { const int q = nwg / NXCD, r = nwg % NXCD, xcd = wgid % NXCD, off = wgid / NXCD; wgid = (xcd < r ? xcd * (q + 1) : r * (q + 1) + (xcd - r) * q) + off; }
        const int nig = WGM * nN, gid = wgid / nig, fm = gid * WGM, gsz = (nM - fm) < WGM ? (nM - fm) : WGM;
        u.pm = fm + ((wgid % nig) % gsz); u.pn = (wgid % nig) / gsz; u.z = 0; u.pad = 0; u.aoff = (size_t)u.pm * tsA; u.boff = (size_t)u.pn * tsB; return true;
    }
    __device__ __forceinline__ void a_ready(const Unit&) const {}
    __device__ __forceinline__ void done(const Unit&) const {}
};
struct CmpOrder {
    int G, c; size_t vdelta;
    __device__ bool next(int i, Unit& u) const {
        const long L = (long)i * G + c; if (L >= 128) return false;
        const int mlp = (int)L / 64, rem = (int)L % 64, pm = rem / 8, ks = rem % 8;
        u.pm = pm; u.pn = 0; u.z = mlp * 8 + ks; u.pad = 0;
        u.aoff = (mlp ? vdelta : 0) + (size_t)pm * 256 * 1024 * 2 + (size_t)ks * 512;
        u.boff = (size_t)mlp * 256 * 2048 * 2 + (size_t)ks * 512; return true;
    }
    __device__ __forceinline__ void a_ready(const Unit&) const {}
    __device__ __forceinline__ void done(const Unit&) const {}
};

__device__ __forceinline__ unsigned cvt_pk_bf16(float lo, float hi) { unsigned r; asm volatile("v_cvt_pk_bf16_f32 %0, %1, %2" : "=v"(r) : "v"(lo), "v"(hi)); return r; }

struct EpiBf16 {
    static constexpr bool PERM = true, AFTER_DRAIN = false;
    bf16_t* O; int ldc; bf16_t* halo;
    __device__ __forceinline__ void operator()(const f32x4 (&acc)[2][2][4][2], const Unit& u, int wr, int wc, int fr, int fq) const {
        const int row0 = u.pm * BM + wr * 64 + fr; const int col0 = u.pn * BM + wc * 32 + 8 * fq;
#pragma unroll
        for (int ai = 0; ai < 2; ++ai)
#pragma unroll
            for (int m = 0; m < 4; ++m) { const int row = row0 + ai * HALF + m * 16; bf16_t* rowp = O + (size_t)row * ldc + col0;
#pragma unroll
                for (int bj = 0; bj < 2; ++bj) { const f32x4 v0 = acc[ai][bj][m][0], v1 = acc[ai][bj][m][1];
                    u32x4 w; w.x = cvt_pk_bf16(v0[0], v0[1]); w.y = cvt_pk_bf16(v0[2], v0[3]); w.z = cvt_pk_bf16(v1[0], v1[1]); w.w = cvt_pk_bf16(v1[2], v1[3]);
                    *(u32x4*)(rowp + bj * HALF) = w;
                    if (halo != nullptr && m == 3 && fr >= 14) *(u32x4*)(halo + ((size_t)(row >> 6) * 2 + (fr - 14)) * ldc + col0 + bj * HALF) = w; } }
    }
};
struct EpiRes {
    static constexpr bool PERM = false, AFTER_DRAIN = false;
    const float* base; float* out; const float* gate;
    __device__ __forceinline__ void operator()(const f32x4 (&acc)[2][2][4][2], const Unit& u, int wr, int wc, int fr, int fq) const {
        const int row0 = u.pm * BM + wr * 64 + fr, col0 = u.pn * BM + wc * 32 + 4 * fq; const int b = (u.pm * BM) / 2048;
        f32x4 gv[2][2];
#pragma unroll
        for (int bj = 0; bj < 2; ++bj)
#pragma unroll
            for (int n = 0; n < 2; ++n) gv[bj][n] = *(const f32x4*)(gate + (size_t)b * 6144 + col0 + bj * HALF + n * 16);
#pragma unroll
        for (int ai = 0; ai < 2; ++ai)
#pragma unroll
            for (int m = 0; m < 4; ++m) { const size_t ro = (size_t)(row0 + ai * HALF + m * 16) * 1024 + col0;
#pragma unroll
                for (int bj = 0; bj < 2; ++bj)
#pragma unroll
                    for (int n = 0; n < 2; ++n) { const f32x4 xv = *(const f32x4*)(base + ro + bj * HALF + n * 16); *(f32x4*)(out + ro + bj * HALF + n * 16) = xv + gv[bj][n] * acc[ai][bj][m][n]; } }
    }
};
struct EpiPart {
    static constexpr bool PERM = false, AFTER_DRAIN = false;
    float* P;
    __device__ __forceinline__ void operator()(const f32x4 (&acc)[2][2][4][2], const Unit& u, int wr, int wc, int fr, int fq) const {
        const int row0 = u.pm * BM + wr * 64 + fr, col0 = wc * 32 + 4 * fq;
#pragma unroll
        for (int ai = 0; ai < 2; ++ai)
#pragma unroll
            for (int m = 0; m < 4; ++m) { float* rowp = P + ((size_t)u.z * 2048 + row0 + ai * HALF + m * 16) * 256 + col0;
#pragma unroll
                for (int bj = 0; bj < 2; ++bj)
#pragma unroll
                    for (int n = 0; n < 2; ++n) *(f32x4*)(rowp + bj * HALF + n * 16) = acc[ai][bj][m][n]; }
    }
};


__device__ __forceinline__ float dpp_ror1(float x) { return __builtin_bit_cast(float, __builtin_amdgcn_update_dpp(0, __builtin_bit_cast(int, x), 0x121, 0xf, 0xf, false)); }
__device__ __forceinline__ float dpp_ror2(float x) { return __builtin_bit_cast(float, __builtin_amdgcn_update_dpp(0, __builtin_bit_cast(int, x), 0x122, 0xf, 0xf, false)); }
__device__ __forceinline__ float dpp_shr1(float old, float x) { return __builtin_bit_cast(float, __builtin_amdgcn_update_dpp(__builtin_bit_cast(int, old), __builtin_bit_cast(int, x), 0x111, 0xf, 0xf, false)); }
__device__ __forceinline__ float dpp_shr2(float old, float x) { return __builtin_bit_cast(float, __builtin_amdgcn_update_dpp(__builtin_bit_cast(int, old), __builtin_bit_cast(int, x), 0x112, 0xf, 0xf, false)); }
struct EpiConv {
    static constexpr bool PERM = true, AFTER_DRAIN = false;
    bf16_t* ACT; bf16_t* head; bf16_t* tail; const float* cw; const float* cb; PG8_LAS float* xb;
    __device__ __forceinline__ void operator()(const f32x4 (&acc)[2][2][4][2], const Unit& u, int wr, int wc, int fr, int fq) const {
        typedef __attribute__((address_space(1))) bf16_t gbf; typedef __attribute__((address_space(1))) unsigned gu32_;
        const int colh = wc * 32 + 8 * fq, FFc = 2816, FF2c = 5632;
        if (fr >= 14) {
#pragma unroll
            for (int ai = 0; ai < 2; ++ai)
#pragma unroll
                for (int bj = 0; bj < 2; ++bj)
#pragma unroll
                    for (int n = 0; n < 2; ++n) *(PG8_LAS f32x4*)(xb + ((ai * 2 + wr) * 2 + (fr - 14)) * 256 + bj * 128 + colh + 4 * n) = acc[ai][bj][3][n];
            if (wr == 1) {
#pragma unroll
                for (int bj = 0; bj < 2; ++bj)
#pragma unroll
                    for (int n = 0; n < 2; ++n) { const f32x4 v = acc[1][bj][3][n]; gu32_* p = (gu32_*)((gbf*)tail + ((size_t)u.pm * 2 + (fr - 14)) * FF2c + bj * FFc + u.pn * 128 + colh + 4 * n);
                        p[0] = cvt_pk_bf16(v[0], v[1]); p[1] = cvt_pk_bf16(v[2], v[3]); }
            }
        }
        if (fr < 2 && wr == 0) {
#pragma unroll
            for (int bj = 0; bj < 2; ++bj)
#pragma unroll
                for (int n = 0; n < 2; ++n) { const f32x4 v = acc[0][bj][0][n]; gu32_* p = (gu32_*)((gbf*)head + ((size_t)u.pm * 2 + fr) * FF2c + bj * FFc + u.pn * 128 + colh + 4 * n);
                    p[0] = cvt_pk_bf16(v[0], v[1]); p[1] = cvt_pk_bf16(v[2], v[3]); }
        }
        asm volatile("s_waitcnt lgkmcnt(0)" ::: "memory"); __builtin_amdgcn_s_barrier(); asm volatile("" ::: "memory");
#pragma unroll
        for (int n = 0; n < 2; ++n) {
            const int ca = u.pn * 128 + colh + 4 * n;
            typedef __attribute__((address_space(1))) f32x4 gf4;
            const f32x4 wa0 = *(const gf4*)(cw + ca), wa1 = *(const gf4*)(cw + FF2c + ca), wa2 = *(const gf4*)(cw + 2 * FF2c + ca), ba = *(const gf4*)(cb + ca);
            const f32x4 wv0 = *(const gf4*)(cw + FFc + ca), wv1 = *(const gf4*)(cw + FF2c + FFc + ca), wv2 = *(const gf4*)(cw + 2 * FF2c + FFc + ca), bv = *(const gf4*)(cb + FFc + ca);
#pragma unroll
            for (int ai = 0; ai < 2; ++ai) {
                const int sai = (ai == 0) ? 0 : (wr == 0 ? 0 : 1), swr = (ai == 0) ? 0 : (wr == 0 ? 1 : 0);
                const bool has = !(ai == 0 && wr == 0);
                f32x4 pa = {0.f, 0.f, 0.f, 0.f}, pv = {0.f, 0.f, 0.f, 0.f};
                if (fr >= 14 && has) { pa = *(const PG8_LAS f32x4*)(xb + ((sai * 2 + swr) * 2 + (fr - 14)) * 256 + colh + 4 * n); pv = *(const PG8_LAS f32x4*)(xb + ((sai * 2 + swr) * 2 + (fr - 14)) * 256 + 128 + colh + 4 * n); }
#pragma unroll
                for (int m = 0; m < 4; ++m) {
                    const f32x4 xa = acc[ai][0][m][n], xv = acc[ai][1][m][n];
                    float res[4];
#pragma unroll
                    for (int c = 0; c < 4; ++c) {
                        const float a1 = dpp_shr1(dpp_ror1(pa[c]), xa[c]), a2 = dpp_shr2(dpp_ror2(pa[c]), xa[c]);
                        const float v1 = dpp_shr1(dpp_ror1(pv[c]), xv[c]), v2 = dpp_shr2(dpp_ror2(pv[c]), xv[c]);
                        const float ya = ba[c] + wa0[c] * a2 + wa1[c] * a1 + wa2[c] * xa[c];
                        const float yv = bv[c] + wv0[c] * v2 + wv1[c] * v1 + wv2[c] * xv[c];
                        res[c] = ya * __builtin_amdgcn_rcpf(1.f + __builtin_amdgcn_exp2f(-1.4426950408889634f * ya)) * yv;
                    }
                    gu32_* p = (gu32_*)((gbf*)ACT + (size_t)(u.pm * BM + ai * HALF + wr * 64 + m * 16 + fr) * FFc + ca);
                    p[0] = cvt_pk_bf16(res[0], res[1]); p[1] = cvt_pk_bf16(res[2], res[3]);
                    pa = xa; pv = xv;
                }
            }
        }
    }
};

template <class Epi, class Sched, bool ALIGN_EPI>
__device__ __forceinline__ void gemm_phase(PG8_LAS unsigned char* lds, const Gemm g, const Sched& S, const Epi& E, int wave_id) {
    const int wid = wave_id, lane = opaque_lane(), tid = wid * 64 + lane, wr = wid >> 2, wc = wid & 3, fr = lane & 15, fq = lane >> 4;
    const int K = g.K, nt = K / BK;
    unsigned voffA[2], voffB[2];
#pragma unroll
    for (int i = 0; i < 2; ++i) { int R, C; stage_rc(tid * 16 + i * 8192, R, C); const int Rb = Epi::PERM ? ((R & ~31) + perm32(R & 31)) : R;
        voffA[i] = (unsigned)(R * g.lda + C) * 2u; voffB[i] = (unsigned)(Rb * g.ldb + C) * 2u; }
    const size_t kstep = (size_t)(BK * 2);
    const size_t hsA = (size_t)HALF * g.lda * 2, hsB = (size_t)HALF * g.ldb * 2;
    const unsigned ldsw = (unsigned)wid * 1024u;
    const int aoff = lds_byte(wr * 64 + fr, fq * 8), boff = lds_byte(wc * 32 + fr, fq * 8);
#define PG8_SA(b, h) (((b) * 2 + (h)) * HTB)
#define PG8_SB(b, h) ((4 + (b) * 2 + (h)) * HTB)
#define PG8_STAGE(bufoff, gbase, voff) do { _Pragma("unroll") for (int _i = 0; _i < 2; ++_i) \
        __builtin_amdgcn_global_load_lds((const unsigned*)((const char*)(gbase) + (voff)[_i]), (PG8_LAS unsigned*)(lds + (bufoff) + ldsw + _i * 8192), 16, 0, 0); } while (0)
#define PG8_LDA(dst, b, h) do { _Pragma("unroll") for (int m = 0; m < 4; ++m) _Pragma("unroll") for (int k = 0; k < 2; ++k) dst[m][k] = *(const PG8_LAS bf16x8*)(lds + PG8_SA(b, h) + aoff + m * 2048 + k * 1024); } while (0)
#define PG8_LDB(dst, b, h) do { _Pragma("unroll") for (int n = 0; n < 2; ++n) _Pragma("unroll") for (int k = 0; k < 2; ++k) dst[n][k] = *(const PG8_LAS bf16x8*)(lds + PG8_SB(b, h) + boff + n * 2048 + k * 1024); } while (0)
#define PG8_MMA(ai, bj, At, Bt) do { __builtin_amdgcn_s_setprio(1); _Pragma("unroll") for (int m = 0; m < 4; ++m) _Pragma("unroll") for (int n = 0; n < 2; ++n) _Pragma("unroll") for (int k = 0; k < 2; ++k) \
        acc[ai][bj][m][n] = __builtin_amdgcn_mfma_f32_16x16x32_bf16(Bt[n][k], At[m][k], acc[ai][bj][m][n], 0, 0, 0); __builtin_amdgcn_s_setprio(0); } while (0)
#define PG8_WAIT_V(n) asm volatile("s_waitcnt vmcnt(" #n ")" ::: "memory")
#define PG8_WAIT_L(n) asm volatile("s_waitcnt lgkmcnt(" #n ")" ::: "memory")
#define PG8_BAR __builtin_amdgcn_s_barrier()
#define PG8_SCHED __builtin_amdgcn_sched_barrier(0)
    Unit cur, nxt; int ui = 0;
    if (!S.next(0, cur)) return;
    f32x4 acc[2][2][4][2];
#pragma unroll
    for (int a = 0; a < 2; ++a)
#pragma unroll
        for (int b = 0; b < 2; ++b)
#pragma unroll
            for (int m = 0; m < 4; ++m)
#pragma unroll
                for (int n = 0; n < 2; ++n) acc[a][b][m][n] = (f32x4){0.f, 0.f, 0.f, 0.f};
    bf16x8 At[4][2], B0[2][2], B1[2][2];
    const char* cA = (const char*)g.A + cur.aoff; const char* cB = (const char*)g.Bt + cur.boff;
    S.a_ready(cur);
    PG8_STAGE(PG8_SB(0, 0), cB, voffB); PG8_STAGE(PG8_SB(0, 1), cB + hsB, voffB); PG8_STAGE(PG8_SA(0, 0), cA, voffA); PG8_STAGE(PG8_SA(0, 1), cA + hsA, voffA);
    if (wr == 1) PG8_BAR;
    PG8_WAIT_V(2); PG8_BAR;
    PG8_STAGE(PG8_SB(1, 0), cB + kstep, voffB); PG8_STAGE(PG8_SA(1, 0), cA + kstep, voffA); PG8_STAGE(PG8_SB(1, 1), cB + hsB + kstep, voffB);
    PG8_WAIT_V(6); PG8_BAR;
    for (;;) {
        const bool has_next = S.next(ui + 1, nxt);
        const char* nA = has_next ? (const char*)g.A + nxt.aoff : cA; const char* nB = has_next ? (const char*)g.Bt + nxt.boff : cB;
        for (int t = 0; t < nt; t += 2) {
            const bool last = (t == nt - 2);
            const char* a1 = cA + (size_t)(t + 1) * kstep;
            const char* a2 = last ? nA : cA + (size_t)(t + 2) * kstep; const char* b2 = last ? nB : cB + (size_t)(t + 2) * kstep;
            const char* a3 = a2 + kstep; const char* b3 = b2 + kstep;
            if (last && has_next) S.a_ready(nxt);
            PG8_LDB(B0, 0, 0); PG8_LDB(B1, 0, 1); PG8_SCHED; PG8_LDA(At, 0, 0); PG8_STAGE(PG8_SA(1, 1), a1 + hsA, voffA);
            PG8_WAIT_V(8); PG8_WAIT_L(0); PG8_BAR; PG8_MMA(0, 0, At, B0); PG8_MMA(0, 1, At, B1); PG8_BAR; PG8_SCHED;
            PG8_LDA(At, 0, 1); PG8_STAGE(PG8_SB(0, 0), b2, voffB); PG8_STAGE(PG8_SB(0, 1), b2 + hsB, voffB); PG8_STAGE(PG8_SA(0, 0), a2, voffA);
            PG8_WAIT_V(8); PG8_WAIT_L(0); PG8_BAR; PG8_MMA(1, 0, At, B0); PG8_MMA(1, 1, At, B1); PG8_BAR; PG8_SCHED;
            PG8_LDB(B0, 1, 0); PG8_LDB(B1, 1, 1); PG8_SCHED; PG8_LDA(At, 1, 0); PG8_STAGE(PG8_SA(0, 1), a2 + hsA, voffA);
            PG8_WAIT_V(8); PG8_WAIT_L(0); PG8_BAR; PG8_MMA(0, 0, At, B0); PG8_MMA(0, 1, At, B1); PG8_BAR; PG8_SCHED;
            PG8_LDA(At, 1, 1); PG8_STAGE(PG8_SB(1, 0), b3, voffB); PG8_STAGE(PG8_SB(1, 1), b3 + hsB, voffB); PG8_STAGE(PG8_SA(1, 0), a3, voffA);
            PG8_WAIT_V(8); PG8_WAIT_L(0); PG8_BAR; PG8_MMA(1, 0, At, B0); PG8_MMA(1, 1, At, B1); PG8_BAR; PG8_SCHED;
        }
        if constexpr (ALIGN_EPI) { if (wr == 0) PG8_BAR; }
        E(acc, cur, wr, wc, fr, fq); S.done(cur);
        if (!has_next) break;
#pragma unroll
        for (int a = 0; a < 2; ++a)
#pragma unroll
            for (int b = 0; b < 2; ++b)
#pragma unroll
                for (int m = 0; m < 4; ++m)
#pragma unroll
                    for (int n = 0; n < 2; ++n) acc[a][b][m][n] = (f32x4){0.f, 0.f, 0.f, 0.f};
        cur = nxt; cA = nA; cB = nB; ++ui;
        if constexpr (ALIGN_EPI) { if (wr == 1) PG8_BAR; }
    }
    PG8_WAIT_V(0);
    if constexpr (!ALIGN_EPI) { if (wr == 0) PG8_BAR; }
    PG8_BAR;
#undef PG8_SA
#undef PG8_SB
#undef PG8_STAGE
#undef PG8_LDA
#undef PG8_LDB
#undef PG8_MMA
#undef PG8_WAIT_V
#undef PG8_WAIT_L
#undef PG8_BAR
#undef PG8_SCHED
}
}

#define LAS __attribute__((address_space(3)))
#define GASQ __attribute__((address_space(1)))
#define GP(Tp, p) ((GASQ Tp*)(p))
#define GCP(Tp, p) ((const GASQ Tp*)(p))
typedef unsigned short bf16;
typedef float f32x4 __attribute__((ext_vector_type(4)));
typedef float f32x2 __attribute__((ext_vector_type(2)));
typedef unsigned v4u __attribute__((ext_vector_type(4)));
typedef unsigned v2u __attribute__((ext_vector_type(2)));

constexpr int NTHR = 512, NWAVES = 8;
constexpr int BSZ = 8, T = 2048, D = 1024, M = BSZ * T;
constexpr int ZLD = 3584, NZ = 3352, FF = 2816, FF2 = 5632, MODW = 6144;
constexpr int ZC_HQ = 0, ZC_HF = 512, ZC_HI = 1024, ZC_HG = 1536, ZC_NQ = 2048, ZC_KC = 2560, ZC_VC = 2688, ZC_KS = 2816, ZC_VS = 2944, ZC_KW = 3072, ZC_VW = 3200, ZC_NG = 3328;
constexpr float EPS = 1e-6f;
constexpr size_t MiB = 1u << 20;
constexpr size_t WS_WIN = 0, WS_WOUT = 7 * MiB, WS_WUP = 9 * MiB, WS_WDN = 20 * MiB, WS_WC1 = 26 * MiB;
constexpr size_t WS_MOD = 28 * MiB, WS_C1 = 28 * MiB + 256 * 1024, WS_KVCMP = 29 * MiB  , WS_HALO = 32 * MiB  ;
constexpr size_t WS_H = 40 * MiB  , WS_Z = 72 * MiB  ;
constexpr size_t WS_QN = 184 * MiB  , WS_KC = 200 * MiB, WS_VC = 205 * MiB, WS_KS = 210 * MiB, WS_VS = 215 * MiB, WS_KW = 220 * MiB, WS_VW = 225 * MiB;
constexpr size_t WS_U = 72 * MiB  , WS_END = 248 * MiB;
constexpr size_t WS_HGT = 229 * MiB  , WS_HVEC = 245 * MiB + 512 * 1024  ;
constexpr size_t WS_BAR = 39 * MiB;
constexpr int LDS_BYTES = 147456;

struct Args { const float* in[20]; float* out; unsigned char* ws; };

__device__ __forceinline__ unsigned f2bf(float f) { unsigned u = __builtin_bit_cast(unsigned, f); return (u + 0x7fffu + ((u >> 16) & 1u)) >> 16; }
__device__ __forceinline__ unsigned pk2(float lo, float hi) { return f2bf(lo) | (f2bf(hi) << 16); }
__device__ __forceinline__ float bf2f(unsigned short h) { return __builtin_bit_cast(float, (unsigned)h << 16); }
__device__ __forceinline__ float bflo(unsigned w) { return __builtin_bit_cast(float, w << 16); }
__device__ __forceinline__ float bfhi(unsigned w) { return __builtin_bit_cast(float, w & 0xffff0000u); }
#define DPPF(x, ctrl) __builtin_bit_cast(float, __builtin_amdgcn_update_dpp(0, __builtin_bit_cast(int, (x)), (ctrl), 0xf, 0xf, false))
__device__ __forceinline__ float wave_sum(float v) {
    v += DPPF(v, 0xB1); v += DPPF(v, 0x4E); v += DPPF(v, 0x141); v += DPPF(v, 0x140);
    v += __shfl_xor(v, 16);
    v += __shfl_xor(v, 32);
    return v;
}
__device__ __forceinline__ float wave_max(float v) {
    v = fmaxf(v, DPPF(v, 0xB1)); v = fmaxf(v, DPPF(v, 0x4E)); v = fmaxf(v, DPPF(v, 0x141)); v = fmaxf(v, DPPF(v, 0x140));
    v = fmaxf(v, __shfl_xor(v, 16));
    v = fmaxf(v, __shfl_xor(v, 32));
    return v;
}
__device__ __forceinline__ float xor32f(float x, int lane) { (void)lane; return __shfl_xor(x, 32); }
__device__ __forceinline__ float sigmoidf_(float x) { return __builtin_amdgcn_rcpf(1.f + __builtin_amdgcn_exp2f(-1.4426950408889634f * x)); }
__device__ __forceinline__ float siluf_(float x) { return x * __builtin_amdgcn_rcpf(1.f + __builtin_amdgcn_exp2f(-1.4426950408889634f * x)); }
#define LDS_FENCE() asm volatile("s_waitcnt lgkmcnt(0)" ::: "memory")
typedef short bf16x8 __attribute__((ext_vector_type(8)));
__device__ __forceinline__ float ex2(float x) { return __builtin_amdgcn_exp2f(x); }

struct Frame {
    LAS unsigned char* lds;
    int tid, lane, wave, G, blk;
};
constexpr int ARGTAB = 147200;
__device__ __forceinline__ const float* argp(const Frame& F, int k) {
    const LAS unsigned* tab = (const LAS unsigned*)(F.lds + ARGTAB);
    const unsigned lo = (unsigned)__builtin_amdgcn_readfirstlane((int)tab[2 * k]), hi = (unsigned)__builtin_amdgcn_readfirstlane((int)tab[2 * k + 1]);
    return (const float*)(((unsigned long long)hi << 32) | (unsigned long long)lo);
}
struct ArgsV { Frame F; struct InV { Frame F; __device__ __forceinline__ const float* operator[](int k) const { return argp(F, k); } } in; unsigned char* ws; float* out; };
__device__ __forceinline__ ArgsV args_view(const Frame& F) { ArgsV A; A.F = F; A.in.F = F; A.ws = (unsigned char*)argp(F, 21); A.out = (float*)argp(F, 20); return A; }
__device__ __forceinline__ Frame phase_frame(Frame F) { F.lane = opaque_lane(); F.tid = F.wave * 64 + F.lane; return F; }

template <bool UPMAP>
__device__ __forceinline__ void p0_transpose_item(const float* W, int K, int N, bf16* WT, LAS float* scr, int item, int nblk, int lane) {
    const int kb = item / nblk, nb = item % nblk, k0 = 64 * kb, n0 = 32 * nb;
    const int d0 = UPMAP ? ((n0 < FF) ? ((n0 >> 7) * 256 + (n0 & 127)) : ((((n0 - FF) >> 7) * 256) + 128 + ((n0 - FF) & 127))) : n0;
    const bool nok = (n0 + (lane & 31)) < N;
    float tv[32];
#pragma unroll
    for (int i = 0; i < 32; ++i) { const int kk = 2 * i + (lane >> 5); tv[i] = nok ? GCP(float, W)[(size_t)(k0 + kk) * N + n0 + (lane & 31)] : 0.f; }
#pragma unroll
    for (int i = 0; i < 32; ++i) { const int kk = 2 * i + (lane >> 5); scr[kk * 33 + (lane & 31)] = tv[i]; }
    if (false)
    for (int i = 0; i < 32; ++i) { const int kk = 2 * i + (lane >> 5); scr[kk * 33 + (lane & 31)] = nok ? GCP(float, W)[(size_t)(k0 + kk) * N + n0 + (lane & 31)] : 0.f; }
    LDS_FENCE();
    const int c = lane & 7;
#pragma unroll
    for (int j = 0; j < 4; ++j) { const int n = (lane >> 3) + 8 * j; const LAS float* s = scr + (8 * c) * 33 + n;
        v4u o; o.x = pk2(s[0 * 33], s[1 * 33]); o.y = pk2(s[2 * 33], s[3 * 33]); o.z = pk2(s[4 * 33], s[5 * 33]); o.w = pk2(s[6 * 33], s[7 * 33]);
        *GP(v4u, WT + (size_t)(d0 + n) * K + k0 + 8 * c) = o; }
    LDS_FENCE();
}

__device__ __forceinline__ void phase0(const Frame& F) {
    const ArgsV A = args_view(F); unsigned char* ws = A.ws;
    LAS float* sc = (LAS float*)F.lds;
    LAS float* red = (LAS float*)(F.lds + 32768);
    const float* c = A.in[1]; const float* w_ada = A.in[3]; const float* b_ada = A.in[4];
    float* mod = (float*)(ws + WS_MOD);
    for (int i = F.tid; i < 8192; i += NTHR) sc[i] = siluf_(c[i]);
    __syncthreads();
    for (int cb = F.blk; cb < 256; cb += F.G) {
        const int n0 = cb * 24, col = F.tid % 24, kg = F.tid / 24;
        if (F.tid < 504) {
            float acc[8];
#pragma unroll
            for (int b = 0; b < 8; ++b) acc[b] = 0.f;
#pragma unroll 7
            for (int k = kg; k < 1024; k += 21) { const float w = GCP(float, w_ada)[(size_t)k * MODW + n0 + col];
#pragma unroll
                for (int b = 0; b < 8; ++b) acc[b] += sc[b * 1024 + k] * w; }
#pragma unroll
            for (int b = 0; b < 8; ++b) red[(kg * 24 + col) * 8 + b] = acc[b];
        }
        __syncthreads();
        if (F.tid < 192) { const int cc = F.tid % 24, b = F.tid / 24; float s = b_ada[n0 + cc];
            for (int g = 0; g < 21; ++g) s += red[(g * 24 + cc) * 8 + b];
            mod[b * MODW + n0 + cc] = s; }
        __syncthreads();
    }
    __syncthreads();
}
__device__ __forceinline__ void phase0b(const Frame& F) {
    const ArgsV A = args_view(F); unsigned char* ws = A.ws;
    LAS float* scr = (LAS float*)(F.lds + F.wave * 16384);
    const int gw = F.blk * NWAVES + F.wave, NGW = F.G * NWAVES;
    constexpr int I_IN = 16 * 105, I_OUT = 16 * 32, I_UP = 16 * 176, I_DN = 44 * 32, I_C1 = 32 * 8;
    constexpr int NITEMS = I_IN + I_OUT + I_UP + I_DN + 2 * I_C1;
    for (int it = gw; it < NITEMS; it += NGW) {
        int r = it;
        if (r < I_IN) { p0_transpose_item<false>(A.in[6], 1024, NZ, (bf16*)(ws + WS_WIN), scr, r, 105, F.lane); continue; } r -= I_IN;
        if (r < I_OUT) { p0_transpose_item<false>(A.in[14], 1024, 1024, (bf16*)(ws + WS_WOUT), scr, r, 32, F.lane); continue; } r -= I_OUT;
        if (r < I_UP) { p0_transpose_item<true>(A.in[16], 1024, FF2, (bf16*)(ws + WS_WUP), scr, r, 176, F.lane); continue; } r -= I_UP;
        if (r < I_DN) { p0_transpose_item<false>(A.in[19], FF, 1024, (bf16*)(ws + WS_WDN), scr, r, 32, F.lane); continue; } r -= I_DN;
        if (r < I_C1) { p0_transpose_item<false>(A.in[12], 2048, 256, (bf16*)(ws + WS_WC1), scr, r, 8, F.lane); continue; } r -= I_C1;
        p0_transpose_item<false>(A.in[12] + (size_t)2048 * 256, 2048, 256, (bf16*)(ws + WS_WC1) + (size_t)256 * 2048, scr, r, 8, F.lane);
    }
    { v4u* z = (v4u*)((bf16*)(ws + WS_WIN) + (size_t)3360 * 1024); const int n16 = 224 * 1024 * 2 / 16;
      for (int i = F.blk * NTHR + F.tid; i < n16; i += F.G * NTHR) z[i] = (v4u){0u, 0u, 0u, 0u}; }
}

__device__ __forceinline__ void phase_c1(const Frame& F, int blk0) {
    if (F.blk < blk0) return;
    const ArgsV A = args_view(F); unsigned char* ws = A.ws;
    const GASQ float* pe = GCP(float, A.in[11]); const GASQ float* w1 = GCP(float, A.in[12]); GASQ float* c1p = GP(float, ws + WS_C1);
    for (int it = (F.blk - blk0) * NWAVES + F.wave; it < 128; it += (F.G - blk0) * NWAVES) {
        const int ks = it >> 3, i = (it >> 2) & 1, j = (it & 3) * 64 + F.lane;
        float s = 0.f;
#pragma unroll 8
        for (int k = ks * 128; k < ks * 128 + 128; ++k) s += pe[i * 2048 + k] * w1[((size_t)i * 2048 + k) * 256 + j];
        c1p[(ks * 2 + i) * 256 + j] = s;
    }
}
__device__ __forceinline__ void norm_mod_rows(const Frame& F, const float* x, const float* g, int sh_off, int sc_off, bf16* H, int m_begin, int m_end, int m_step) {
    const float* mod = (const float*)((unsigned char*)argp(F, 21) + WS_MOD);
    for (int m0 = m_begin; m0 < m_end; m0 += 2 * m_step) {
        const int m1 = m0 + m_step; const bool two = m1 < m_end; const int mm[2] = {m0, two ? m1 : m0};
        f32x4 v[2][4]; float s[2] = {0.f, 0.f};
#pragma unroll
        for (int r = 0; r < 2; ++r) { const GASQ f32x4* xr = GCP(f32x4, x + (size_t)mm[r] * D) + F.lane;
#pragma unroll
            for (int j = 0; j < 4; ++j) v[r][j] = xr[64 * j]; }
#pragma unroll
        for (int r = 0; r < 2; ++r)
#pragma unroll
            for (int j = 0; j < 4; ++j) s[r] += (v[r][j].x * v[r][j].x + v[r][j].y * v[r][j].y) + (v[r][j].z * v[r][j].z + v[r][j].w * v[r][j].w);
#pragma unroll
        for (int r = 0; r < 2; ++r) {
            if (r == 1 && !two) break;
            const int m = mm[r], b = m / T;
            const float rstd = rsqrtf(wave_sum(s[r]) * (1.f / D) + EPS);
            GASQ v2u* o8 = GP(v2u, H + (size_t)m * D) + F.lane;
#pragma unroll
            for (int j = 0; j < 4; ++j) {
                const int k = (F.lane + 64 * j) * 4;
                const f32x4 gg = *GCP(f32x4, g + k), sc = *GCP(f32x4, mod + b * MODW + sc_off + k), sh = *GCP(f32x4, mod + b * MODW + sh_off + k);
                const f32x4 y = v[r][j] * rstd * gg * (sc + 1.f) + sh;
                v2u w; w.x = pk2(y.x, y.y); w.y = pk2(y.z, y.w); o8[64 * j] = w;
            }
        }
    }
}
__device__ __forceinline__ void phase_norm_mod(const Frame& F, const float* x, const float* g, int sh_off, int sc_off, bf16* H) {
    norm_mod_rows(F, x, g, sh_off, sc_off, H, F.blk * NWAVES + F.wave, M, F.G * NWAVES);
}
__device__ __forceinline__ void phase_nsa_prep(const Frame& F) {
    const ArgsV A = args_view(F); unsigned char* ws = A.ws;
    const GASQ bf16* Z = GCP(bf16, ws + WS_Z);
    const GASQ int* pos = GCP(int, A.in[2]);
    const int gw = F.blk * NWAVES + F.wave, NGW = F.G * NWAVES, lane = F.lane;
    const float invt[8] = {1.0f, 0.1939227432012558f, 0.03760603070259094f, 0.007292664609849453f, 0.0014142135623842478f, 0.00027424818836152554f, 5.3182957344688475e-05f, 1.0313385246263351e-05f};
    float inv = 0.f;
#pragma unroll
    for (int i = 0; i < 8; ++i) inv = ((lane & 7) == i) ? invt[i] : inv;
    const float gq = GCP(float, A.in[9])[lane], gk0 = GCP(float, A.in[10])[lane], gk1 = GCP(float, A.in[10])[64 + lane], gk2 = GCP(float, A.in[10])[128 + lane];
    for (int m = gw; m < M; m += NGW) {
        const int b = m / T, t = m % T;
        const GASQ bf16* zr = Z + (size_t)m * ZLD + ZC_NQ + lane;
        unsigned short zv[20];
#pragma unroll
        for (int v = 0; v < 20; ++v) zv[v] = (v == 14 || v == 15 || v == 18 || v == 19) ? (unsigned short)0 : zr[v * 64];
        const float rev = (float)pos[m] * inv * 0.15915494309189535f;
        const float fr = rev - floorf(rev);
        const float cs = __builtin_amdgcn_cosf(fr), sn = __builtin_amdgcn_sinf(fr);
#pragma unroll
        for (int v = 0; v < 20; ++v) {
            if (v == 14 || v == 15 || v == 18 || v == 19) continue;
            GASQ bf16* dst;
            if (v < 8) dst = GP(bf16, ws + WS_QN) + ((size_t)(b * 8 + v) * T + t) * 64;
            else { const size_t off = v < 10 ? WS_KC : v < 12 ? WS_VC : v < 14 ? WS_KS : WS_KW; dst = GP(bf16, ws + off) + ((size_t)(b * 2 + (v & 1)) * T + t) * 64; }
            if (v == 10 || v == 11) { dst[lane] = zv[v]; continue; }
            const float x = bf2f(zv[v]);
            const float ss = wave_sum(x * x);
            const float gsel = v < 8 ? gq : v < 10 ? gk0 : v < 14 ? gk1 : gk2;
            float y = x * rsqrtf(ss * (1.f / 64.f) + EPS) * gsel;
            const float partner = DPPF(y, 0x128);
            if (lane < 8) y = y * cs - partner * sn; else if (lane < 16) y = y * cs + partner * sn;
            dst[lane] = (bf16)f2bf(v < 8 ? y * 0.18033688011112042f   : y);
        }
    }
    for (int it = gw; it < BSZ * 2 * 2 * 32; it += NGW) {
        const int tb = it & 31, br = (it >> 5) & 1, gi = (it >> 6) & 1, b = it >> 7;
        const GASQ bf16* zr = Z + ((size_t)b * T + tb * 64) * ZLD + (br == 0 ? ZC_VS : ZC_VW) + gi * 64 + lane;
        GASQ bf16* dst = GP(bf16, ws + (br == 0 ? WS_VS : WS_VW)) + ((size_t)(b * 2 + gi) * 64 + lane) * T + tb * 64;
        unsigned short tv[64];
#pragma unroll
        for (int tt = 0; tt < 64; ++tt) tv[tt] = zr[(size_t)tt * ZLD];
#pragma unroll
        for (int c8 = 0; c8 < 8; ++c8) {
            unsigned w[4];
#pragma unroll
            for (int e = 0; e < 4; ++e) w[e] = (unsigned)tv[c8 * 8 + 2 * e] | ((unsigned)tv[c8 * 8 + 2 * e + 1] << 16);
            *(GASQ v4u*)(dst + c8 * 8) = (v4u){w[0], w[1], w[2], w[3]};
        }
    }
}

constexpr int HG_P = 0, HG_G = 17408, HG_GT = 34816, HG_AM = 53248, HG_ST = 72704  , HG_VT = 66816, HG_TOT = 69120, HG_VEC = 71168;
#define MFMA16(a, b, c) __builtin_amdgcn_mfma_f32_16x16x32_bf16((a), (b), (c), 0, 0, 0)
__device__ __forceinline__ void phase_hg_prep(const Frame& F, float* OUTB) {
    const ArgsV A = args_view(F); const GASQ bf16* Z = GCP(bf16, A.ws + WS_Z);
    const float* lbl = A.in[7];
    GASQ bf16* Pg = GP(bf16, A.ws + WS_H); GASQ bf16* Gg = Pg + (size_t)1024 * 8192;
    GASQ bf16* GTg = GP(bf16, A.ws + WS_HGT); GASQ float* VECg = GP(float, A.ws + WS_HVEC);
    const int tid = F.tid; LAS float* TOT = (LAS float*)(F.lds + HG_TOT);
    const int k = tid & 127, rg = tid >> 7;
#pragma unroll 1
    for (int it = F.blk; it < 1024; it += F.G) {
        const int bh = it >> 5, c = it & 31, b = bh >> 2, h = bh & 3, ch = h * 128 + k;
        const float lb = 1.f / (1.f + expf(lbl[512 + ch] - lbl[ch]));
        const GASQ bf16* zb = Z + ((size_t)b * T + c * 64 + rg * 16) * ZLD + ch;
        unsigned short zf[16], zq[16];
#pragma unroll
        for (int i = 0; i < 16; ++i) { zf[i] = zb[i * ZLD + ZC_HF]; zq[i] = zb[i * ZLD + ZC_HQ]; }
        float cum[16], qv[16], kv[16]; float run = 0.f;
#pragma unroll
        for (int i = 0; i < 16; ++i) {
            const float z1 = bf2f(zf[i]), z2 = bf2f(zq[i]);
            const float sg = __builtin_amdgcn_rcpf(1.f + ex2(-1.4426950408889634f * z1));
            const float f = lb + (1.f - lb) * sg;
            run += __builtin_amdgcn_logf(f); cum[i] = run; kv[i] = 1.f - f;
            qv[i] = z2 * __builtin_amdgcn_rcpf(1.f + ex2(-1.4426950408889634f * z2));
        }
        __syncthreads();
        TOT[rg * 128 + k] = run;
        __syncthreads();
        const float t0 = TOT[k], t1 = TOT[128 + k], t2 = TOT[256 + k], t3 = TOT[384 + k];
        const float e0 = t0 + t1, Bt = e0 + (t2 + t3);
        const float off = (rg == 0) ? 0.f : (rg == 1) ? t0 : (rg == 2) ? e0 : (e0 + t2);
        unsigned gt[8];
#pragma unroll
        for (int i = 0; i < 16; ++i) {
            const float bt = off + cum[i];
            const float p = qv[i] * ex2(bt - e0), g = kv[i] * ex2(e0 - bt);
            const unsigned gb = f2bf(g);
            Pg[((size_t)it * 64 + rg * 16 + i) * 128 + k] = (bf16)f2bf(p);
            Gg[((size_t)it * 64 + rg * 16 + i) * 128 + k] = (bf16)gb;
            if (i & 1) gt[i >> 1] |= gb << 16; else gt[i >> 1] = gb;
        }
        *(GASQ v4u*)(GTg + ((size_t)it * 128 + k) * 64 + rg * 16) = (v4u){gt[0], gt[1], gt[2], gt[3]};
        *(GASQ v4u*)(GTg + ((size_t)it * 128 + k) * 64 + rg * 16 + 8) = (v4u){gt[4], gt[5], gt[6], gt[7]};
        if (rg == 0) { VECg[(size_t)it * 384 + k] = ex2(e0); VECg[(size_t)it * 384 + 128 + k] = ex2(Bt); VECg[(size_t)it * 384 + 256 + k] = ex2(Bt - e0); }
    }
    __syncthreads();
}
__device__ __forceinline__ void phase_hg_scan(const Frame& F, float* OHG) {
    const ArgsV A = args_view(F); const GASQ bf16* Z = GCP(bf16, A.ws + WS_Z);
    const GASQ bf16* Pg = GCP(bf16, A.ws + WS_H); const GASQ bf16* Gg = Pg + (size_t)1024 * 8192;
    const GASQ bf16* GTg = GCP(bf16, A.ws + WS_HGT); const GASQ float* VECg = GCP(float, A.ws + WS_HVEC);
    const int tid = F.tid, lane = F.lane, w = F.wave, fr = lane & 15, fq = lane >> 4;
    LAS unsigned char* L = F.lds;
    LAS float* VEC = (LAS float*)(L + HG_VEC);
#pragma unroll 1
    for (int item = F.blk; item < 256; item += F.G) {
        const int bh = (item & 7) * 4 + (item >> 6), vs = (item >> 3) & 7, b = bh >> 2, h = bh & 3, it0 = bh * 32, oitem = bh * 8 + vs;
        const GASQ bf16* zb = Z + (size_t)b * T * ZLD;
        const unsigned vo = (unsigned)((tid >> 4) * 2 * ZLD + ZC_HI + h * 128 + vs * 16 + (tid & 15));
        const int r0 = tid >> 4, c16 = tid & 15, k0 = tid >> 3, c8 = tid & 7;
        const unsigned pgo = (unsigned)(r0 * 128 + c16 * 8), gto = (unsigned)(k0 * 64 + c8 * 8);
        f32x4 S = {0.f, 0.f, 0.f, 0.f};
        v4u sp[2], sg[2], st[2]; f32x4 sv = {0.f, 0.f, 0.f, 0.f}; unsigned short vr[2];
#define HG_LOAD(cc) do { const size_t itc = (size_t)(it0 + (cc)); \
            sp[0] = *(const GASQ v4u*)(Pg + itc * 8192 + pgo); sp[1] = *(const GASQ v4u*)(Pg + itc * 8192 + 4096 + pgo); \
            sg[0] = *(const GASQ v4u*)(Gg + itc * 8192 + pgo); sg[1] = *(const GASQ v4u*)(Gg + itc * 8192 + 4096 + pgo); \
            st[0] = *(const GASQ v4u*)(GTg + itc * 8192 + gto); st[1] = *(const GASQ v4u*)(GTg + itc * 8192 + 4096 + gto); \
            if (tid < 96) sv = *(const GASQ f32x4*)(VECg + itc * 384 + tid * 4); \
            vr[0] = zb[(unsigned)((cc) * 64 * ZLD) + vo]; vr[1] = zb[(unsigned)((cc) * 64 * ZLD) + vo + ZLD]; } while (0)
        HG_LOAD(0);
#pragma unroll 1
        for (int c = 0; c < 32; ++c) {
            *(LAS v4u*)(L + HG_P + r0 * 272 + c16 * 16) = sp[0]; *(LAS v4u*)(L + HG_P + (r0 + 32) * 272 + c16 * 16) = sp[1];
            *(LAS v4u*)(L + HG_G + r0 * 272 + c16 * 16) = sg[0]; *(LAS v4u*)(L + HG_G + (r0 + 32) * 272 + c16 * 16) = sg[1];
            *(LAS v4u*)(L + HG_GT + k0 * 144 + c8 * 16) = st[0]; *(LAS v4u*)(L + HG_GT + (k0 + 64) * 144 + c8 * 16) = st[1];
            if (tid < 96) *(LAS f32x4*)(VEC + tid * 4) = sv;
            *(LAS unsigned*)(L + HG_VT + (tid & 15) * 144 + (tid >> 4) * 4) = (unsigned)vr[0] | ((unsigned)vr[1] << 16);
            if (c < 31) HG_LOAD(c + 1);
            __syncthreads();
            { const int kk = 16 * w + fq * 4; const f32x4 ev = *(const LAS f32x4*)(VEC + kk);
              v2u sw; sw.x = pk2(ev.x * S.x, ev.y * S.y); sw.y = pk2(ev.z * S.z, ev.w * S.w);
              *(LAS v2u*)(L + HG_ST + fr * 272 + kk * 2) = sw; }
#pragma unroll
            for (int q2 = 0; q2 < 2; ++q2) {
                const int tt = 2 * w + q2, ti = tt >> 2, tj = tt & 3;
                f32x4 acc = {0.f, 0.f, 0.f, 0.f};
#pragma unroll
                for (int ks = 0; ks < 4; ++ks) {
                    const bf16x8 pa = *(const LAS bf16x8*)(L + HG_P + (16 * ti + fr) * 272 + (ks * 32 + fq * 8) * 2);
                    const bf16x8 gb = *(const LAS bf16x8*)(L + HG_G + (16 * tj + fr) * 272 + (ks * 32 + fq * 8) * 2);
                    acc = MFMA16(pa, gb, acc);
                }
                asm volatile("s_nop 7\n\ts_nop 7" ::: "memory");
#pragma unroll
                for (int j = 0; j < 4; ++j) { const bool keep = (tj < ti) || ((tj == ti) && (fq * 4 + j >= fr)); acc[j] = keep ? acc[j] : 0.f; }
#pragma unroll
                for (int j = 0; j < 4; ++j) {
                    const unsigned ab = f2bf(acc[j]), ao = (unsigned)__builtin_amdgcn_update_dpp(0, (int)ab, 0xB1, 0xf, 0xf, false);
                    if ((j & 1) == (fr & 1)) *(LAS unsigned*)(L + HG_AM + (16 * ti + fq * 4 + j) * 144 + (16 * tj + (fr & ~1)) * 2) = (fr & 1) ? (ao | (ab << 16)) : (ab | (ao << 16));
                }
            }
            __syncthreads();
            {
                const int wr = w & 3;
                f32x4 o = {0.f, 0.f, 0.f, 0.f};
                if (w < 4) {
#pragma unroll
                    for (int ks = 0; ks < 4; ++ks) {
                        const bf16x8 pa = *(const LAS bf16x8*)(L + HG_P + (16 * wr + fr) * 272 + (ks * 32 + fq * 8) * 2);
                        const bf16x8 sb = *(const LAS bf16x8*)(L + HG_ST + fr * 272 + (ks * 32 + fq * 8) * 2);
                        o = MFMA16(pa, sb, o);
                    }
#pragma unroll
                    for (int ks = 0; ks < 2; ++ks) {
                        const bf16x8 aa = *(const LAS bf16x8*)(L + HG_AM + (16 * wr + fr) * 144 + (ks * 32 + fq * 8) * 2);
                        const bf16x8 vb = *(const LAS bf16x8*)(L + HG_VT + fr * 144 + (ks * 32 + fq * 8) * 2);
                        o = MFMA16(aa, vb, o);
                    }
                    asm volatile("s_nop 7\n\ts_nop 7" ::: "memory");
                    GASQ float* op = GP(float, OHG + ((size_t)oitem * T + c * 64 + 16 * wr + fq * 4) * 16 + fr);
#pragma unroll
                    for (int j = 0; j < 4; ++j) op[j * 16] = o[j];
                }
            }
            {
                f32x4 u = {0.f, 0.f, 0.f, 0.f};
#pragma unroll
                for (int ks = 0; ks < 2; ++ks) {
                    const bf16x8 ga = *(const LAS bf16x8*)(L + HG_GT + (16 * w + fr) * 144 + (ks * 32 + fq * 8) * 2);
                    const bf16x8 vb = *(const LAS bf16x8*)(L + HG_VT + fr * 144 + (ks * 32 + fq * 8) * 2);
                    u = MFMA16(ga, vb, u);
                }
                asm volatile("s_nop 7\n\ts_nop 7" ::: "memory");
                const int kk = 16 * w + fq * 4; const f32x4 eB = *(const LAS f32x4*)(VEC + 128 + kk), eD = *(const LAS f32x4*)(VEC + 256 + kk);
                S = eB * S + eD * u;
            }
            __syncthreads();
        }
#undef HG_LOAD
    }
}
__device__ __forceinline__ void phase_hg_scan_v1(const Frame& F, float* OHG) {
    const ArgsV A = args_view(F); const bf16* Z = (const bf16*)(A.ws + WS_Z);
    const float* lbl = A.in[7];
    LAS float* Fm = (LAS float*)F.lds;
    LAS float* Qm = (LAS float*)(F.lds + 32768);
    LAS float* Vm = (LAS float*)(F.lds + 65536);
    LAS float* Om = (LAS float*)(F.lds + 69632);
    const int tid = F.tid, lane = F.lane;
    for (int item = F.blk; item < 256; item += F.G) {
        const int b = item >> 5, h = (item >> 3) & 3, vs = item & 7;
        const int col = tid & 127; const int ch = h * 128 + col;
        const float lb = 1.f / (1.f + expf(lbl[512 + ch] - lbl[ch]));
        const int k0 = (lane & 31) * 4, vloc = F.wave * 2 + (lane >> 5);
        float S0 = 0.f, S1 = 0.f, S2 = 0.f, S3 = 0.f;
        for (int c = 0; c < 32; ++c) {
            __syncthreads();
            const size_t mbase = (size_t)b * T + c * 64;
#pragma unroll 4
            for (int i = 0; i < 16; ++i) { const int row = (tid >> 7) + 4 * i; const bf16* zr = Z + (mbase + row) * ZLD;
                const float zf = bf2f(zr[ZC_HF + ch]), zq = bf2f(zr[ZC_HQ + ch]);
                Fm[row * 128 + col] = lb + (1.f - lb) * sigmoidf_(zf); Qm[row * 128 + col] = siluf_(zq); }
#pragma unroll
            for (int i = 0; i < 2; ++i) { const int idx = tid + 512 * i, row = idx >> 4, vc = idx & 15; Vm[idx] = bf2f(Z[(mbase + row) * ZLD + ZC_HI + h * 128 + vs * 16 + vc]); }
            __syncthreads();
            for (int t = 0; t < 64; ++t) {
                const f32x4 f4 = *(const LAS f32x4*)(Fm + t * 128 + k0), q4 = *(const LAS f32x4*)(Qm + t * 128 + k0); const float vt = Vm[t * 16 + vloc];
                S0 = f4.x * S0 + (1.f - f4.x) * vt; S1 = f4.y * S1 + (1.f - f4.y) * vt; S2 = f4.z * S2 + (1.f - f4.z) * vt; S3 = f4.w * S3 + (1.f - f4.w) * vt;
                float p = (q4.x * S0 + q4.y * S1) + (q4.z * S2 + q4.w * S3);
                p += __shfl_xor(p, 1); p += __shfl_xor(p, 2); p += __shfl_xor(p, 4); p += __shfl_xor(p, 8); p += __shfl_xor(p, 16);
                if ((lane & 31) == 0) Om[t * 16 + vloc] = p;
            }
            __syncthreads();
#pragma unroll
            for (int i = 0; i < 2; ++i) { const int idx = tid + 512 * i, row = idx >> 4, vc = idx & 15; OHG[((size_t)item * T + c * 64 + row) * 16 + vc] = Om[idx]; }
        }
        __syncthreads();
    }
}
__device__ __forceinline__ void phase_hg_norm(const Frame& F, const float* OHG) {
    const ArgsV A = args_view(F); const bf16* Z = (const bf16*)(A.ws + WS_Z); bf16* MIX = (bf16*)(A.ws + WS_H);
    const int gw = F.blk * NWAVES + F.wave, NGW = F.G * NWAVES, lane = F.lane;
    const f32x2 ngv = *GCP(f32x2, A.in[8] + 2 * lane);
    for (int m = gw; m < M; m += NGW) {
        f32x2 o[4]; unsigned gz[4];
#pragma unroll
        for (int h = 0; h < 4; ++h) {
            o[h] = *GCP(f32x2, OHG + ((size_t)((m / T) * 32 + h * 8 + (lane >> 3)) * T + (m % T)) * 16 + 2 * (lane & 7));
            gz[h] = *GCP(unsigned, Z + (size_t)m * ZLD + ZC_HG + h * 128 + 2 * lane);
        }
#pragma unroll
        for (int h = 0; h < 4; ++h) {
            const float ss = wave_sum(o[h].x * o[h].x + o[h].y * o[h].y);
            const float r = rsqrtf(ss * (1.f / 128.f) + EPS);
            const float y0 = o[h].x * r * ngv.x * siluf_(bflo(gz[h])), y1 = o[h].y * r * ngv.y * siluf_(bfhi(gz[h]));
            *GP(unsigned, MIX + (size_t)m * D + h * 128 + 2 * lane) = pk2(y0, y1);
        }
    }
}

__device__ __forceinline__ void phase_cmp_finish(const Frame& F, const float* PART) {
    const ArgsV A = args_view(F); const float* c1 = (const float*)(A.ws + WS_C1); const float* w2 = A.in[13]; float* KV = (float*)(A.ws + WS_KVCMP);
    LAS float* hw = (LAS float*)(F.lds + F.wave * 2048);
    const int gw = F.blk * NWAVES + F.wave, NGW = F.G * NWAVES, lane = F.lane;
    GASQ bf16* KVb = GP(bf16, KV);
    for (int R = gw; R < 2048; R += NGW) {
        f32x4 s0 = {0.f, 0.f, 0.f, 0.f}, s1 = {0.f, 0.f, 0.f, 0.f};
#pragma unroll
        for (int kp = 0; kp < 16; ++kp) { s0 += *GCP(f32x4, c1 + (kp * 2 + 0) * 256 + lane * 4); s1 += *GCP(f32x4, c1 + (kp * 2 + 1) * 256 + lane * 4); }
#pragma unroll
        for (int ks = 0; ks < 8; ++ks) { s0 += *GCP(f32x4, PART + ((size_t)ks * 2048 + R) * 256 + lane * 4); s1 += *GCP(f32x4, PART + ((size_t)(8 + ks) * 2048 + R) * 256 + lane * 4); }
        f32x4 h0, h1;
        h0.x = siluf_(s0.x); h0.y = siluf_(s0.y); h0.z = siluf_(s0.z); h0.w = siluf_(s0.w);
        h1.x = siluf_(s1.x); h1.y = siluf_(s1.y); h1.z = siluf_(s1.z); h1.w = siluf_(s1.w);
        *(LAS f32x4*)(hw + lane * 4) = h0; *(LAS f32x4*)(hw + 256 + lane * 4) = h1;
        LDS_FENCE();
        const GASQ float* wp0 = GCP(float, w2 + lane); const GASQ float* wp1 = GCP(float, w2 + (size_t)256 * 64 + lane);
        f32x4 a0 = {0.f, 0.f, 0.f, 0.f}, a1 = {0.f, 0.f, 0.f, 0.f};
#pragma unroll 4
        for (int j4 = 0; j4 < 64; ++j4) {
            const f32x4 h0v = *(const LAS f32x4*)(hw + 4 * j4), h1v = *(const LAS f32x4*)(hw + 256 + 4 * j4);
            const f32x4 w0v = {wp0[(4 * j4) * 64], wp0[(4 * j4 + 1) * 64], wp0[(4 * j4 + 2) * 64], wp0[(4 * j4 + 3) * 64]};
            const f32x4 w1v = {wp1[(4 * j4) * 64], wp1[(4 * j4 + 1) * 64], wp1[(4 * j4 + 2) * 64], wp1[(4 * j4 + 3) * 64]};
            a0 += h0v * w0v; a1 += h1v * w1v;
        }
        float o0 = (a0.x + a0.y) + (a0.z + a0.w), o1 = (a1.x + a1.y) + (a1.z + a1.w);
        if ((R & 127) == 127) { o0 = 0.f; o1 = 0.f; }
        KVb[(size_t)R * 64 + lane] = (bf16)f2bf(o0);
        KVb[(size_t)2048 * 64 + ((size_t)(R >> 7) * 64 + lane) * 128 + (R & 127)] = (bf16)f2bf(o1);
        LDS_FENCE();
    }
}

typedef float f32x16 __attribute__((ext_vector_type(16)));
#define MFMA32(a, b, c) __builtin_amdgcn_mfma_f32_32x32x16_bf16((a), (b), (c), 0, 0, 0)
__device__ __forceinline__ unsigned cvtpk(float lo, float hi) { typedef float f2_t __attribute__((ext_vector_type(2))); typedef __bf16 b2_t __attribute__((ext_vector_type(2)));
    f2_t v = {lo, hi}; b2_t r = __builtin_convertvector(v, b2_t); return __builtin_bit_cast(unsigned, r); }
constexpr int AT_KB = 0, AT_VB = 18432, AT_IMP = 36864, AT_SEL = 69632, AT_OUT = 69888  , AT_ROW = 144;

template <int MM>
__device__ __forceinline__ void attn_block_mfma(const LAS unsigned char* Kb, const LAS unsigned char* Vb, const bf16x8 (&qf)[4], f32x16 (&O)[2], float& m, float& l, int lane, bool selbit, int tl) {
    const int r32 = lane & 31, h = lane >> 5;
    f32x16 S[2];
#pragma unroll
    for (int kt = 0; kt < 2; ++kt) {
#pragma unroll
        for (int i = 0; i < 16; ++i) S[kt][i] = 0.f;
#pragma unroll
        for (int ks = 0; ks < 4; ++ks) { const bf16x8 kf = *(const LAS bf16x8*)(Kb + (kt * 32 + r32) * AT_ROW + (ks * 16 + h * 8) * 2); S[kt] = MFMA32(kf, qf[ks], S[kt]); }
        __builtin_amdgcn_sched_barrier(0);
    }
    float mx = -INFINITY;
#pragma unroll
    for (int kt = 0; kt < 2; ++kt)
#pragma unroll
        for (int i = 0; i < 16; ++i) { const int kl = kt * 32 + 8 * (i >> 2) + 4 * h + (i & 3);
            bool ok = selbit; if (MM == 1) ok = ok && (kl <= tl); if (MM == 2) ok = ok && (kl > tl);
            const float s = ok ? S[kt][i] : -INFINITY; S[kt][i] = s; mx = fmaxf(mx, s); }
    mx = fmaxf(mx, xor32f(mx, lane));
    const float mn = fmaxf(m, mx), alpha = ex2(m - mn); m = mn;
    float rs = 0.f;
#pragma unroll
    for (int kt = 0; kt < 2; ++kt)
#pragma unroll
        for (int i = 0; i < 16; ++i) { const float p = ex2(S[kt][i] - mn); S[kt][i] = p; rs += p; }
    l = l * alpha + rs;
#pragma unroll
    for (int i = 0; i < 16; ++i) { O[0][i] *= alpha; O[1][i] *= alpha; }
    bf16x8 pf[4];
#pragma unroll
    for (int s = 0; s < 4; ++s) { const int kt = s >> 1, bb = 8 * (s & 1);
        v4u w; w.x = cvtpk(S[kt][bb + 0], S[kt][bb + 1]); w.y = cvtpk(S[kt][bb + 2], S[kt][bb + 3]); w.z = cvtpk(S[kt][bb + 4], S[kt][bb + 5]); w.w = cvtpk(S[kt][bb + 6], S[kt][bb + 7]);
        pf[s] = __builtin_bit_cast(bf16x8, w); }
#pragma unroll
    for (int dt = 0; dt < 2; ++dt)
#pragma unroll
        for (int s = 0; s < 4; ++s) { const LAS unsigned char* vp = Vb + (dt * 32 + r32) * AT_ROW + (16 * s + 4 * h) * 2;
            const v2u lo = *(const LAS v2u*)vp, hi = *(const LAS v2u*)(vp + 16);
            const v4u w = {lo.x, lo.y, hi.x, hi.y};
            O[dt] = MFMA32(__builtin_bit_cast(bf16x8, w), pf[s], O[dt]); if (s & 1) __builtin_amdgcn_sched_barrier(0); }
}

template <bool WIN>
__device__ __forceinline__ void attn_branch(const Frame& F, const bf16* Kx, const bf16* VTx, size_t bg, int qb, int jlo, int jhi, const bf16x8 (&qf)[4], f32x16 (&O)[2], float& m, float& l, unsigned mysel, int tl) {
    const int tid = F.tid, lane = F.lane, row = tid >> 3, ch = tid & 7;
    const GASQ bf16* kg = (const GASQ bf16*)(Kx + bg * T * 64); const GASQ bf16* vg = (const GASQ bf16*)(VTx + bg * 64 * T);
    const unsigned ko = (unsigned)(row * 64 + ch * 8), vo = (unsigned)(row * T + ch * 8);
    const int so = row * AT_ROW + ch * 16;
    v4u kr = *(const GASQ v4u*)(kg + (jlo * 4096 + ko)), vr = *(const GASQ v4u*)(vg + (jlo * 64 + vo));
    *(LAS v4u*)(F.lds + AT_KB + so) = kr; *(LAS v4u*)(F.lds + AT_VB + so) = vr;
    __syncthreads();
    int buf = 0;
    for (int jb = jlo; jb <= jhi; ++jb) {
        const bool more = jb < jhi;
        if (more) { kr = *(const GASQ v4u*)(kg + ((jb + 1) * 4096 + ko)); vr = *(const GASQ v4u*)(vg + ((jb + 1) * 64 + vo)); }
        const LAS unsigned char* Kb = F.lds + AT_KB + buf * 9216; const LAS unsigned char* Vb = F.lds + AT_VB + buf * 9216;
        const bool selbit = WIN ? true : (((mysel >> jb) & 1u) != 0u);
        if (jb == qb) attn_block_mfma<1>(Kb, Vb, qf, O, m, l, lane, selbit, tl);
        else if (WIN && jb == qb - 8) attn_block_mfma<2>(Kb, Vb, qf, O, m, l, lane, selbit, tl);
        else attn_block_mfma<0>(Kb, Vb, qf, O, m, l, lane, selbit, tl);
        buf ^= 1;
        if (more) { *(LAS v4u*)(F.lds + AT_KB + buf * 9216 + so) = kr; *(LAS v4u*)(F.lds + AT_VB + buf * 9216 + so) = vr; }
        __syncthreads();
    }
}

template <class Bar>
__device__ __forceinline__ void phase_nsa_attn(const Frame& F, const Bar* pending) {
    const ArgsV A = args_view(F); unsigned char* ws = A.ws;
    const bf16* Z = (const bf16*)(ws + WS_Z); const bf16* QN = (const bf16*)(ws + WS_QN);
    const bf16* KS = (const bf16*)(ws + WS_KS); const bf16* VST = (const bf16*)(ws + WS_VS); const bf16* KW = (const bf16*)(ws + WS_KW); const bf16* VWT = (const bf16*)(ws + WS_VW);
    const bf16* KC = (const bf16*)(ws + WS_KVCMP); const bf16* VCT = KC + (size_t)2048 * 64; bf16* MIX = (bf16*)(ws + WS_H);
    const int r = F.wave >> 1, tb = F.wave & 1;
    LAS float* IMP = (LAS float*)(F.lds + AT_IMP);
    LAS unsigned* SEL = (LAS unsigned*)(F.lds + AT_SEL);
    bool waiting = (pending != nullptr);
#pragma unroll 1
    for (int item = F.blk; item < 256; item += F.G) {
        const size_t bg = (size_t)((item & 7) * 2 + (item >> 7)); const int b = (int)(bg >> 1), g = (int)(bg & 1), pi = (item >> 3) & 15;
#pragma unroll 1
        for (int u2 = 0; u2 < 2; ++u2) {
            Frame Fu = F; Fu.lane = opaque_lane(); Fu.tid = F.wave * 64 + Fu.lane;
            const int tid = Fu.tid, lane = Fu.lane, r32 = lane & 31, h = lane >> 5, tl = tb * 32 + r32;
            const int qb = u2 ? (31 - pi) : pi;
            const int t = qb * 64 + tl; const size_t mrow = (size_t)b * T + t;
            bf16x8 qf[4];
            { const GASQ bf16* qp = (const GASQ bf16*)(QN + ((size_t)(b * 8 + g * 4 + r) * T + t) * 64 + h * 8);
#pragma unroll
              for (int ks = 0; ks < 4; ++ks) qf[ks] = *(const GASQ bf16x8*)(qp + ks * 16); }
            const GASQ bf16* gz = (const GASQ bf16*)(Z + mrow * ZLD + ZC_NG + (g * 4 + r) * 3);
            const float g0 = sigmoidf_(bf2f(gz[0])), g1 = sigmoidf_(bf2f(gz[1])), g2 = sigmoidf_(bf2f(gz[2]));
            LAS float* OL = (LAS float*)(F.lds + AT_OUT + F.wave * 8192) + lane;
            {
                f32x16 O[2]; float m = -1e30f, l = 0.f;
#pragma unroll
                for (int i = 0; i < 16; ++i) { O[0][i] = 0.f; O[1][i] = 0.f; }
                __syncthreads();
                attn_branch<true>(Fu, KW, VWT, bg, qb, qb >= 8 ? qb - 8 : 0, qb, qf, O, m, l, 0xffffffffu, tl);
                l += xor32f(l, lane);
                const float sc = g2 / l;
#pragma unroll
                for (int i = 0; i < 16; ++i) { OL[i * 64] = sc * O[0][i]; OL[(16 + i) * 64] = sc * O[1][i]; }
            }
            if (waiting) { xcd_wait(*pending); waiting = false; }
            __syncthreads();
            { const int row = tid >> 3, ch = tid & 7;
              const GASQ bf16* kcb = (const GASQ bf16*)(KC + bg * 8192); const GASQ bf16* vcb = (const GASQ bf16*)(VCT + bg * 8192);
#pragma unroll
              for (int i = 0; i < 2; ++i) { const v4u v = *(const GASQ v4u*)(kcb + (unsigned)((row + 64 * i) * 64 + ch * 8)); *(LAS v4u*)(F.lds + AT_KB + (row + 64 * i) * AT_ROW + ch * 16) = v; }
#pragma unroll
              for (int i = 0; i < 2; ++i) { const v4u v = *(const GASQ v4u*)(vcb + (unsigned)(row * 128 + (ch + 8 * i) * 8)); *(LAS v4u*)(F.lds + AT_VB + row * 272 + (ch + 8 * i) * 16) = v; } }
            __syncthreads();
            {
                const int nvalid = (t >= 31) ? (((t - 31) >> 4) + 1) : 0;
                float mx = -1e30f;
#pragma unroll
                for (int kt = 0; kt < 4; ++kt) {
                    f32x16 S;
#pragma unroll
                    for (int i = 0; i < 16; ++i) S[i] = 0.f;
#pragma unroll
                    for (int ks = 0; ks < 4; ++ks) { const bf16x8 kf = *(const LAS bf16x8*)(F.lds + AT_KB + (kt * 32 + r32) * AT_ROW + (ks * 16 + h * 8) * 2); S = MFMA32(kf, qf[ks], S); }
#pragma unroll
                    for (int i = 0; i < 16; ++i) { const int n = kt * 32 + 8 * (i >> 2) + 4 * h + (i & 3); mx = fmaxf(mx, (n < nvalid) ? S[i] : -INFINITY); }
                    __builtin_amdgcn_sched_barrier(0);
                }
                mx = fmaxf(mx, xor32f(mx, lane));
                f32x16 Oc[2];
#pragma unroll
                for (int i = 0; i < 16; ++i) { Oc[0][i] = 0.f; Oc[1][i] = 0.f; }
                float impv[16]; float rs = 0.f, yprev = 0.f;
#pragma unroll
                for (int kt = 0; kt < 4; ++kt) {
                    f32x16 S;
#pragma unroll
                    for (int i = 0; i < 16; ++i) S[i] = 0.f;
#pragma unroll
                    for (int ks = 0; ks < 4; ++ks) { const bf16x8 kf = *(const LAS bf16x8*)(F.lds + AT_KB + (kt * 32 + r32) * AT_ROW + (ks * 16 + h * 8) * 2); S = MFMA32(kf, qf[ks], S); }
#pragma unroll
                    for (int i = 0; i < 16; ++i) { const int n = kt * 32 + 8 * (i >> 2) + 4 * h + (i & 3); const float p = (n < nvalid) ? ex2(S[i] - mx) : 0.f; S[i] = p; rs += p; }
#pragma unroll
                    for (int a = 0; a < 4; ++a) {
                        const float x = S[4 * a + 3], y = xor32f(x, lane);
                        impv[kt * 4 + a] = (S[4 * a] + S[4 * a + 1] + S[4 * a + 2] + 0.5f * x) + 0.5f * (h ? y : yprev);
                        yprev = y;
                    }
#pragma unroll
                    for (int s2 = 0; s2 < 2; ++s2) { const int s = kt * 2 + s2, bb = 8 * s2;
                        v4u w; w.x = cvtpk(S[bb + 0], S[bb + 1]); w.y = cvtpk(S[bb + 2], S[bb + 3]); w.z = cvtpk(S[bb + 4], S[bb + 5]); w.w = cvtpk(S[bb + 6], S[bb + 7]);
                        const bf16x8 pf = __builtin_bit_cast(bf16x8, w);
#pragma unroll
                        for (int dt = 0; dt < 2; ++dt) { const LAS unsigned char* vp = F.lds + AT_VB + (dt * 32 + r32) * 272 + (16 * s + 4 * h) * 2;
                            const v2u lo = *(const LAS v2u*)vp, hi = *(const LAS v2u*)(vp + 16);
                            const v4u wv = {lo.x, lo.y, hi.x, hi.y};
                            Oc[dt] = MFMA32(__builtin_bit_cast(bf16x8, wv), pf, Oc[dt]); } }
                    __builtin_amdgcn_sched_barrier(0);
                }
                rs += xor32f(rs, lane);
                const float inv = rs > 0.f ? 1.f / rs : 0.f;
#pragma unroll
                for (int q = 0; q < 16; ++q) IMP[(r * 64 + tl) * 32 + 8 * (q >> 2) + 2 * (q & 3) + h] = impv[q] * inv;
                const float gi = g0 * inv;
#pragma unroll
                for (int i = 0; i < 16; ++i) { OL[i * 64] += gi * Oc[0][i]; OL[(16 + i) * 64] += gi * Oc[1][i]; }
            }
            __syncthreads();
#pragma unroll 1
            for (int i = 0; i < 4; ++i) {
                const int idx = tid + 512 * i, tok = idx >> 5, j = idx & 31;
                const float v = ((IMP[(0 * 64 + tok) * 32 + j] + IMP[(1 * 64 + tok) * 32 + j]) + IMP[(2 * 64 + tok) * 32 + j]) + IMP[(3 * 64 + tok) * 32 + j];
                const bool causal = j <= qb, forced = (j == 0) || (j == qb) || (j == qb - 1);
                const float val = causal ? (forced ? INFINITY : v) : -1.f;
                int rank = 0;
#pragma unroll
                for (int i2 = 0; i2 < 32; ++i2) { const int vb = __builtin_bit_cast(int, val); const float vlo = __builtin_bit_cast(float, __builtin_amdgcn_readlane(vb, i2)), vhi = __builtin_bit_cast(float, __builtin_amdgcn_readlane(vb, 32 + i2));
                    const float vi = (lane < 32) ? vlo : vhi; rank += ((vi > val) || (vi == val && i2 < j)) ? 1 : 0; }
                const unsigned long long bal = __ballot((rank < 16) && causal);
                if (lane == 0) SEL[tok] = (unsigned)bal;
                if (lane == 32) SEL[tok] = (unsigned)(bal >> 32);
            }
            __syncthreads();
            const unsigned mysel = SEL[tl];
            {
                f32x16 O[2]; float m = -1e30f, l = 0.f;
#pragma unroll
                for (int i = 0; i < 16; ++i) { O[0][i] = 0.f; O[1][i] = 0.f; }
                attn_branch<false>(Fu, KS, VST, bg, qb, 0, qb, qf, O, m, l, mysel, tl);
                l += xor32f(l, lane);
                const float sc = g1 / l;
                GASQ bf16* op = (GASQ bf16*)(MIX + mrow * D + 512 + (g * 4 + r) * 64 + 4 * h);
#pragma unroll
                for (int dt = 0; dt < 2; ++dt)
#pragma unroll
                    for (int a = 0; a < 4; ++a) { float o[4];
#pragma unroll
                        for (int c = 0; c < 4; ++c) o[c] = OL[(dt * 16 + 4 * a + c) * 64] + sc * O[dt][4 * a + c];
                        v2u w; w.x = cvtpk(o[0], o[1]); w.y = cvtpk(o[2], o[3]); *(GASQ v2u*)(op + dt * 32 + 8 * a) = w; }
            }
        }
    }
    if (waiting) xcd_wait(*pending);
}

__device__ __forceinline__ void conv_seam_rows(const Frame& F, int pm) {
    const ArgsV A = args_view(F); GASQ bf16* ACT = GP(bf16, A.ws + WS_U); const GASQ bf16* HEAD = GCP(bf16, A.ws + WS_HALO); const GASQ bf16* TAIL = HEAD + (size_t)64 * 2 * FF2;
    const GASQ float* cw = GCP(float, A.in[17]); const GASQ float* cb = GCP(float, A.in[18]);
#pragma unroll
    for (int it6 = 0; it6 < 6; ++it6) {
        const int c = F.tid + it6 * NTHR; if (c >= FF) break;
        const GASQ bf16* h0 = HEAD + ((size_t)pm * 2) * FF2; const GASQ bf16* h1 = h0 + FF2;
        const float a0 = bf2f(h0[c]), a1 = bf2f(h1[c]), v0 = bf2f(h0[FF + c]), v1 = bf2f(h1[FF + c]);
        float ta0 = 0.f, ta1 = 0.f, tv0 = 0.f, tv1 = 0.f;
        if (pm & 7) { const GASQ bf16* t0 = TAIL + ((size_t)(pm - 1) * 2) * FF2; const GASQ bf16* t1 = t0 + FF2; ta0 = bf2f(t0[c]); ta1 = bf2f(t1[c]); tv0 = bf2f(t0[FF + c]); tv1 = bf2f(t1[FF + c]); }
        const float wa0 = cw[c], wa1 = cw[FF2 + c], wa2 = cw[2 * FF2 + c], ba = cb[c], wv0 = cw[FF + c], wv1 = cw[FF2 + FF + c], wv2 = cw[2 * FF2 + FF + c], bv = cb[FF + c];
        const float ya0 = ba + wa0 * ta0 + wa1 * ta1 + wa2 * a0, yv0 = bv + wv0 * tv0 + wv1 * tv1 + wv2 * v0;
        const float ya1 = ba + wa0 * ta1 + wa1 * a0 + wa2 * a1, yv1 = bv + wv0 * tv1 + wv1 * v0 + wv2 * v1;
        ACT[((size_t)pm * 256) * FF + c] = (bf16)f2bf(siluf_(ya0) * yv0);
        ACT[((size_t)pm * 256 + 1) * FF + c] = (bf16)f2bf(siluf_(ya1) * yv1);
    }
    asm volatile("s_waitcnt vmcnt(0)" ::: "memory");
    __syncthreads();
}

#define XB_TMO      128
#define XB_XCNT(j)  (256  + 64 * (j))
#define XB_XSUB(j)  (1280 + 64 * (j))
#define XB_XGEN(j)  (2304 + 64 * (j))
#define XB_TOP      3328
#define XB_TOPGEN   3392
#define XCD_BAR_WORDS 3456
#define XB_SPIN_CAP (1u << 18)

__device__ __forceinline__ unsigned xb_ld(unsigned* p)              { return __hip_atomic_load(p, __ATOMIC_RELAXED, __HIP_MEMORY_SCOPE_AGENT); }
__device__ __forceinline__ unsigned xb_add(unsigned* p, unsigned v) { return __hip_atomic_fetch_add(p, v, __ATOMIC_RELAXED, __HIP_MEMORY_SCOPE_AGENT); }
__device__ __forceinline__ unsigned xb_xcc_id() { return (unsigned)__builtin_amdgcn_s_getreg((3 << 11) | 20) & 0xFu; }
#define XB_SPIN(cond, bar) do { unsigned _sp = 0; while (cond) { __builtin_amdgcn_s_sleep(1); \
    if ((++_sp & 255u) == 0u) { if (xb_ld(&(bar)[XB_TMO])) break; if (_sp > XB_SPIN_CAP) { atomicAdd(&(bar)[XB_TMO], 1u); break; } } } } while (0)

struct XcdBarrier {
    unsigned* bar; unsigned x;
    volatile LAS unsigned* st;
};

__device__ __forceinline__ XcdBarrier xcd_barrier_post(unsigned* bar, volatile LAS unsigned* st) {
    XcdBarrier b; b.bar = bar; b.x = xb_xcc_id(); b.st = st;
    if (threadIdx.x == 0) (void)xb_add(&bar[XB_XCNT(b.x)], 1u);
    return b;
}
__device__ __forceinline__ void xcd_barrier_complete(unsigned* bar, unsigned x, unsigned& nloc, unsigned& nx) {
    const unsigned G = gridDim.x * gridDim.y * gridDim.z;
    unsigned sum, cnt, mine, sp = 0u;
    for (;;) {
        sum = 0u; cnt = 0u; mine = 0u;
#pragma unroll
        for (unsigned j = 0; j < 16; ++j) { const unsigned c = xb_ld(&bar[XB_XCNT(j)]); sum += c; cnt += (c > 0u) ? 1u : 0u; mine = (j == x) ? c : mine; }
        if (sum == G) break;
        __builtin_amdgcn_s_sleep(1);
        if ((++sp & 255u) == 0u) { if (xb_ld(&bar[XB_TMO])) break; if (sp > XB_SPIN_CAP) { atomicAdd(&bar[XB_TMO], 1u); break; } }
    }
    nloc = mine > 0u ? mine : 1u; nx = cnt > 0u ? cnt : 1u;
}

__device__ __forceinline__ void xcd_arrive(const XcdBarrier& b) {
    asm volatile("s_waitcnt vmcnt(0)" ::: "memory");
    __syncthreads();
    if (threadIdx.x == 0) {
        unsigned* bar = b.bar;
        __builtin_amdgcn_s_waitcnt(0);
        unsigned nloc = b.st[0], nx = b.st[1];
        if (nloc == 0u) { xcd_barrier_complete(bar, b.x, nloc, nx); b.st[0] = nloc; b.st[1] = nx; }
        const unsigned old = xb_add(&bar[XB_XSUB(b.x)], 1u);
        const unsigned gen = old / nloc;
        if (old + 1u == (gen + 1u) * nloc) {
            __builtin_amdgcn_fence(__ATOMIC_RELEASE, "agent");
            asm volatile("s_waitcnt vmcnt(0)" ::: "memory");
            const unsigned og = xb_add(&bar[XB_TOP], 1u);
            const unsigned tg = og / nx;
            if (og + 1u == (tg + 1u) * nx) xb_add(&bar[XB_TOPGEN], 1u);
        }
        b.st[2] = gen;
    }
}
__device__ __forceinline__ void xcd_wait(const XcdBarrier& b) {
    if (threadIdx.x == 0) {
        unsigned* bar = b.bar; const unsigned gen = b.st[2];
        XB_SPIN(xb_ld(&bar[XB_TOPGEN]) == gen, bar);
        __builtin_amdgcn_fence(__ATOMIC_ACQUIRE, "agent");
        asm volatile("s_waitcnt vmcnt(0)" ::: "memory");
    }
    __syncthreads();
}
__device__ __forceinline__ void xcd_barrier(const XcdBarrier& b) { xcd_arrive(b); xcd_wait(b); }


__global__ void __launch_bounds__(NTHR, 2) fwd_megakernel(Args args) {
    extern __shared__ __attribute__((aligned(16))) unsigned char lds_raw[];
    cg::grid_group grid = cg::this_grid();
    Frame F;
    F.lds = (LAS unsigned char*)lds_raw;
    F.wave = __builtin_amdgcn_readfirstlane((int)(threadIdx.x >> 6)); F.lane = opaque_lane(); F.tid = F.wave * 64 + F.lane;
    F.G = gridDim.x; F.blk = blockIdx.x;
    if (F.tid < 22) { const unsigned long long p = (F.tid < 20) ? (unsigned long long)args.in[F.tid < 20 ? F.tid : 0] : (F.tid == 20 ? (unsigned long long)args.out : (unsigned long long)args.ws);
        LAS unsigned* tab = (LAS unsigned*)(F.lds + ARGTAB); tab[2 * F.tid] = (unsigned)p; tab[2 * F.tid + 1] = (unsigned)(p >> 32); }
    if (F.tid == 0) { ((LAS unsigned*)(F.lds + ARGTAB + 192))[0] = 0u; ((LAS unsigned*)(F.lds + ARGTAB + 192))[1] = 0u; ((LAS unsigned*)(F.lds + ARGTAB + 192))[2] = 0u; }
    __syncthreads();
    const XcdBarrier xbar = xcd_barrier_post((unsigned*)(args.ws + WS_BAR), (volatile LAS unsigned*)(F.lds + ARGTAB + 192));
#define WSP ((unsigned char*)argp(F, 21))
#define OUTP ((float*)argp(F, 20))
#define PARTP (OUTP + (size_t)8 * 1024 * 1024)
    LAS unsigned char* glds = (LAS unsigned char*)lds_raw;
#define GRID_SYNC_CG() do { __builtin_amdgcn_fence(__ATOMIC_RELEASE, "agent"); asm volatile("s_waitcnt vmcnt(0) lgkmcnt(0)" ::: "memory"); grid.sync(); \
        __builtin_amdgcn_fence(__ATOMIC_ACQUIRE, "agent"); asm volatile("s_waitcnt vmcnt(0)" ::: "memory"); } while (0)
#define GRID_SYNC() xcd_barrier(xbar)

    phase0(phase_frame(F));
    xcd_arrive(xbar);
    if (gridDim.x == 0x7fffffffu) GRID_SYNC_CG();
    phase0b(phase_frame(F));
    xcd_wait(xbar);
    phase_norm_mod(phase_frame(F), argp(F, 0), argp(F, 5), 0, 1024, (bf16*)(WSP + WS_H));
    GRID_SYNC();
    {
        unsigned char* ws = WSP;
        pg8::Gemm g{(const bf16*)(ws + WS_H), (const bf16*)(ws + WS_WIN), 1024, 1024, 1024, 0};
        pg8::StaticOrder S; S.init(64, 14, F.G, F.blk, (size_t)256 * 1024 * 2, (size_t)256 * 1024 * 2);
        pg8::EpiBf16 E{(bf16*)(ws + WS_Z), ZLD, nullptr};
        pg8::gemm_phase<pg8::EpiBf16, pg8::StaticOrder, true>(glds, g, S, E, F.wave);
    }
    phase_c1(phase_frame(F), (64 * 14) % F.G);
    GRID_SYNC();
    phase_nsa_prep(phase_frame(F));
    phase_hg_prep(phase_frame(F), OUTP);
    GRID_SYNC();
    phase_hg_scan(phase_frame(F), OUTP);
    __syncthreads();
    {
        unsigned char* ws = WSP;
        pg8::Gemm g{(const bf16*)(ws + WS_KC), (const bf16*)(ws + WS_WC1), 256, 1024, 2048, 0};
        pg8::CmpOrder S{F.G, F.blk, (size_t)(WS_VC - WS_KC)};
        pg8::EpiPart E{PARTP};
        pg8::gemm_phase<pg8::EpiPart, pg8::CmpOrder, false>(glds, g, S, E, F.wave);
    }
    GRID_SYNC();
    phase_hg_norm(phase_frame(F), OUTP);
    phase_cmp_finish(phase_frame(F), PARTP);
    xcd_arrive(xbar);
    phase_nsa_attn(phase_frame(F), &xbar);
    GRID_SYNC();
    {
        unsigned char* ws = WSP;
        pg8::Gemm g{(const bf16*)(ws + WS_H), (const bf16*)(ws + WS_WOUT), 1024, 1024, 1024, 0};
        pg8::StaticOrder S; S.init(64, 4, F.G, F.blk, (size_t)256 * 1024 * 2, (size_t)256 * 1024 * 2);
        pg8::EpiRes E{argp(F, 0), OUTP, (const float*)(ws + WS_MOD) + 2048};
        pg8::gemm_phase<pg8::EpiRes, pg8::StaticOrder, true>(glds, g, S, E, F.wave);
    }
    if (F.G == 256) {
        pg8::StaticOrder S; S.init(64, 4, F.G, F.blk, 0, 0); pg8::Unit u0; (void)S.next(0, u0);
        unsigned* pc = (unsigned*)(WSP + WS_BAR) + 4096 + 64 * u0.pm;
        asm volatile("s_waitcnt vmcnt(0)" ::: "memory");
        __syncthreads();
        if (F.tid == 0) {
            __builtin_amdgcn_fence(__ATOMIC_RELEASE, "agent"); asm volatile("s_waitcnt vmcnt(0)" ::: "memory");
            (void)__hip_atomic_fetch_add(pc, 1u, __ATOMIC_RELAXED, __HIP_MEMORY_SCOPE_AGENT);
            unsigned spins = 0;
            while (__hip_atomic_load(pc, __ATOMIC_RELAXED, __HIP_MEMORY_SCOPE_AGENT) < 4u && ++spins < (1u << 22)) __builtin_amdgcn_s_sleep(1);
            __builtin_amdgcn_fence(__ATOMIC_ACQUIRE, "agent"); asm volatile("s_waitcnt vmcnt(0)" ::: "memory");
        }
        __syncthreads();
        const Frame Fp = phase_frame(F);
        norm_mod_rows(Fp, OUTP, argp(F, 15), 3072, 4096, (bf16*)(WSP + WS_H), u0.pm * 256 + u0.pn * 64 + Fp.wave, u0.pm * 256 + u0.pn * 64 + 64, NWAVES);
    } else {
        GRID_SYNC();
        phase_norm_mod(phase_frame(F), OUTP, argp(F, 15), 3072, 4096, (bf16*)(WSP + WS_H));
    }
    GRID_SYNC();
    {
        unsigned char* ws = WSP;
        pg8::Gemm g{(const bf16*)(ws + WS_H), (const bf16*)(ws + WS_WUP), 1024, 1024, 1024, 0};
        pg8::StaticOrder S; S.init(64, 22, F.G, F.blk, (size_t)256 * 1024 * 2, (size_t)256 * 1024 * 2);
        pg8::EpiConv E{(bf16*)(ws + WS_U), (bf16*)(ws + WS_HALO), (bf16*)(ws + WS_HALO) + (size_t)64 * 2 * FF2, argp(F, 17), argp(F, 18), (LAS float*)(glds + 131072)};
        pg8::gemm_phase<pg8::EpiConv, pg8::StaticOrder, true>(glds, g, S, E, F.wave);
    }
    GRID_SYNC();
    {
        unsigned char* ws = WSP;
        pg8::Gemm g{(const bf16*)(ws + WS_U), (const bf16*)(ws + WS_WDN), FF, FF, FF, 0};
        pg8::StaticOrder S; S.init(64, 4, F.G, F.blk, (size_t)256 * FF * 2, (size_t)256 * FF * 2);
        { pg8::Unit u0; for (int i = 0; S.next(i, u0); ++i) conv_seam_rows(phase_frame(F), u0.pm); }
        pg8::EpiRes E{OUTP, OUTP, (const float*)(ws + WS_MOD) + 5120};
        pg8::gemm_phase<pg8::EpiRes, pg8::StaticOrder, true>(glds, g, S, E, F.wave);
    }
}

extern "C" void kernel_launch(void* const* d_in, const int* in_sizes, int n_in, void* d_out, int out_size, void* d_ws, size_t ws_size, hipStream_t stream) {
    static int grid = 0;
    if (grid == 0) {
        if (n_in != 20 || out_size != M * D || ws_size < WS_END) { fprintf(stderr, "kernel_launch: unexpected shapes (n_in %d out %d ws %zu)\n", n_in, out_size, ws_size); grid = -1; return; }
        int dev = 0, cus = 0, per_cu = 0;
        (void)hipGetDevice(&dev);
        (void)hipDeviceGetAttribute(&cus, hipDeviceAttributeMultiprocessorCount, dev);
        if (hipFuncSetAttribute((const void*)fwd_megakernel, hipFuncAttributeMaxDynamicSharedMemorySize, LDS_BYTES) != hipSuccess) { fprintf(stderr, "kernel_launch: hipFuncSetAttribute failed\n"); }
        if (hipOccupancyMaxActiveBlocksPerMultiprocessor(&per_cu, (const void*)fwd_megakernel, NTHR, LDS_BYTES) != hipSuccess || per_cu < 1) { fprintf(stderr, "kernel_launch: occupancy query says %d\n", per_cu); per_cu = 1; }
        (void)hipGetLastError();
        grid = cus * 1;
        if (grid > 256) grid = 256;
    }
    if (grid < 0) return;
    (void)hipMemsetAsync((char*)d_ws + WS_BAR, 0, 32768, stream);
    Args a{};
    for (int i = 0; i < 20; ++i) a.in[i] = (const float*)d_in[i];
    a.out = (float*)d_out; a.ws = (unsigned char*)d_ws;
    void* kargs[] = {&a};
    hipError_t e = hipLaunchCooperativeKernel((const void*)fwd_megakernel, dim3(grid), dim3(NTHR), kargs, LDS_BYTES, stream);
    if (e != hipSuccess) fprintf(stderr, "cooperative launch failed: %s (grid %d)\n", hipGetErrorString(e), grid);
}
```

```cpp
#include <hip/hip_runtime.h>
#include <hip/hip_cooperative_groups.h>
#include <cstdio>
#include <cstdint>
namespace cg = cooperative_groups;

__device__ __forceinline__ int opaque_lane() { unsigned ones = ~0u; asm volatile("" : "+s"(ones)); return (int)__builtin_amdgcn_mbcnt_hi(ones, __builtin_amdgcn_mbcnt_lo(ones, 0u)); }
namespace pg8 {
#define PG8_LAS __attribute__((address_space(3)))
typedef unsigned short bf16_t;
typedef short bf16x8 __attribute__((ext_vector_type(8)));
typedef float f32x4 __attribute__((ext_vector_type(4)));
typedef unsigned u32x4 __attribute__((ext_vector_type(4)));
constexpr int BM = 256, BK = 64, HALF = 128, HTB = HALF * BK * 2, STAGE_BYTES = 8 * HTB, NXCD = 8, WGM = 8;

__host__ __device__ __forceinline__ int lds_byte(int r, int c) { const int st = (r >> 4) * 2 + (c >> 5), rr = r & 15, cc = c & 31, ob = rr * 64 + cc * 2; return st * 1024 + (ob ^ (((ob >> 9) & 1) << 5)); }
__host__ __device__ __forceinline__ void stage_rc(int b, int& R, int& C) { const int st = b / 1024, sb = b % 1024, swz = sb ^ (((sb >> 9) & 1) << 5); R = (st >> 1) * 16 + swz / 64; C = (st & 1) * 32 + (swz % 64) / 2; }
__host__ __device__ __forceinline__ int perm32(int rho) { const int n = rho >> 4, i = rho & 15; return 8 * (i >> 2) + 4 * n + (i & 3); }

struct Unit { int pm, pn, z, pad; size_t aoff, boff; };
struct Gemm { const bf16_t* A; const bf16_t* Bt; int K, lda, ldb, pad; };

struct StaticOrder {
    int nM, nN, nwg, G, c; size_t tsA, tsB;
    __device__ void init(int nM_, int nN_, int G_, int c_, size_t tsA_, size_t tsB_) { nM = nM_; nN = nN_; nwg = nM * nN; G = G_; c = c_; tsA = tsA_; tsB = tsB_; }
    __device__ bool next(int i, Unit& u) const {
        const long L = (long)i * G + c; if (L >= nwg) return false;
        int wgid = (int)L; { const int q = nwg / NXCD, r = nwg % NXCD, xcd = wgid % NXCD, off = wgid / NXCD; wgid = (xcd < r ? xcd * (q + 1) : r * (q + 1) + (xcd - r) * q) + off; }
        const int nig = WGM * nN, gid = wgid / nig, fm = gid * WGM, gsz = (nM - fm) < WGM ? (nM - fm) : WGM;
        u.pm = fm + ((wgid % nig) % gsz); u.pn = (wgid % nig) / gsz; u.z = 0; u.pad = 0; u.aoff = (size_t)u.pm * tsA; u.boff = (size_t)u.pn * tsB; return true;
    }
    __device__ __forceinline__ void a_ready(const Unit&) const {}
    __device__ __forceinline__ void done(const Unit&) const {}
};
struct CmpOrder {
    int G, c; size_t vdelta;
    __device__ bool next(int i, Unit& u) const {
        const long L = (long)i * G + c; if (L >= 128) return false;
        const int mlp = (int)L / 64, rem = (int)L % 64, pm = rem / 8, ks = rem % 8;
        u.pm = pm; u.pn = 0; u.z = mlp * 8 + ks; u.pad = 0;
        u.aoff = (mlp ? vdelta : 0) + (size_t)pm * 256 * 1024 * 2 + (size_t)ks * 512;
        u.boff = (size_t)mlp * 256 * 2048 * 2 + (size_t)ks * 512; return true;
    }
    __device__ __forceinline__ void a_ready(const Unit&) const {}
    __device__ __forceinline__ void done(const Unit&) const {}
};

__device__ __forceinline__ unsigned cvt_pk_bf16(float lo, float hi) { unsigned r; asm volatile("v_cvt_pk_bf16_f32 %0, %1, %2" : "=v"(r) : "v"(lo), "v"(hi)); return r; }

struct EpiBf16 {
    static constexpr bool PERM = true, AFTER_DRAIN = false;
    bf16_t* O; int ldc; bf16_t* halo;
    __device__ __forceinline__ void operator()(const f32x4 (&acc)[2][2][4][2], const Unit& u, int wr, int wc, int fr, int fq) const {
        const int row0 = u.pm * BM + wr * 64 + fr; const int col0 = u.pn * BM + wc * 32 + 8 * fq;
#pragma unroll
        for (int ai = 0; ai < 2; ++ai)
#pragma unroll
            for (int m = 0; m < 4; ++m) { const int row = row0 + ai * HALF + m * 16; bf16_t* rowp = O + (size_t)row * ldc + col0;
#pragma unroll
                for (int bj = 0; bj < 2; ++bj) { const f32x4 v0 = acc[ai][bj][m][0], v1 = acc[ai][bj][m][1];
                    u32x4 w; w.x = cvt_pk_bf16(v0[0], v0[1]); w.y = cvt_pk_bf16(v0[2], v0[3]); w.z = cvt_pk_bf16(v1[0], v1[1]); w.w = cvt_pk_bf16(v1[2], v1[3]);
                    *(u32x4*)(rowp + bj * HALF) = w;
                    if (halo != nullptr && m == 3 && fr >= 14) *(u32x4*)(halo + ((size_t)(row >> 6) * 2 + (fr - 14)) * ldc + col0 + bj * HALF) = w; } }
    }
};
struct EpiRes {
    static constexpr bool PERM = false, AFTER_DRAIN = false;
    const float* base; float* out; const float* gate;
    __device__ __forceinline__ void operator()(const f32x4 (&acc)[2][2][4][2], const Unit& u, int wr, int wc, int fr, int fq) const {
        const int row0 = u.pm * BM + wr * 64 + fr, col0 = u.pn * BM + wc * 32 + 4 * fq; const int b = (u.pm * BM) / 2048;
        f32x4 gv[2][2];
#pragma unroll
        for (int bj = 0; bj < 2; ++bj)
#pragma unroll
            for (int n = 0; n < 2; ++n) gv[bj][n] = *(const f32x4*)(gate + (size_t)b * 6144 + col0 + bj * HALF + n * 16);
#pragma unroll
        for (int ai = 0; ai < 2; ++ai)
#pragma unroll
            for (int m = 0; m < 4; ++m) { const size_t ro = (size_t)(row0 + ai * HALF + m * 16) * 1024 + col0;
#pragma unroll
                for (int bj = 0; bj < 2; ++bj)
#pragma unroll
                    for (int n = 0; n < 2; ++n) { const f32x4 xv = *(const f32x4*)(base + ro + bj * HALF + n * 16); *(f32x4*)(out + ro + bj * HALF + n * 16) = xv + gv[bj][n] * acc[ai][bj][m][n]; } }
    }
};
struct EpiPart {
    static constexpr bool PERM = false, AFTER_DRAIN = false;
    float* P;
    __device__ __forceinline__ void operator()(const f32x4 (&acc)[2][2][4][2], const Unit& u, int wr, int wc, int fr, int fq) const {
        const int row0 = u.pm * BM + wr * 64 + fr, col0 = wc * 32 + 4 * fq;
#pragma unroll
        for (int ai = 0; ai < 2; ++ai)
#pragma unroll
            for (int m = 0; m < 4; ++m) { float* rowp = P + ((size_t)u.z * 2048 + row0 + ai * HALF + m * 16) * 256 + col0;
#pragma unroll
                for (int bj = 0; bj < 2; ++bj)
#pragma unroll
                    for (int n = 0; n < 2; ++n) *(f32x4*)(rowp + bj * HALF + n * 16) = acc[ai][bj][m][n]; }
    }
};


__device__ __forceinline__ float dpp_ror1(float x) { return __builtin_bit_cast(float, __builtin_amdgcn_update_dpp(0, __builtin_bit_cast(int, x), 0x121, 0xf, 0xf, false)); }
__device__ __forceinline__ float dpp_ror2(float x) { return __builtin_bit_cast(float, __builtin_amdgcn_update_dpp(0, __builtin_bit_cast(int, x), 0x122, 0xf, 0xf, false)); }
__device__ __forceinline__ float dpp_shr1(float old, float x) { return __builtin_bit_cast(float, __builtin_amdgcn_update_dpp(__builtin_bit_cast(int, old), __builtin_bit_cast(int, x), 0x111, 0xf, 0xf, false)); }
__device__ __forceinline__ float dpp_shr2(float old, float x) { return __builtin_bit_cast(float, __builtin_amdgcn_update_dpp(__builtin_bit_cast(int, old), __builtin_bit_cast(int, x), 0x112, 0xf, 0xf, false)); }
struct EpiConv {
    static constexpr bool PERM = true, AFTER_DRAIN = false;
    bf16_t* ACT; bf16_t* head; bf16_t* tail; const float* cw; const float* cb; PG8_LAS float* xb;
    __device__ __forceinline__ void operator()(const f32x4 (&acc)[2][2][4][2], const Unit& u, int wr, int wc, int fr, int fq) const {
        typedef __attribute__((address_space(1))) bf16_t gbf; typedef __attribute__((address_space(1))) unsigned gu32_;
        const int colh = wc * 32 + 8 * fq, FFc = 2816, FF2c = 5632;
        if (fr >= 14) {
#pragma unroll
            for (int ai = 0; ai < 2; ++ai)
#pragma unroll
                for (int bj = 0; bj < 2; ++bj)
#pragma unroll
                    for (int n = 0; n < 2; ++n) *(PG8_LAS f32x4*)(xb + ((ai * 2 + wr) * 2 + (fr - 14)) * 256 + bj * 128 + colh + 4 * n) = acc[ai][bj][3][n];
            if (wr == 1) {
#pragma unroll
                for (int bj = 0; bj < 2; ++bj)
#pragma unroll
                    for (int n = 0; n < 2; ++n) { const f32x4 v = acc[1][bj][3][n]; gu32_* p = (gu32_*)((gbf*)tail + ((size_t)u.pm * 2 + (fr - 14)) * FF2c + bj * FFc + u.pn * 128 + colh + 4 * n);
                        p[0] = cvt_pk_bf16(v[0], v[1]); p[1] = cvt_pk_bf16(v[2], v[3]); }
            }
        }
        if (fr < 2 && wr == 0) {
#pragma unroll
            for (int bj = 0; bj < 2; ++bj)
#pragma unroll
                for (int n = 0; n < 2; ++n) { const f32x4 v = acc[0][bj][0][n]; gu32_* p = (gu32_*)((gbf*)head + ((size_t)u.pm * 2 + fr) * FF2c + bj * FFc + u.pn * 128 + colh + 4 * n);
                    p[0] = cvt_pk_bf16(v[0], v[1]); p[1] = cvt_pk_bf16(v[2], v[3]); }
        }
        asm volatile("s_waitcnt lgkmcnt(0)" ::: "memory"); __builtin_amdgcn_s_barrier(); asm volatile("" ::: "memory");
#pragma unroll
        for (int n = 0; n < 2; ++n) {
            const int ca = u.pn * 128 + colh + 4 * n;
            typedef __attribute__((address_space(1))) f32x4 gf4;
            const f32x4 wa0 = *(const gf4*)(cw + ca), wa1 = *(const gf4*)(cw + FF2c + ca), wa2 = *(const gf4*)(cw + 2 * FF2c + ca), ba = *(const gf4*)(cb + ca);
            const f32x4 wv0 = *(const gf4*)(cw + FFc + ca), wv1 = *(const gf4*)(cw + FF2c + FFc + ca), wv2 = *(const gf4*)(cw + 2 * FF2c + FFc + ca), bv = *(const gf4*)(cb + FFc + ca);
#pragma unroll
            for (int ai = 0; ai < 2; ++ai) {
                const int sai = (ai == 0) ? 0 : (wr == 0 ? 0 : 1), swr = (ai == 0) ? 0 : (wr == 0 ? 1 : 0);
                const bool has = !(ai == 0 && wr == 0);
                f32x4 pa = {0.f, 0.f, 0.f, 0.f}, pv = {0.f, 0.f, 0.f, 0.f};
                if (fr >= 14 && has) { pa = *(const PG8_LAS f32x4*)(xb + ((sai * 2 + swr) * 2 + (fr - 14)) * 256 + colh + 4 * n); pv = *(const PG8_LAS f32x4*)(xb + ((sai * 2 + swr) * 2 + (fr - 14)) * 256 + 128 + colh + 4 * n); }
#pragma unroll
                for (int m = 0; m < 4; ++m) {
                    const f32x4 xa = acc[ai][0][m][n], xv = acc[ai][1][m][n];
                    float res[4];
#pragma unroll
                    for (int c = 0; c < 4; ++c) {
                        const float a1 = dpp_shr1(dpp_ror1(pa[c]), xa[c]), a2 = dpp_shr2(dpp_ror2(pa[c]), xa[c]);
                        const float v1 = dpp_shr1(dpp_ror1(pv[c]), xv[c]), v2 = dpp_shr2(dpp_ror2(pv[c]), xv[c]);
                        const float ya = ba[c] + wa0[c] * a2 + wa1[c] * a1 + wa2[c] * xa[c];
                        const float yv = bv[c] + wv0[c] * v2 + wv1[c] * v1 + wv2[c] * xv[c];
                        res[c] = ya * __builtin_amdgcn_rcpf(1.f + __builtin_amdgcn_exp2f(-1.4426950408889634f * ya)) * yv;
                    }
                    gu32_* p = (gu32_*)((gbf*)ACT + (size_t)(u.pm * BM + ai * HALF + wr * 64 + m * 16 + fr) * FFc + ca);
                    p[0] = cvt_pk_bf16(res[0], res[1]); p[1] = cvt_pk_bf16(res[2], res[3]);
                    pa = xa; pv = xv;
                }
            }
        }
    }
};

template <class Epi, class Sched, bool ALIGN_EPI>
__device__ __forceinline__ void gemm_phase(PG8_LAS unsigned char* lds, const Gemm g, const Sched& S, const Epi& E, int wave_id) {
    const int wid = wave_id, lane = opaque_lane(), tid = wid * 64 + lane, wr = wid >> 2, wc = wid & 3, fr = lane & 15, fq = lane >> 4;
    const int K = g.K, nt = K / BK;
    unsigned voffA[2], voffB[2];
#pragma unroll
    for (int i = 0; i < 2; ++i) { int R, C; stage_rc(tid * 16 + i * 8192, R, C); const int Rb = Epi::PERM ? ((R & ~31) + perm32(R & 31)) : R;
        voffA[i] = (unsigned)(R * g.lda + C) * 2u; voffB[i] = (unsigned)(Rb * g.ldb + C) * 2u; }
    const size_t kstep = (size_t)(BK * 2);
    const size_t hsA = (size_t)HALF * g.lda * 2, hsB = (size_t)HALF * g.ldb * 2;
    const unsigned ldsw = (unsigned)wid * 1024u;
    const int aoff = lds_byte(wr * 64 + fr, fq * 8), boff = lds_byte(wc * 32 + fr, fq * 8);
#define PG8_SA(b, h) (((b) * 2 + (h)) * HTB)
#define PG8_SB(b, h) ((4 + (b) * 2 + (h)) * HTB)
#define PG8_STAGE(bufoff, gbase, voff) do { _Pragma("unroll") for (int _i = 0; _i < 2; ++_i) \
        __builtin_amdgcn_global_load_lds((const unsigned*)((const char*)(gbase) + (voff)[_i]), (PG8_LAS unsigned*)(lds + (bufoff) + ldsw + _i * 8192), 16, 0, 0); } while (0)
#define PG8_LDA(dst, b, h) do { _Pragma("unroll") for (int m = 0; m < 4; ++m) _Pragma("unroll") for (int k = 0; k < 2; ++k) dst[m][k] = *(const PG8_LAS bf16x8*)(lds + PG8_SA(b, h) + aoff + m * 2048 + k * 1024); } while (0)
#define PG8_LDB(dst, b, h) do { _Pragma("unroll") for (int n = 0; n < 2; ++n) _Pragma("unroll") for (int k = 0; k < 2; ++k) dst[n][k] = *(const PG8_LAS bf16x8*)(lds + PG8_SB(b, h) + boff + n * 2048 + k * 1024); } while (0)
#define PG8_MMA(ai, bj, At, Bt) do { __builtin_amdgcn_s_setprio(1); _Pragma("unroll") for (int m = 0; m < 4; ++m) _Pragma("unroll") for (int n = 0; n < 2; ++n) _Pragma("unroll") for (int k = 0; k < 2; ++k) \
        acc[ai][bj][m][n] = __builtin_amdgcn_mfma_f32_16x16x32_bf16(Bt[n][k], At[m][k], acc[ai][bj][m][n], 0, 0, 0); __builtin_amdgcn_s_setprio(0); } while (0)
#define PG8_WAIT_V(n) asm volatile("s_waitcnt vmcnt(" #n ")" ::: "memory")
#define PG8_WAIT_L(n) asm volatile("s_waitcnt lgkmcnt(" #n ")" ::: "memory")
#define PG8_BAR __builtin_amdgcn_s_barrier()
#define PG8_SCHED __builtin_amdgcn_sched_barrier(0)
    Unit cur, nxt; int ui = 0;
    if (!S.next(0, cur)) return;
    f32x4 acc[2][2][4][2];
#pragma unroll
    for (int a = 0; a < 2; ++a)
#pragma unroll
        for (int b = 0; b < 2; ++b)
#pragma unroll
            for (int m = 0; m < 4; ++m)
#pragma unroll
                for (int n = 0; n < 2; ++n) acc[a][b][m][n] = (f32x4){0.f, 0.f, 0.f, 0.f};
    bf16x8 At[4][2], B0[2][2], B1[2][2];
    const char* cA = (const char*)g.A + cur.aoff; const char* cB = (const char*)g.Bt + cur.boff;
    S.a_ready(cur);
    PG8_STAGE(PG8_SB(0, 0), cB, voffB); PG8_STAGE(PG8_SB(0, 1), cB + hsB, voffB); PG8_STAGE(PG8_SA(0, 0), cA, voffA); PG8_STAGE(PG8_SA(0, 1), cA + hsA, voffA);
    if (wr == 1) PG8_BAR;
    PG8_WAIT_V(2); PG8_BAR;
    PG8_STAGE(PG8_SB(1, 0), cB + kstep, voffB); PG8_STAGE(PG8_SA(1, 0), cA + kstep, voffA); PG8_STAGE(PG8_SB(1, 1), cB + hsB + kstep, voffB);
    PG8_WAIT_V(6); PG8_BAR;
    for (;;) {
        const bool has_next = S.next(ui + 1, nxt);
        const char* nA = has_next ? (const char*)g.A + nxt.aoff : cA; const char* nB = has_next ? (const char*)g.Bt + nxt.boff : cB;
        for (int t = 0; t < nt; t += 2) {
            const bool last = (t == nt - 2);
            const char* a1 = cA + (size_t)(t + 1) * kstep;
            const char* a2 = last ? nA : cA + (size_t)(t + 2) * kstep; const char* b2 = last ? nB : cB + (size_t)(t + 2) * kstep;
            const char* a3 = a2 + kstep; const char* b3 = b2 + kstep;
            if (last && has_next) S.a_ready(nxt);
            PG8_LDB(B0, 0, 0); PG8_LDB(B1, 0, 1); PG8_SCHED; PG8_LDA(At, 0, 0); PG8_STAGE(PG8_SA(1, 1), a1 + hsA, voffA);
            PG8_WAIT_V(8); PG8_WAIT_L(0); PG8_BAR; PG8_MMA(0, 0, At, B0); PG8_MMA(0, 1, At, B1); PG8_BAR; PG8_SCHED;
            PG8_LDA(At, 0, 1); PG8_STAGE(PG8_SB(0, 0), b2, voffB); PG8_STAGE(PG8_SB(0, 1), b2 + hsB, voffB); PG8_STAGE(PG8_SA(0, 0), a2, voffA);
            PG8_WAIT_V(8); PG8_WAIT_L(0); PG8_BAR; PG8_MMA(1, 0, At, B0); PG8_MMA(1, 1, At, B1); PG8_BAR; PG8_SCHED;
            PG8_LDB(B0, 1, 0); PG8_LDB(B1, 1, 1); PG8_SCHED; PG8_LDA(At, 1, 0); PG8_STAGE(PG8_SA(0, 1), a2 + hsA, voffA);
            PG8_WAIT_V(8); PG8_WAIT_L(0); PG8_BAR; PG8_MMA(0, 0, At, B0); PG8_MMA(0, 1, At, B1); PG8_BAR; PG8_SCHED;
            PG8_LDA(At, 1, 1); PG8_STAGE(PG8_SB(1, 0), b3, voffB); PG8_STAGE(PG8_SB(1, 1), b3 + hsB, voffB); PG8_STAGE(PG8_SA(1, 0), a3, voffA);
            PG8_WAIT_V(8); PG8_WAIT_L(0); PG8_BAR; PG8_MMA(1, 0, At, B0); PG8_MMA(1, 1, At, B1); PG8_BAR; PG8_SCHED;
        }
        if constexpr (ALIGN_EPI) { if (wr == 0) PG8_BAR; }
        E(acc, cur, wr, wc, fr, fq); S.done(cur);
        if (!has_next) break;
#pragma unroll
        for (int a = 0; a < 2; ++a)
#pragma unroll
            for (int b = 0; b < 2; ++b)
#pragma unroll
                for (int m = 0; m < 4; ++m)
#pragma unroll
                    for (int n = 0; n < 2; ++n) acc[a][b][m][n] = (f32x4){0.f, 0.f, 0.f, 0.f};
        cur = nxt; cA = nA; cB = nB; ++ui;
        if constexpr (ALIGN_EPI) { if (wr == 1) PG8_BAR; }
    }
    PG8_WAIT_V(0);
    if constexpr (!ALIGN_EPI) { if (wr == 0) PG8_BAR; }
    PG8_BAR;
#undef PG8_SA
#undef PG8_SB
#undef PG8_STAGE
#undef PG8_LDA
#undef PG8_LDB
#undef PG8_MMA
#undef PG8_WAIT_V
#undef PG8_WAIT_L
#undef PG8_BAR
#undef PG8_SCHED
}
}

#define LAS __attribute__((address_space(3)))
#define GASQ __attribute__((address_space(1)))
#define GP(Tp, p) ((GASQ Tp*)(p))
#define GCP(Tp, p) ((const GASQ Tp*)(p))
typedef unsigned short bf16;
typedef float f32x4 __attribute__((ext_vector_type(4)));
typedef float f32x2 __attribute__((ext_vector_type(2)));
typedef unsigned v4u __attribute__((ext_vector_type(4)));
typedef unsigned v2u __attribute__((ext_vector_type(2)));

constexpr int NTHR = 512, NWAVES = 8;
constexpr int BSZ = 8, T = 2048, D = 1024, M = BSZ * T;
constexpr int ZLD = 3584, NZ = 3352, FF = 2816, FF2 = 5632, MODW = 6144;
constexpr int ZC_HQ = 0, ZC_HF = 512, ZC_HI = 1024, ZC_HG = 1536, ZC_NQ = 2048, ZC_KC = 2560, ZC_VC = 2688, ZC_KS = 2816, ZC_VS = 2944, ZC_KW = 3072, ZC_VW = 3200, ZC_NG = 3328;
constexpr float EPS = 1e-6f;
constexpr size_t MiB = 1u << 20;
constexpr size_t WS_WIN = 0, WS_WOUT = 7 * MiB, WS_WUP = 9 * MiB, WS_WDN = 20 * MiB, WS_WC1 = 26 * MiB;
constexpr size_t WS_MOD = 28 * MiB, WS_C1 = 28 * MiB + 256 * 1024, WS_KVCMP = 29 * MiB  , WS_HALO = 32 * MiB  ;
constexpr size_t WS_H = 40 * MiB  , WS_Z = 72 * MiB  ;
constexpr size_t WS_QN = 184 * MiB  , WS_KC = 200 * MiB, WS_VC = 205 * MiB, WS_KS = 210 * MiB, WS_VS = 215 * MiB, WS_KW = 220 * MiB, WS_VW = 225 * MiB;
constexpr size_t WS_U = 72 * MiB  , WS_END = 248 * MiB;
constexpr size_t WS_HGT = 229 * MiB  , WS_HVEC = 245 * MiB + 512 * 1024  ;
constexpr size_t WS_BAR = 39 * MiB;
constexpr int LDS_BYTES = 147456;

struct Args { const float* in[20]; float* out; unsigned char* ws; };

__device__ __forceinline__ unsigned f2bf(float f) { unsigned u = __builtin_bit_cast(unsigned, f); return (u + 0x7fffu + ((u >> 16) & 1u)) >> 16; }
__device__ __forceinline__ unsigned pk2(float lo, float hi) { return f2bf(lo) | (f2bf(hi) << 16); }
__device__ __forceinline__ float bf2f(unsigned short h) { return __builtin_bit_cast(float, (unsigned)h << 16); }
__device__ __forceinline__ float bflo(unsigned w) { return __builtin_bit_cast(float, w << 16); }
__device__ __forceinline__ float bfhi(unsigned w) { return __builtin_bit_cast(float, w & 0xffff0000u); }
#define DPPF(x, ctrl) __builtin_bit_cast(float, __builtin_amdgcn_update_dpp(0, __builtin_bit_cast(int, (x)), (ctrl), 0xf, 0xf, false))
__device__ __forceinline__ float wave_sum(float v) {
    v += DPPF(v, 0xB1); v += DPPF(v, 0x4E); v += DPPF(v, 0x141); v += DPPF(v, 0x140);
    v += __shfl_xor(v, 16);
    v += __shfl_xor(v, 32);
    return v;
}
__device__ __forceinline__ float wave_max(float v) {
    v = fmaxf(v, DPPF(v, 0xB1)); v = fmaxf(v, DPPF(v, 0x4E)); v = fmaxf(v, DPPF(v, 0x141)); v = fmaxf(v, DPPF(v, 0x140));
    v = fmaxf(v, __shfl_xor(v, 16));
    v = fmaxf(v, __shfl_xor(v, 32));
    return v;
}
__device__ __forceinline__ float xor32f(float x, int lane) { (void)lane; return __shfl_xor(x, 32); }
__device__ __forceinline__ float sigmoidf_(float x) { return __builtin_amdgcn_rcpf(1.f + __builtin_amdgcn_exp2f(-1.4426950408889634f * x)); }
__device__ __forceinline__ float siluf_(float x) { return x * __builtin_amdgcn_rcpf(1.f + __builtin_amdgcn_exp2f(-1.4426950408889634f * x)); }
#define LDS_FENCE() asm volatile("s_waitcnt lgkmcnt(0)" ::: "memory")
typedef short bf16x8 __attribute__((ext_vector_type(8)));
__device__ __forceinline__ float ex2(float x) { return __builtin_amdgcn_exp2f(x); }

struct Frame {
    LAS unsigned char* lds;
    int tid, lane, wave, G, blk;
};
constexpr int ARGTAB = 147200;
__device__ __forceinline__ const float* argp(const Frame& F, int k) {
    const LAS unsigned* tab = (const LAS unsigned*)(F.lds + ARGTAB);
    const unsigned lo = (unsigned)__builtin_amdgcn_readfirstlane((int)tab[2 * k]), hi = (unsigned)__builtin_amdgcn_readfirstlane((int)tab[2 * k + 1]);
    return (const float*)(((unsigned long long)hi << 32) | (unsigned long long)lo);
}
struct ArgsV { Frame F; struct InV { Frame F; __device__ __forceinline__ const float* operator[](int k) const { return argp(F, k); } } in; unsigned char* ws; float* out; };
__device__ __forceinline__ ArgsV args_view(const Frame& F) { ArgsV A; A.F = F; A.in.F = F; A.ws = (unsigned char*)argp(F, 21); A.out = (float*)argp(F, 20); return A; }
__device__ __forceinline__ Frame phase_frame(Frame F) { F.lane = opaque_lane(); F.tid = F.wave * 64 + F.lane; return F; }

template <bool UPMAP>
__device__ __forceinline__ void p0_transpose_item(const float* W, int K, int N, bf16* WT, LAS float* scr, int item, int nblk, int lane) {
    const int kb = item / nblk, nb = item % nblk, k0 = 64 * kb, n0 = 32 * nb;
    const int d0 = UPMAP ? ((n0 < FF) ? ((n0 >> 7) * 256 + (n0 & 127)) : ((((n0 - FF) >> 7) * 256) + 128 + ((n0 - FF) & 127))) : n0;
    const bool nok = (n0 + (lane & 31)) < N;
    float tv[32];
#pragma unroll
    for (int i = 0; i < 32; ++i) { const int kk = 2 * i + (lane >> 5); tv[i] = nok ? GCP(float, W)[(size_t)(k0 + kk) * N + n0 + (lane & 31)] : 0.f; }
#pragma unroll
    for (int i = 0; i < 32; ++i) { const int kk = 2 * i + (lane >> 5); scr[kk * 33 + (lane & 31)] = tv[i]; }
    if (false)
    for (int i = 0; i < 32; ++i) { const int kk = 2 * i + (lane >> 5); scr[kk * 33 + (lane & 31)] = nok ? GCP(float, W)[(size_t)(k0 + kk) * N + n0 + (lane & 31)] : 0.f; }
    LDS_FENCE();
    const int c = lane & 7;
#pragma unroll
    for (int j = 0; j < 4; ++j) { const int n = (lane >> 3) + 8 * j; const LAS float* s = scr + (8 * c) * 33 + n;
        v4u o; o.x = pk2(s[0 * 33], s[1 * 33]); o.y = pk2(s[2 * 33], s[3 * 33]); o.z = pk2(s[4 * 33], s[5 * 33]); o.w = pk2(s[6 * 33], s[7 * 33]);
        *GP(v4u, WT + (size_t)(d0 + n) * K + k0 + 8 * c) = o; }
    LDS_FENCE();
}

__device__ __forceinline__ void phase0(const Frame& F) {
    const ArgsV A = args_view(F); unsigned char* ws = A.ws;
    LAS float* sc = (LAS float*)F.lds;
    LAS float* red = (LAS float*)(F.lds + 32768);
    const float* c = A.in[1]; const float* w_ada = A.in[3]; const float* b_ada = A.in[4];
    float* mod = (float*)(ws + WS_MOD);
    { float cv[16];
#pragma unroll
      for (int i = 0; i < 16; ++i) cv[i] = GCP(float, c)[F.tid + i * NTHR];
#pragma unroll
      for (int i = 0; i < 16; ++i) sc[F.tid + i * NTHR] = siluf_(cv[i]); }
    __syncthreads();
    for (int cb = F.blk; cb < 256; cb += F.G) {
        const int n0 = cb * 24, col = F.tid % 24, kg = F.tid / 24;
        if (F.tid < 504) {
            float acc[8];
#pragma unroll
            for (int b = 0; b < 8; ++b) acc[b] = 0.f;
#pragma unroll 7
            for (int k = kg; k < 1024; k += 21) { const float w = GCP(float, w_ada)[(size_t)k * MODW + n0 + col];
#pragma unroll
                for (int b = 0; b < 8; ++b) acc[b] += sc[b * 1024 + k] * w; }
#pragma unroll
            for (int b = 0; b < 8; ++b) red[(kg * 24 + col) * 8 + b] = acc[b];
        }
        __syncthreads();
        if (F.tid < 192) { const int cc = F.tid % 24, b = F.tid / 24; float s = b_ada[n0 + cc];
            for (int g = 0; g < 21; ++g) s += red[(g * 24 + cc) * 8 + b];
            mod[b * MODW + n0 + cc] = s; }
        __syncthreads();
    }
    __syncthreads();
}
__device__ __forceinline__ void phase0b(const Frame& F) {
    const ArgsV A = args_view(F); unsigned char* ws = A.ws;
    LAS float* scr = (LAS float*)(F.lds + F.wave * 16384);
    const int gw = F.blk * NWAVES + F.wave, NGW = F.G * NWAVES;
    constexpr int I_IN = 16 * 105, I_OUT = 16 * 32, I_UP = 16 * 176, I_DN = 44 * 32, I_C1 = 32 * 8;
    constexpr int NITEMS = I_IN + I_OUT + I_UP + I_DN + 2 * I_C1;
    for (int it = gw; it < NITEMS; it += NGW) {
        int r = it;
        if (r < I_IN) { p0_transpose_item<false>(A.in[6], 1024, NZ, (bf16*)(ws + WS_WIN), scr, r, 105, F.lane); continue; } r -= I_IN;
        if (r < I_OUT) { p0_transpose_item<false>(A.in[14], 1024, 1024, (bf16*)(ws + WS_WOUT), scr, r, 32, F.lane); continue; } r -= I_OUT;
        if (r < I_UP) { p0_transpose_item<true>(A.in[16], 1024, FF2, (bf16*)(ws + WS_WUP), scr, r, 176, F.lane); continue; } r -= I_UP;
        if (r < I_DN) { p0_transpose_item<false>(A.in[19], FF, 1024, (bf16*)(ws + WS_WDN), scr, r, 32, F.lane); continue; } r -= I_DN;
        if (r < I_C1) { p0_transpose_item<false>(A.in[12], 2048, 256, (bf16*)(ws + WS_WC1), scr, r, 8, F.lane); continue; } r -= I_C1;
        p0_transpose_item<false>(A.in[12] + (size_t)2048 * 256, 2048, 256, (bf16*)(ws + WS_WC1) + (size_t)256 * 2048, scr, r, 8, F.lane);
    }
    { v4u* z = (v4u*)((bf16*)(ws + WS_WIN) + (size_t)3360 * 1024); const int n16 = 224 * 1024 * 2 / 16;
      for (int i = F.blk * NTHR + F.tid; i < n16; i += F.G * NTHR) z[i] = (v4u){0u, 0u, 0u, 0u}; }
}

__device__ __forceinline__ void phase_c1(const Frame& F, int blk0) {
    if (F.blk < blk0) return;
    const ArgsV A = args_view(F); unsigned char* ws = A.ws;
    const GASQ float* pe = GCP(float, A.in[11]); const GASQ float* w1 = GCP(float, A.in[12]); GASQ float* c1p = GP(float, ws + WS_C1);
    for (int it = (F.blk - blk0) * NWAVES + F.wave; it < 128; it += (F.G - blk0) * NWAVES) {
        const int ks = it >> 3, i = (it >> 2) & 1, j = (it & 3) * 64 + F.lane;
        float s = 0.f;
#pragma unroll 8
        for (int k = ks * 128; k < ks * 128 + 128; ++k) s += pe[i * 2048 + k] * w1[((size_t)i * 2048 + k) * 256 + j];
        c1p[(ks * 2 + i) * 256 + j] = s;
    }
}
__device__ __forceinline__ void norm_mod_rows(const Frame& F, const float* x, const float* g, int sh_off, int sc_off, bf16* H, int m_begin, int m_end, int m_step) {
    const float* mod = (const float*)((unsigned char*)argp(F, 21) + WS_MOD);
    for (int m0 = m_begin; m0 < m_end; m0 += 2 * m_step) {
        const int m1 = m0 + m_step; const bool two = m1 < m_end; const int mm[2] = {m0, two ? m1 : m0};
        f32x4 v[2][4]; float s[2] = {0.f, 0.f};
#pragma unroll
        for (int r = 0; r < 2; ++r) { const GASQ f32x4* xr = GCP(f32x4, x + (size_t)mm[r] * D) + F.lane;
#pragma unroll
            for (int j = 0; j < 4; ++j) v[r][j] = xr[64 * j]; }
#pragma unroll
        for (int r = 0; r < 2; ++r)
#pragma unroll
            for (int j = 0; j < 4; ++j) s[r] += (v[r][j].x * v[r][j].x + v[r][j].y * v[r][j].y) + (v[r][j].z * v[r][j].z + v[r][j].w * v[r][j].w);
#pragma unroll
        for (int r = 0; r < 2; ++r) {
            if (r == 1 && !two) break;
            const int m = mm[r], b = m / T;
            const float rstd = rsqrtf(wave_sum(s[r]) * (1.f / D) + EPS);
            GASQ v2u* o8 = GP(v2u, H + (size_t)m * D) + F.lane;
#pragma unroll
            for (int j = 0; j < 4; ++j) {
                const int k = (F.lane + 64 * j) * 4;
                const f32x4 gg = *GCP(f32x4, g + k), sc = *GCP(f32x4, mod + b * MODW + sc_off + k), sh = *GCP(f32x4, mod + b * MODW + sh_off + k);
                const f32x4 y = v[r][j] * rstd * gg * (sc + 1.f) + sh;
                v2u w; w.x = pk2(y.x, y.y); w.y = pk2(y.z, y.w); o8[64 * j] = w;
            }
        }
    }
}
__device__ __forceinline__ void phase_norm_mod(const Frame& F, const float* x, const float* g, int sh_off, int sc_off, bf16* H) {
    norm_mod_rows(F, x, g, sh_off, sc_off, H, F.blk * NWAVES + F.wave, M, F.G * NWAVES);
}
__device__ __forceinline__ void phase_nsa_prep(const Frame& F) {
    const ArgsV A = args_view(F); unsigned char* ws = A.ws;
    const GASQ bf16* Z = GCP(bf16, ws + WS_Z);
    const GASQ int* pos = GCP(int, A.in[2]);
    const int gw = F.blk * NWAVES + F.wave, NGW = F.G * NWAVES, lane = F.lane;
    const float invt[8] = {1.0f, 0.1939227432012558f, 0.03760603070259094f, 0.007292664609849453f, 0.0014142135623842478f, 0.00027424818836152554f, 5.3182957344688475e-05f, 1.0313385246263351e-05f};
    float inv = 0.f;
#pragma unroll
    for (int i = 0; i < 8; ++i) inv = ((lane & 7) == i) ? invt[i] : inv;
    const float gq = GCP(float, A.in[9])[lane], gk0 = GCP(float, A.in[10])[lane], gk1 = GCP(float, A.in[10])[64 + lane], gk2 = GCP(float, A.in[10])[128 + lane];
    for (int m = gw; m < M; m += NGW) {
        const int b = m / T, t = m % T;
        const GASQ bf16* zr = Z + (size_t)m * ZLD + ZC_NQ + lane;
        unsigned short zv[20];
#pragma unroll
        for (int v = 0; v < 20; ++v) zv[v] = (v == 14 || v == 15 || v == 18 || v == 19) ? (unsigned short)0 : zr[v * 64];
        const float rev = (float)pos[m] * inv * 0.15915494309189535f;
        const float fr = rev - floorf(rev);
        const float cs = __builtin_amdgcn_cosf(fr), sn = __builtin_amdgcn_sinf(fr);
#pragma unroll
        for (int v = 0; v < 20; ++v) {
            if (v == 14 || v == 15 || v == 18 || v == 19) continue;
            GASQ bf16* dst;
            if (v < 8) dst = GP(bf16, ws + WS_QN) + ((size_t)(b * 8 + v) * T + t) * 64;
            else { const size_t off = v < 10 ? WS_KC : v < 12 ? WS_VC : v < 14 ? WS_KS : WS_KW; dst = GP(bf16, ws + off) + ((size_t)(b * 2 + (v & 1)) * T + t) * 64; }
            if (v == 10 || v == 11) { dst[lane] = zv[v]; continue; }
            const float x = bf2f(zv[v]);
            const float ss = wave_sum(x * x);
            const float gsel = v < 8 ? gq : v < 10 ? gk0 : v < 14 ? gk1 : gk2;
            float y = x * rsqrtf(ss * (1.f / 64.f) + EPS) * gsel;
            const float partner = DPPF(y, 0x128);
            if (lane < 8) y = y * cs - partner * sn; else if (lane < 16) y = y * cs + partner * sn;
            dst[lane] = (bf16)f2bf(v < 8 ? y * 0.18033688011112042f   : y);
        }
    }
    for (int it = gw; it < BSZ * 2 * 2 * 32; it += NGW) {
        const int tb = it & 31, br = (it >> 5) & 1, gi = (it >> 6) & 1, b = it >> 7;
        const GASQ bf16* zr = Z + ((size_t)b * T + tb * 64) * ZLD + (br == 0 ? ZC_VS : ZC_VW) + gi * 64 + lane;
        GASQ bf16* dst = GP(bf16, ws + (br == 0 ? WS_VS : WS_VW)) + ((size_t)(b * 2 + gi) * 64 + lane) * T + tb * 64;
#pragma unroll
        for (int c8 = 0; c8 < 8; ++c8) {
            unsigned w[4];
#pragma unroll
            for (int e = 0; e < 4; ++e) { const unsigned lo = zr[(size_t)(c8 * 8 + 2 * e) * ZLD], hi = zr[(size_t)(c8 * 8 + 2 * e + 1) * ZLD]; w[e] = lo | (hi << 16); }
            *(GASQ v4u*)(dst + c8 * 8) = (v4u){w[0], w[1], w[2], w[3]};
        }
    }
}

constexpr int HG_P = 0, HG_G = 17408, HG_GT = 34816, HG_AM = 53248, HG_ST = 72704  , HG_VT = 66816, HG_TOT = 69120, HG_VEC = 71168;
#define MFMA16(a, b, c) __builtin_amdgcn_mfma_f32_16x16x32_bf16((a), (b), (c), 0, 0, 0)
__device__ __forceinline__ void phase_hg_prep(const Frame& F, float* OUTB) {
    const ArgsV A = args_view(F); const GASQ bf16* Z = GCP(bf16, A.ws + WS_Z);
    const float* lbl = A.in[7];
    GASQ bf16* Pg = GP(bf16, A.ws + WS_H); GASQ bf16* Gg = Pg + (size_t)1024 * 8192;
    GASQ bf16* GTg = GP(bf16, A.ws + WS_HGT); GASQ float* VECg = GP(float, A.ws + WS_HVEC);
    const int tid = F.tid; LAS float* TOT = (LAS float*)(F.lds + HG_TOT);
    const int k = tid & 127, rg = tid >> 7;
#pragma unroll 1
    for (int it = F.blk; it < 1024; it += F.G) {
        const int bh = it >> 5, c = it & 31, b = bh >> 2, h = bh & 3, ch = h * 128 + k;
        const float lb = 1.f / (1.f + expf(lbl[512 + ch] - lbl[ch]));
        const GASQ bf16* zb = Z + ((size_t)b * T + c * 64 + rg * 16) * ZLD + ch;
        unsigned short zf[16], zq[16];
#pragma unroll
        for (int i = 0; i < 16; ++i) { zf[i] = zb[i * ZLD + ZC_HF]; zq[i] = zb[i * ZLD + ZC_HQ]; }
        float cum[16], qv[16], kv[16]; float run = 0.f;
#pragma unroll
        for (int i = 0; i < 16; ++i) {
            const float z1 = bf2f(zf[i]), z2 = bf2f(zq[i]);
            const float sg = __builtin_amdgcn_rcpf(1.f + ex2(-1.4426950408889634f * z1));
            const float f = lb + (1.f - lb) * sg;
            run += __builtin_amdgcn_logf(f); cum[i] = run; kv[i] = 1.f - f;
            qv[i] = z2 * __builtin_amdgcn_rcpf(1.f + ex2(-1.4426950408889634f * z2));
        }
        __syncthreads();
        TOT[rg * 128 + k] = run;
        __syncthreads();
        const float t0 = TOT[k], t1 = TOT[128 + k], t2 = TOT[256 + k], t3 = TOT[384 + k];
        const float e0 = t0 + t1, Bt = e0 + (t2 + t3);
        const float off = (rg == 0) ? 0.f : (rg == 1) ? t0 : (rg == 2) ? e0 : (e0 + t2);
        unsigned gt[8];
#pragma unroll
        for (int i = 0; i < 16; ++i) {
            const float bt = off + cum[i];
            const float p = qv[i] * ex2(bt - e0), g = kv[i] * ex2(e0 - bt);
            const unsigned gb = f2bf(g);
            Pg[((size_t)it * 64 + rg * 16 + i) * 128 + k] = (bf16)f2bf(p);
            Gg[((size_t)it * 64 + rg * 16 + i) * 128 + k] = (bf16)gb;
            if (i & 1) gt[i >> 1] |= gb << 16; else gt[i >> 1] = gb;
        }
        *(GASQ v4u*)(GTg + ((size_t)it * 128 + k) * 64 + rg * 16) = (v4u){gt[0], gt[1], gt[2], gt[3]};
        *(GASQ v4u*)(GTg + ((size_t)it * 128 + k) * 64 + rg * 16 + 8) = (v4u){gt[4], gt[5], gt[6], gt[7]};
        if (rg == 0) { VECg[(size_t)it * 384 + k] = ex2(e0); VECg[(size_t)it * 384 + 128 + k] = ex2(Bt); VECg[(size_t)it * 384 + 256 + k] = ex2(Bt - e0); }
    }
    __syncthreads();
}
__device__ __forceinline__ void phase_hg_scan(const Frame& F, float* OHG) {
    const ArgsV A = args_view(F); const GASQ bf16* Z = GCP(bf16, A.ws + WS_Z);
    const GASQ bf16* Pg = GCP(bf16, A.ws + WS_H); const GASQ bf16* Gg = Pg + (size_t)1024 * 8192;
    const GASQ bf16* GTg = GCP(bf16, A.ws + WS_HGT); const GASQ float* VECg = GCP(float, A.ws + WS_HVEC);
    const int tid = F.tid, lane = F.lane, w = F.wave, fr = lane & 15, fq = lane >> 4;
    LAS unsigned char* L = F.lds;
    LAS float* VEC = (LAS float*)(L + HG_VEC);
#pragma unroll 1
    for (int item = F.blk; item < 256; item += F.G) {
        const int bh = (item & 7) * 4 + (item >> 6), vs = (item >> 3) & 7, b = bh >> 2, h = bh & 3, it0 = bh * 32, oitem = bh * 8 + vs;
        const GASQ bf16* zb = Z + (size_t)b * T * ZLD;
        const unsigned vo = (unsigned)((tid >> 4) * 2 * ZLD + ZC_HI + h * 128 + vs * 16 + (tid & 15));
        const int r0 = tid >> 4, c16 = tid & 15, k0 = tid >> 3, c8 = tid & 7;
        const unsigned pgo = (unsigned)(r0 * 128 + c16 * 8), gto = (unsigned)(k0 * 64 + c8 * 8);
        f32x4 S = {0.f, 0.f, 0.f, 0.f};
        v4u sp[2], sg[2], st[2]; f32x4 sv = {0.f, 0.f, 0.f, 0.f}; unsigned short vr[2];
#define HG_LOAD(cc) do { const size_t itc = (size_t)(it0 + (cc)); \
            sp[0] = *(const GASQ v4u*)(Pg + itc * 8192 + pgo); sp[1] = *(const GASQ v4u*)(Pg + itc * 8192 + 4096 + pgo); \
            sg[0] = *(const GASQ v4u*)(Gg + itc * 8192 + pgo); sg[1] = *(const GASQ v4u*)(Gg + itc * 8192 + 4096 + pgo); \
            st[0] = *(const GASQ v4u*)(GTg + itc * 8192 + gto); st[1] = *(const GASQ v4u*)(GTg + itc * 8192 + 4096 + gto); \
            if (tid < 96) sv = *(const GASQ f32x4*)(VECg + itc * 384 + tid * 4); \
            vr[0] = zb[(unsigned)((cc) * 64 * ZLD) + vo]; vr[1] = zb[(unsigned)((cc) * 64 * ZLD) + vo + ZLD]; } while (0)
        HG_LOAD(0);
#pragma unroll 1
        for (int c = 0; c < 32; ++c) {
            *(LAS v4u*)(L + HG_P + r0 * 272 + c16 * 16) = sp[0]; *(LAS v4u*)(L + HG_P + (r0 + 32) * 272 + c16 * 16) = sp[1];
            *(LAS v4u*)(L + HG_G + r0 * 272 + c16 * 16) = sg[0]; *(LAS v4u*)(L + HG_G + (r0 + 32) * 272 + c16 * 16) = sg[1];
            *(LAS v4u*)(L + HG_GT + k0 * 144 + c8 * 16) = st[0]; *(LAS v4u*)(L + HG_GT + (k0 + 64) * 144 + c8 * 16) = st[1];
            if (tid < 96) *(LAS f32x4*)(VEC + tid * 4) = sv;
            *(LAS unsigned*)(L + HG_VT + (tid & 15) * 144 + (tid >> 4) * 4) = (unsigned)vr[0] | ((unsigned)vr[1] << 16);
            if (c < 31) HG_LOAD(c + 1);
            __syncthreads();
            { const int kk = 16 * w + fq * 4; const f32x4 ev = *(const LAS f32x4*)(VEC + kk);
              v2u sw; sw.x = pk2(ev.x * S.x, ev.y * S.y); sw.y = pk2(ev.z * S.z, ev.w * S.w);
              *(LAS v2u*)(L + HG_ST + fr * 272 + kk * 2) = sw; }
#pragma unroll
            for (int q2 = 0; q2 < 2; ++q2) {
                const int tt = 2 * w + q2, ti = tt >> 2, tj = tt & 3;
                f32x4 acc = {0.f, 0.f, 0.f, 0.f};
#pragma unroll
                for (int ks = 0; ks < 4; ++ks) {
                    const bf16x8 pa = *(const LAS bf16x8*)(L + HG_P + (16 * ti + fr) * 272 + (ks * 32 + fq * 8) * 2);
                    const bf16x8 gb = *(const LAS bf16x8*)(L + HG_G + (16 * tj + fr) * 272 + (ks * 32 + fq * 8) * 2);
                    acc = MFMA16(pa, gb, acc);
                }
                asm volatile("s_nop 7\n\ts_nop 7" ::: "memory");
#pragma unroll
                for (int j = 0; j < 4; ++j) { const bool keep = (tj < ti) || ((tj == ti) && (fq * 4 + j >= fr)); acc[j] = keep ? acc[j] : 0.f; }
#pragma unroll
                for (int j = 0; j < 4; ++j) {
                    const unsigned ab = f2bf(acc[j]), ao = (unsigned)__builtin_amdgcn_update_dpp(0, (int)ab, 0xB1, 0xf, 0xf, false);
                    if ((j & 1) == (fr & 1)) *(LAS unsigned*)(L + HG_AM + (16 * ti + fq * 4 + j) * 144 + (16 * tj + (fr & ~1)) * 2) = (fr & 1) ? (ao | (ab << 16)) : (ab | (ao << 16));
                }
            }
            __syncthreads();
            {
                const int wr = w & 3;
                f32x4 o = {0.f, 0.f, 0.f, 0.f};
                if (w < 4) {
#pragma unroll
                    for (int ks = 0; ks < 4; ++ks) {
                        const bf16x8 pa = *(const LAS bf16x8*)(L + HG_P + (16 * wr + fr) * 272 + (ks * 32 + fq * 8) * 2);
                        const bf16x8 sb = *(const LAS bf16x8*)(L + HG_ST + fr * 272 + (ks * 32 + fq * 8) * 2);
                        o = MFMA16(pa, sb, o);
                    }
#pragma unroll
                    for (int ks = 0; ks < 2; ++ks) {
                        const bf16x8 aa = *(const LAS bf16x8*)(L + HG_AM + (16 * wr + fr) * 144 + (ks * 32 + fq * 8) * 2);
                        const bf16x8 vb = *(const LAS bf16x8*)(L + HG_VT + fr * 144 + (ks * 32 + fq * 8) * 2);
                        o = MFMA16(aa, vb, o);
                    }
                    asm volatile("s_nop 7\n\ts_nop 7" ::: "memory");
                    GASQ float* op = GP(float, OHG + ((size_t)oitem * T + c * 64 + 16 * wr + fq * 4) * 16 + fr);
#pragma unroll
                    for (int j = 0; j < 4; ++j) op[j * 16] = o[j];
                }
            }
            {
                f32x4 u = {0.f, 0.f, 0.f, 0.f};
#pragma unroll
                for (int ks = 0; ks < 2; ++ks) {
                    const bf16x8 ga = *(const LAS bf16x8*)(L + HG_GT + (16 * w + fr) * 144 + (ks * 32 + fq * 8) * 2);
                    const bf16x8 vb = *(const LAS bf16x8*)(L + HG_VT + fr * 144 + (ks * 32 + fq * 8) * 2);
                    u = MFMA16(ga, vb, u);
                }
                asm volatile("s_nop 7\n\ts_nop 7" ::: "memory");
                const int kk = 16 * w + fq * 4; const f32x4 eB = *(const LAS f32x4*)(VEC + 128 + kk), eD = *(const LAS f32x4*)(VEC + 256 + kk);
                S = eB * S + eD * u;
            }
            __syncthreads();
        }
#undef HG_LOAD
    }
}
__device__ __forceinline__ void phase_hg_scan_v1(const Frame& F, float* OHG) {
    const ArgsV A = args_view(F); const bf16* Z = (const bf16*)(A.ws + WS_Z);
    const float* lbl = A.in[7];
    LAS float* Fm = (LAS float*)F.lds;
    LAS float* Qm = (LAS float*)(F.lds + 32768);
    LAS float* Vm = (LAS float*)(F.lds + 65536);
    LAS float* Om = (LAS float*)(F.lds + 69632);
    const int tid = F.tid, lane = F.lane;
    for (int item = F.blk; item < 256; item += F.G) {
        const int b = item >> 5, h = (item >> 3) & 3, vs = item & 7;
        const int col = tid & 127; const int ch = h * 128 + col;
        const float lb = 1.f / (1.f + expf(lbl[512 + ch] - lbl[ch]));
        const int k0 = (lane & 31) * 4, vloc = F.wave * 2 + (lane >> 5);
        float S0 = 0.f, S1 = 0.f, S2 = 0.f, S3 = 0.f;
        for (int c = 0; c < 32; ++c) {
            __syncthreads();
            const size_t mbase = (size_t)b * T + c * 64;
#pragma unroll 4
            for (int i = 0; i < 16; ++i) { const int row = (tid >> 7) + 4 * i; const bf16* zr = Z + (mbase + row) * ZLD;
                const float zf = bf2f(zr[ZC_HF + ch]), zq = bf2f(zr[ZC_HQ + ch]);
                Fm[row * 128 + col] = lb + (1.f - lb) * sigmoidf_(zf); Qm[row * 128 + col] = siluf_(zq); }
#pragma unroll
            for (int i = 0; i < 2; ++i) { const int idx = tid + 512 * i, row = idx >> 4, vc = idx & 15; Vm[idx] = bf2f(Z[(mbase + row) * ZLD + ZC_HI + h * 128 + vs * 16 + vc]); }
            __syncthreads();
            for (int t = 0; t < 64; ++t) {
                const f32x4 f4 = *(const LAS f32x4*)(Fm + t * 128 + k0), q4 = *(const LAS f32x4*)(Qm + t * 128 + k0); const float vt = Vm[t * 16 + vloc];
                S0 = f4.x * S0 + (1.f - f4.x) * vt; S1 = f4.y * S1 + (1.f - f4.y) * vt; S2 = f4.z * S2 + (1.f - f4.z) * vt; S3 = f4.w * S3 + (1.f - f4.w) * vt;
                float p = (q4.x * S0 + q4.y * S1) + (q4.z * S2 + q4.w * S3);
                p += __shfl_xor(p, 1); p += __shfl_xor(p, 2); p += __shfl_xor(p, 4); p += __shfl_xor(p, 8); p += __shfl_xor(p, 16);
                if ((lane & 31) == 0) Om[t * 16 + vloc] = p;
            }
            __syncthreads();
#pragma unroll
            for (int i = 0; i < 2; ++i) { const int idx = tid + 512 * i, row = idx >> 4, vc = idx & 15; OHG[((size_t)item * T + c * 64 + row) * 16 + vc] = Om[idx]; }
        }
        __syncthreads();
    }
}
__device__ __forceinline__ void phase_hg_norm(const Frame& F, const float* OHG) {
    const ArgsV A = args_view(F); const bf16* Z = (const bf16*)(A.ws + WS_Z); bf16* MIX = (bf16*)(A.ws + WS_H);
    const int gw = F.blk * NWAVES + F.wave, NGW = F.G * NWAVES, lane = F.lane;
    const f32x2 ngv = *GCP(f32x2, A.in[8] + 2 * lane);
    for (int m = gw; m < M; m += NGW) {
        f32x2 o[4]; unsigned gz[4];
#pragma unroll
        for (int h = 0; h < 4; ++h) {
            o[h] = *GCP(f32x2, OHG + ((size_t)((m / T) * 32 + h * 8 + (lane >> 3)) * T + (m % T)) * 16 + 2 * (lane & 7));
            gz[h] = *GCP(unsigned, Z + (size_t)m * ZLD + ZC_HG + h * 128 + 2 * lane);
        }
#pragma unroll
        for (int h = 0; h < 4; ++h) {
            const float ss = wave_sum(o[h].x * o[h].x + o[h].y * o[h].y);
            const float r = rsqrtf(ss * (1.f / 128.f) + EPS);
            const float y0 = o[h].x * r * ngv.x * siluf_(bflo(gz[h])), y1 = o[h].y * r * ngv.y * siluf_(bfhi(gz[h]));
            *GP(unsigned, MIX + (size_t)m * D + h * 128 + 2 * lane) = pk2(y0, y1);
        }
    }
}

__device__ __forceinline__ void phase_cmp_finish(const Frame& F, const float* PART) {
    const ArgsV A = args_view(F); const float* c1 = (const float*)(A.ws + WS_C1); const float* w2 = A.in[13]; float* KV = (float*)(A.ws + WS_KVCMP);
    LAS float* hw = (LAS float*)(F.lds + F.wave * 2048);
    const int gw = F.blk * NWAVES + F.wave, NGW = F.G * NWAVES, lane = F.lane;
    GASQ bf16* KVb = GP(bf16, KV);
    for (int R = gw; R < 2048; R += NGW) {
        f32x4 s0 = {0.f, 0.f, 0.f, 0.f}, s1 = {0.f, 0.f, 0.f, 0.f};
#pragma unroll
        for (int kp = 0; kp < 16; ++kp) { s0 += *GCP(f32x4, c1 + (kp * 2 + 0) * 256 + lane * 4); s1 += *GCP(f32x4, c1 + (kp * 2 + 1) * 256 + lane * 4); }
#pragma unroll
        for (int ks = 0; ks < 8; ++ks) { s0 += *GCP(f32x4, PART + ((size_t)ks * 2048 + R) * 256 + lane * 4); s1 += *GCP(f32x4, PART + ((size_t)(8 + ks) * 2048 + R) * 256 + lane * 4); }
        f32x4 h0, h1;
        h0.x = siluf_(s0.x); h0.y = siluf_(s0.y); h0.z = siluf_(s0.z); h0.w = siluf_(s0.w);
        h1.x = siluf_(s1.x); h1.y = siluf_(s1.y); h1.z = siluf_(s1.z); h1.w = siluf_(s1.w);
        *(LAS f32x4*)(hw + lane * 4) = h0; *(LAS f32x4*)(hw + 256 + lane * 4) = h1;
        LDS_FENCE();
        const GASQ float* wp0 = GCP(float, w2 + lane); const GASQ float* wp1 = GCP(float, w2 + (size_t)256 * 64 + lane);
        f32x4 a0 = {0.f, 0.f, 0.f, 0.f}, a1 = {0.f, 0.f, 0.f, 0.f};
#pragma unroll 4
        for (int j4 = 0; j4 < 64; ++j4) {
            const f32x4 h0v = *(const LAS f32x4*)(hw + 4 * j4), h1v = *(const LAS f32x4*)(hw + 256 + 4 * j4);
            const f32x4 w0v = {wp0[(4 * j4) * 64], wp0[(4 * j4 + 1) * 64], wp0[(4 * j4 + 2) * 64], wp0[(4 * j4 + 3) * 64]};
            const f32x4 w1v = {wp1[(4 * j4) * 64], wp1[(4 * j4 + 1) * 64], wp1[(4 * j4 + 2) * 64], wp1[(4 * j4 + 3) * 64]};
            a0 += h0v * w0v; a1 += h1v * w1v;
        }
        float o0 = (a0.x + a0.y) + (a0.z + a0.w), o1 = (a1.x + a1.y) + (a1.z + a1.w);
        if ((R & 127) == 127) { o0 = 0.f; o1 = 0.f; }
        KVb[(size_t)R * 64 + lane] = (bf16)f2bf(o0);
        KVb[(size_t)2048 * 64 + ((size_t)(R >> 7) * 64 + lane) * 128 + (R & 127)] = (bf16)f2bf(o1);
        LDS_FENCE();
    }
}

typedef float f32x16 __attribute__((ext_vector_type(16)));
#define MFMA32(a, b, c) __builtin_amdgcn_mfma_f32_32x32x16_bf16((a), (b), (c), 0, 0, 0)
__device__ __forceinline__ unsigned cvtpk(float lo, float hi) { typedef float f2_t __attribute__((ext_vector_type(2))); typedef __bf16 b2_t __attribute__((ext_vector_type(2)));
    f2_t v = {lo, hi}; b2_t r = __builtin_convertvector(v, b2_t); return __builtin_bit_cast(unsigned, r); }
constexpr int AT_KB = 0, AT_VB = 18432, AT_IMP = 36864, AT_SEL = 69632, AT_OUT = 69888  , AT_ROW = 144;

template <int MM>
__device__ __forceinline__ void attn_block_mfma(const LAS unsigned char* Kb, const LAS unsigned char* Vb, const bf16x8 (&qf)[4], f32x16 (&O)[2], float& m, float& l, int lane, bool selbit, int tl) {
    const int r32 = lane & 31, h = lane >> 5;
    f32x16 S[2];
#pragma unroll
    for (int kt = 0; kt < 2; ++kt) {
#pragma unroll
        for (int i = 0; i < 16; ++i) S[kt][i] = 0.f;
#pragma unroll
        for (int ks = 0; ks < 4; ++ks) { const bf16x8 kf = *(const LAS bf16x8*)(Kb + (kt * 32 + r32) * AT_ROW + (ks * 16 + h * 8) * 2); S[kt] = MFMA32(kf, qf[ks], S[kt]); }
        __builtin_amdgcn_sched_barrier(0);
    }
    float mx = -INFINITY;
#pragma unroll
    for (int kt = 0; kt < 2; ++kt)
#pragma unroll
        for (int i = 0; i < 16; ++i) { const int kl = kt * 32 + 8 * (i >> 2) + 4 * h + (i & 3);
            bool ok = selbit; if (MM == 1) ok = ok && (kl <= tl); if (MM == 2) ok = ok && (kl > tl);
            const float s = ok ? S[kt][i] : -INFINITY; S[kt][i] = s; mx = fmaxf(mx, s); }
    mx = fmaxf(mx, xor32f(mx, lane));
    const float mn = fmaxf(m, mx), alpha = ex2(m - mn); m = mn;
    float rs = 0.f;
#pragma unroll
    for (int kt = 0; kt < 2; ++kt)
#pragma unroll
        for (int i = 0; i < 16; ++i) { const float p = ex2(S[kt][i] - mn); S[kt][i] = p; rs += p; }
    l = l * alpha + rs;
#pragma unroll
    for (int i = 0; i < 16; ++i) { O[0][i] *= alpha; O[1][i] *= alpha; }
    bf16x8 pf[4];
#pragma unroll
    for (int s = 0; s < 4; ++s) { const int kt = s >> 1, bb = 8 * (s & 1);
        v4u w; w.x = cvtpk(S[kt][bb + 0], S[kt][bb + 1]); w.y = cvtpk(S[kt][bb + 2], S[kt][bb + 3]); w.z = cvtpk(S[kt][bb + 4], S[kt][bb + 5]); w.w = cvtpk(S[kt][bb + 6], S[kt][bb + 7]);
        pf[s] = __builtin_bit_cast(bf16x8, w); }
#pragma unroll
    for (int dt = 0; dt < 2; ++dt)
#pragma unroll
        for (int s = 0; s < 4; ++s) { const LAS unsigned char* vp = Vb + (dt * 32 + r32) * AT_ROW + (16 * s + 4 * h) * 2;
            const v2u lo = *(const LAS v2u*)vp, hi = *(const LAS v2u*)(vp + 16);
            const v4u w = {lo.x, lo.y, hi.x, hi.y};
            O[dt] = MFMA32(__builtin_bit_cast(bf16x8, w), pf[s], O[dt]); if (s & 1) __builtin_amdgcn_sched_barrier(0); }
}

template <bool WIN>
__device__ __forceinline__ void attn_branch(const Frame& F, const bf16* Kx, const bf16* VTx, size_t bg, int qb, int jlo, int jhi, const bf16x8 (&qf)[4], f32x16 (&O)[2], float& m, float& l, unsigned mysel, int tl) {
    const int tid = F.tid, lane = F.lane, row = tid >> 3, ch = tid & 7;
    const GASQ bf16* kg = (const GASQ bf16*)(Kx + bg * T * 64); const GASQ bf16* vg = (const GASQ bf16*)(VTx + bg * 64 * T);
    const unsigned ko = (unsigned)(row * 64 + ch * 8), vo = (unsigned)(row * T + ch * 8);
    const int so = row * AT_ROW + ch * 16;
    v4u kr = *(const GASQ v4u*)(kg + (jlo * 4096 + ko)), vr = *(const GASQ v4u*)(vg + (jlo * 64 + vo));
    *(LAS v4u*)(F.lds + AT_KB + so) = kr; *(LAS v4u*)(F.lds + AT_VB + so) = vr;
    __syncthreads();
    int buf = 0;
    for (int jb = jlo; jb <= jhi; ++jb) {
        const bool more = jb < jhi;
        if (more) { kr = *(const GASQ v4u*)(kg + ((jb + 1) * 4096 + ko)); vr = *(const GASQ v4u*)(vg + ((jb + 1) * 64 + vo)); }
        const LAS unsigned char* Kb = F.lds + AT_KB + buf * 9216; const LAS unsigned char* Vb = F.lds + AT_VB + buf * 9216;
        const bool selbit = WIN ? true : (((mysel >> jb) & 1u) != 0u);
        if (jb == qb) attn_block_mfma<1>(Kb, Vb, qf, O, m, l, lane, selbit, tl);
        else if (WIN && jb == qb - 8) attn_block_mfma<2>(Kb, Vb, qf, O, m, l, lane, selbit, tl);
        else attn_block_mfma<0>(Kb, Vb, qf, O, m, l, lane, selbit, tl);
        buf ^= 1;
        if (more) { *(LAS v4u*)(F.lds + AT_KB + buf * 9216 + so) = kr; *(LAS v4u*)(F.lds + AT_VB + buf * 9216 + so) = vr; }
        __syncthreads();
    }
}

template <class Bar>
__device__ __forceinline__ void phase_nsa_attn(const Frame& F, const Bar* pending) {
    const ArgsV A = args_view(F); unsigned char* ws = A.ws;
    const bf16* Z = (const bf16*)(ws + WS_Z); const bf16* QN = (const bf16*)(ws + WS_QN);
    const bf16* KS = (const bf16*)(ws + WS_KS); const bf16* VST = (const bf16*)(ws + WS_VS); const bf16* KW = (const bf16*)(ws + WS_KW); const bf16* VWT = (const bf16*)(ws + WS_VW);
    const bf16* KC = (const bf16*)(ws + WS_KVCMP); const bf16* VCT = KC + (size_t)2048 * 64; bf16* MIX = (bf16*)(ws + WS_H);
    const int r = F.wave >> 1, tb = F.wave & 1;
    LAS float* IMP = (LAS float*)(F.lds + AT_IMP);
    LAS unsigned* SEL = (LAS unsigned*)(F.lds + AT_SEL);
    bool waiting = (pending != nullptr);
#pragma unroll 1
    for (int item = F.blk; item < 256; item += F.G) {
        const size_t bg = (size_t)((item & 7) * 2 + (item >> 7)); const int b = (int)(bg >> 1), g = (int)(bg & 1), pi = (item >> 3) & 15;
#pragma unroll 1
        for (int u2 = 0; u2 < 2; ++u2) {
            Frame Fu = F; Fu.lane = opaque_lane(); Fu.tid = F.wave * 64 + Fu.lane;
            const int tid = Fu.tid, lane = Fu.lane, r32 = lane & 31, h = lane >> 5, tl = tb * 32 + r32;
            const int qb = u2 ? (31 - pi) : pi;
            const int t = qb * 64 + tl; const size_t mrow = (size_t)b * T + t;
            bf16x8 qf[4];
            { const GASQ bf16* qp = (const GASQ bf16*)(QN + ((size_t)(b * 8 + g * 4 + r) * T + t) * 64 + h * 8);
#pragma unroll
              for (int ks = 0; ks < 4; ++ks) qf[ks] = *(const GASQ bf16x8*)(qp + ks * 16); }
            const GASQ bf16* gz = (const GASQ bf16*)(Z + mrow * ZLD + ZC_NG + (g * 4 + r) * 3);
            const float g0 = sigmoidf_(bf2f(gz[0])), g1 = sigmoidf_(bf2f(gz[1])), g2 = sigmoidf_(bf2f(gz[2]));
            LAS float* OL = (LAS float*)(F.lds + AT_OUT + F.wave * 8192) + lane;
            {
                f32x16 O[2]; float m = -1e30f, l = 0.f;
#pragma unroll
                for (int i = 0; i < 16; ++i) { O[0][i] = 0.f; O[1][i] = 0.f; }
                __syncthreads();
                attn_branch<true>(Fu, KW, VWT, bg, qb, qb >= 8 ? qb - 8 : 0, qb, qf, O, m, l, 0xffffffffu, tl);
                l += xor32f(l, lane);
                const float sc = g2 / l;
#pragma unroll
                for (int i = 0; i < 16; ++i) { OL[i * 64] = sc * O[0][i]; OL[(16 + i) * 64] = sc * O[1][i]; }
            }
            if (waiting) { xcd_wait(*pending); waiting = false; }
            __syncthreads();
            { const int row = tid >> 3, ch = tid & 7;
              const GASQ bf16* kcb = (const GASQ bf16*)(KC + bg * 8192); const GASQ bf16* vcb = (const GASQ bf16*)(VCT + bg * 8192);
#pragma unroll
              for (int i = 0; i < 2; ++i) { const v4u v = *(const GASQ v4u*)(kcb + (unsigned)((row + 64 * i) * 64 + ch * 8)); *(LAS v4u*)(F.lds + AT_KB + (row + 64 * i) * AT_ROW + ch * 16) = v; }
#pragma unroll
              for (int i = 0; i < 2; ++i) { const v4u v = *(const GASQ v4u*)(vcb + (unsigned)(row * 128 + (ch + 8 * i) * 8)); *(LAS v4u*)(F.lds + AT_VB + row * 272 + (ch + 8 * i) * 16) = v; } }
            __syncthreads();
            {
                const int nvalid = (t >= 31) ? (((t - 31) >> 4) + 1) : 0;
                float mx = -1e30f;
#pragma unroll
                for (int kt = 0; kt < 4; ++kt) {
                    f32x16 S;
#pragma unroll
                    for (int i = 0; i < 16; ++i) S[i] = 0.f;
#pragma unroll
                    for (int ks = 0; ks < 4; ++ks) { const bf16x8 kf = *(const LAS bf16x8*)(F.lds + AT_KB + (kt * 32 + r32) * AT_ROW + (ks * 16 + h * 8) * 2); S = MFMA32(kf, qf[ks], S); }
#pragma unroll
                    for (int i = 0; i < 16; ++i) { const int n = kt * 32 + 8 * (i >> 2) + 4 * h + (i & 3); mx = fmaxf(mx, (n < nvalid) ? S[i] : -INFINITY); }
                    __builtin_amdgcn_sched_barrier(0);
                }
                mx = fmaxf(mx, xor32f(mx, lane));
                f32x16 Oc[2];
#pragma unroll
                for (int i = 0; i < 16; ++i) { Oc[0][i] = 0.f; Oc[1][i] = 0.f; }
                float impv[16]; float rs = 0.f, yprev = 0.f;
#pragma unroll
                for (int kt = 0; kt < 4; ++kt) {
                    f32x16 S;
#pragma unroll
                    for (int i = 0; i < 16; ++i) S[i] = 0.f;
#pragma unroll
                    for (int ks = 0; ks < 4; ++ks) { const bf16x8 kf = *(const LAS bf16x8*)(F.lds + AT_KB + (kt * 32 + r32) * AT_ROW + (ks * 16 + h * 8) * 2); S = MFMA32(kf, qf[ks], S); }
#pragma unroll
                    for (int i = 0; i < 16; ++i) { const int n = kt * 32 + 8 * (i >> 2) + 4 * h + (i & 3); const float p = (n < nvalid) ? ex2(S[i] - mx) : 0.f; S[i] = p; rs += p; }
#pragma unroll
                    for (int a = 0; a < 4; ++a) {
                        const float x = S[4 * a + 3], y = xor32f(x, lane);
                        impv[kt * 4 + a] = (S[4 * a] + S[4 * a + 1] + S[4 * a + 2] + 0.5f * x) + 0.5f * (h ? y : yprev);
                        yprev = y;
                    }
#pragma unroll
                    for (int s2 = 0; s2 < 2; ++s2) { const int s = kt * 2 + s2, bb = 8 * s2;
                        v4u w; w.x = cvtpk(S[bb + 0], S[bb + 1]); w.y = cvtpk(S[bb + 2], S[bb + 3]); w.z = cvtpk(S[bb + 4], S[bb + 5]); w.w = cvtpk(S[bb + 6], S[bb + 7]);
                        const bf16x8 pf = __builtin_bit_cast(bf16x8, w);
#pragma unroll
                        for (int dt = 0; dt < 2; ++dt) { const LAS unsigned char* vp = F.lds + AT_VB + (dt * 32 + r32) * 272 + (16 * s + 4 * h) * 2;
                            const v2u lo = *(const LAS v2u*)vp, hi = *(const LAS v2u*)(vp + 16);
                            const v4u wv = {lo.x, lo.y, hi.x, hi.y};
                            Oc[dt] = MFMA32(__builtin_bit_cast(bf16x8, wv), pf, Oc[dt]); } }
                    __builtin_amdgcn_sched_barrier(0);
                }
                rs += xor32f(rs, lane);
                const float inv = rs > 0.f ? 1.f / rs : 0.f;
#pragma unroll
                for (int q = 0; q < 16; ++q) IMP[(r * 64 + tl) * 32 + 8 * (q >> 2) + 2 * (q & 3) + h] = impv[q] * inv;
                const float gi = g0 * inv;
#pragma unroll
                for (int i = 0; i < 16; ++i) { OL[i * 64] += gi * Oc[0][i]; OL[(16 + i) * 64] += gi * Oc[1][i]; }
            }
            __syncthreads();
#pragma unroll 1
            for (int i = 0; i < 4; ++i) {
                const int idx = tid + 512 * i, tok = idx >> 5, j = idx & 31;
                const float v = ((IMP[(0 * 64 + tok) * 32 + j] + IMP[(1 * 64 + tok) * 32 + j]) + IMP[(2 * 64 + tok) * 32 + j]) + IMP[(3 * 64 + tok) * 32 + j];
                const bool causal = j <= qb, forced = (j == 0) || (j == qb) || (j == qb - 1);
                const float val = causal ? (forced ? INFINITY : v) : -1.f;
                int rank = 0;
#pragma unroll
                for (int i2 = 0; i2 < 32; ++i2) { const int vb = __builtin_bit_cast(int, val); const float vlo = __builtin_bit_cast(float, __builtin_amdgcn_readlane(vb, i2)), vhi = __builtin_bit_cast(float, __builtin_amdgcn_readlane(vb, 32 + i2));
                    const float vi = (lane < 32) ? vlo : vhi; rank += ((vi > val) || (vi == val && i2 < j)) ? 1 : 0; }
                const unsigned long long bal = __ballot((rank < 16) && causal);
                if (lane == 0) SEL[tok] = (unsigned)bal;
                if (lane == 32) SEL[tok] = (unsigned)(bal >> 32);
            }
            __syncthreads();
            const unsigned mysel = SEL[tl];
            {
                f32x16 O[2]; float m = -1e30f, l = 0.f;
#pragma unroll
                for (int i = 0; i < 16; ++i) { O[0][i] = 0.f; O[1][i] = 0.f; }
                attn_branch<false>(Fu, KS, VST, bg, qb, 0, qb, qf, O, m, l, mysel, tl);
                l += xor32f(l, lane);
                const float sc = g1 / l;
                GASQ bf16* op = (GASQ bf16*)(MIX + mrow * D + 512 + (g * 4 + r) * 64 + 4 * h);
#pragma unroll
                for (int dt = 0; dt < 2; ++dt)
#pragma unroll
                    for (int a = 0; a < 4; ++a) { float o[4];
#pragma unroll
                        for (int c = 0; c < 4; ++c) o[c] = OL[(dt * 16 + 4 * a + c) * 64] + sc * O[dt][4 * a + c];
                        v2u w; w.x = cvtpk(o[0], o[1]); w.y = cvtpk(o[2], o[3]); *(GASQ v2u*)(op + dt * 32 + 8 * a) = w; }
            }
        }
    }
    if (waiting) xcd_wait(*pending);
}

__device__ __forceinline__ void conv_seam_rows(const Frame& F, int pm) {
    const ArgsV A = args_view(F); GASQ bf16* ACT = GP(bf16, A.ws + WS_U); const GASQ bf16* HEAD = GCP(bf16, A.ws + WS_HALO); const GASQ bf16* TAIL = HEAD + (size_t)64 * 2 * FF2;
    const GASQ float* cw = GCP(float, A.in[17]); const GASQ float* cb = GCP(float, A.in[18]);
#pragma unroll
    for (int it6 = 0; it6 < 6; ++it6) {
        const int c = F.tid + it6 * NTHR; if (c >= FF) break;
        const GASQ bf16* h0 = HEAD + ((size_t)pm * 2) * FF2; const GASQ bf16* h1 = h0 + FF2;
        const float a0 = bf2f(h0[c]), a1 = bf2f(h1[c]), v0 = bf2f(h0[FF + c]), v1 = bf2f(h1[FF + c]);
        float ta0 = 0.f, ta1 = 0.f, tv0 = 0.f, tv1 = 0.f;
        if (pm & 7) { const GASQ bf16* t0 = TAIL + ((size_t)(pm - 1) * 2) * FF2; const GASQ bf16* t1 = t0 + FF2; ta0 = bf2f(t0[c]); ta1 = bf2f(t1[c]); tv0 = bf2f(t0[FF + c]); tv1 = bf2f(t1[FF + c]); }
        const float wa0 = cw[c], wa1 = cw[FF2 + c], wa2 = cw[2 * FF2 + c], ba = cb[c], wv0 = cw[FF + c], wv1 = cw[FF2 + FF + c], wv2 = cw[2 * FF2 + FF + c], bv = cb[FF + c];
        const float ya0 = ba + wa0 * ta0 + wa1 * ta1 + wa2 * a0, yv0 = bv + wv0 * tv0 + wv1 * tv1 + wv2 * v0;
        const float ya1 = ba + wa0 * ta1 + wa1 * a0 + wa2 * a1, yv1 = bv + wv0 * tv1 + wv1 * v0 + wv2 * v1;
        ACT[((size_t)pm * 256) * FF + c] = (bf16)f2bf(siluf_(ya0) * yv0);
        ACT[((size_t)pm * 256 + 1) * FF + c] = (bf16)f2bf(siluf_(ya1) * yv1);
    }
    asm volatile("s_waitcnt vmcnt(0)" ::: "memory");
    __syncthreads();
}

#define XB_TMO      128
#define XB_XCNT(j)  (256  + 64 * (j))
#define XB_XSUB(j)  (1280 + 64 * (j))
#define XB_XGEN(j)  (2304 + 64 * (j))
#define XB_TOP      3328
#define XB_TOPGEN   3392
#define XCD_BAR_WORDS 3456
#define XB_SPIN_CAP (1u << 18)

__device__ __forceinline__ unsigned xb_ld(unsigned* p)              { return __hip_atomic_load(p, __ATOMIC_RELAXED, __HIP_MEMORY_SCOPE_AGENT); }
__device__ __forceinline__ unsigned xb_add(unsigned* p, unsigned v) { return __hip_atomic_fetch_add(p, v, __ATOMIC_RELAXED, __HIP_MEMORY_SCOPE_AGENT); }
__device__ __forceinline__ unsigned xb_xcc_id() { return (unsigned)__builtin_amdgcn_s_getreg((3 << 11) | 20) & 0xFu; }
#define XB_SPIN(cond, bar) do { unsigned _sp = 0; while (cond) { __builtin_amdgcn_s_sleep(1); \
    if ((++_sp & 255u) == 0u) { if (xb_ld(&(bar)[XB_TMO])) break; if (_sp > XB_SPIN_CAP) { atomicAdd(&(bar)[XB_TMO], 1u); break; } } } } while (0)

struct XcdBarrier {
    unsigned* bar; unsigned x;
    volatile LAS unsigned* st;
};

__device__ __forceinline__ XcdBarrier xcd_barrier_post(unsigned* bar, volatile LAS unsigned* st) {
    XcdBarrier b; b.bar = bar; b.x = xb_xcc_id(); b.st = st;
    if (threadIdx.x == 0) (void)xb_add(&bar[XB_XCNT(b.x)], 1u);
    return b;
}
__device__ __forceinline__ void xcd_barrier_complete(unsigned* bar, unsigned x, unsigned& nloc, unsigned& nx) {
    const unsigned G = gridDim.x * gridDim.y * gridDim.z;
    unsigned sum, cnt, mine, sp = 0u;
    for (;;) {
        sum = 0u; cnt = 0u; mine = 0u;
#pragma unroll
        for (unsigned j = 0; j < 16; ++j) { const unsigned c = xb_ld(&bar[XB_XCNT(j)]); sum += c; cnt += (c > 0u) ? 1u : 0u; mine = (j == x) ? c : mine; }
        if (sum == G) break;
        __builtin_amdgcn_s_sleep(1);
        if ((++sp & 255u) == 0u) { if (xb_ld(&bar[XB_TMO])) break; if (sp > XB_SPIN_CAP) { atomicAdd(&bar[XB_TMO], 1u); break; } }
    }
    nloc = mine > 0u ? mine : 1u; nx = cnt > 0u ? cnt : 1u;
}

__device__ __forceinline__ void xcd_arrive(const XcdBarrier& b) {
    asm volatile("s_waitcnt vmcnt(0)" ::: "memory");
    __syncthreads();
    if (threadIdx.x == 0) {
        unsigned* bar = b.bar;
        __builtin_amdgcn_s_waitcnt(0);
        unsigned nloc = b.st[0], nx = b.st[1];
        if (nloc == 0u) { xcd_barrier_complete(bar, b.x, nloc, nx); b.st[0] = nloc; b.st[1] = nx; }
        const unsigned old = xb_add(&bar[XB_XSUB(b.x)], 1u);
        const unsigned gen = old / nloc;
        if (old + 1u == (gen + 1u) * nloc) {
            __builtin_amdgcn_fence(__ATOMIC_RELEASE, "agent");
            asm volatile("s_waitcnt vmcnt(0)" ::: "memory");
            const unsigned og = xb_add(&bar[XB_TOP], 1u);
            const unsigned tg = og / nx;
            if (og + 1u == (tg + 1u) * nx) xb_add(&bar[XB_TOPGEN], 1u);
        }
        b.st[2] = gen;
    }
}
__device__ __forceinline__ void xcd_wait(const XcdBarrier& b) {
    if (threadIdx.x == 0) {
        unsigned* bar = b.bar; const unsigned gen = b.st[2];
        XB_SPIN(xb_ld(&bar[XB_TOPGEN]) == gen, bar);
        __builtin_amdgcn_fence(__ATOMIC_ACQUIRE, "agent");
        asm volatile("s_waitcnt vmcnt(0)" ::: "memory");
    }
    __syncthreads();
}
__device__ __forceinline__ void xcd_barrier(const XcdBarrier& b) { xcd_arrive(b); xcd_wait(b); }


__global__ void __launch_bounds__(NTHR, 2) fwd_megakernel(Args args) {
    extern __shared__ __attribute__((aligned(16))) unsigned char lds_raw[];
    cg::grid_group grid = cg::this_grid();
    Frame F;
    F.lds = (LAS unsigned char*)lds_raw;
    F.wave = __builtin_amdgcn_readfirstlane((int)(threadIdx.x >> 6)); F.lane = opaque_lane(); F.tid = F.wave * 64 + F.lane;
    F.G = gridDim.x; F.blk = blockIdx.x;
    if (F.tid < 22) { const unsigned long long p = (F.tid < 20) ? (unsigned long long)args.in[F.tid < 20 ? F.tid : 0] : (F.tid == 20 ? (unsigned long long)args.out : (unsigned long long)args.ws);
        LAS unsigned* tab = (LAS unsigned*)(F.lds + ARGTAB); tab[2 * F.tid] = (unsigned)p; tab[2 * F.tid + 1] = (unsigned)(p >> 32); }
    if (F.tid == 0) { ((LAS unsigned*)(F.lds + ARGTAB + 192))[0] = 0u; ((LAS unsigned*)(F.lds + ARGTAB + 192))[1] = 0u; ((LAS unsigned*)(F.lds + ARGTAB + 192))[2] = 0u; }
    __syncthreads();
    const XcdBarrier xbar = xcd_barrier_post((unsigned*)(args.ws + WS_BAR), (volatile LAS unsigned*)(F.lds + ARGTAB + 192));
#define WSP ((unsigned char*)argp(F, 21))
#define OUTP ((float*)argp(F, 20))
#define PARTP (OUTP + (size_t)8 * 1024 * 1024)
    LAS unsigned char* glds = (LAS unsigned char*)lds_raw;
#define GRID_SYNC_CG() do { __builtin_amdgcn_fence(__ATOMIC_RELEASE, "agent"); asm volatile("s_waitcnt vmcnt(0) lgkmcnt(0)" ::: "memory"); grid.sync(); \
        __builtin_amdgcn_fence(__ATOMIC_ACQUIRE, "agent"); asm volatile("s_waitcnt vmcnt(0)" ::: "memory"); } while (0)
#define GRID_SYNC() xcd_barrier(xbar)

    phase0(phase_frame(F));
    xcd_arrive(xbar);
    if (gridDim.x == 0x7fffffffu) GRID_SYNC_CG();
    phase0b(phase_frame(F));
    xcd_wait(xbar);
    phase_norm_mod(phase_frame(F), argp(F, 0), argp(F, 5), 0, 1024, (bf16*)(WSP + WS_H));
    GRID_SYNC();
    {
        unsigned char* ws = WSP;
        pg8::Gemm g{(const bf16*)(ws + WS_H), (const bf16*)(ws + WS_WIN), 1024, 1024, 1024, 0};
        pg8::StaticOrder S; S.init(64, 14, F.G, F.blk, (size_t)256 * 1024 * 2, (size_t)256 * 1024 * 2);
        pg8::EpiBf16 E{(bf16*)(ws + WS_Z), ZLD, nullptr};
        pg8::gemm_phase<pg8::EpiBf16, pg8::StaticOrder, true>(glds, g, S, E, F.wave);
    }
    phase_c1(phase_frame(F), (64 * 14) % F.G);
    GRID_SYNC();
    phase_nsa_prep(phase_frame(F));
    phase_hg_prep(phase_frame(F), OUTP);
    GRID_SYNC();
    phase_hg_scan(phase_frame(F), OUTP);
    __syncthreads();
    {
        unsigned char* ws = WSP;
        pg8::Gemm g{(const bf16*)(ws + WS_KC), (const bf16*)(ws + WS_WC1), 256, 1024, 2048, 0};
        pg8::CmpOrder S{F.G, F.blk, (size_t)(WS_VC - WS_KC)};
        pg8::EpiPart E{PARTP};
        pg8::gemm_phase<pg8::EpiPart, pg8::CmpOrder, false>(glds, g, S, E, F.wave);
    }
    GRID_SYNC();
    phase_hg_norm(phase_frame(F), OUTP);
    phase_cmp_finish(phase_frame(F), PARTP);
    xcd_arrive(xbar);
    phase_nsa_attn(phase_frame(F), &xbar);
    GRID_SYNC();
    {
        unsigned char* ws = WSP;
        pg8::Gemm g{(const bf16*)(ws + WS_H), (const bf16*)(ws + WS_WOUT), 1024, 1024, 1024, 0};
        pg8::StaticOrder S; S.init(64, 4, F.G, F.blk, (size_t)256 * 1024 * 2, (size_t)256 * 1024 * 2);
        pg8::EpiRes E{argp(F, 0), OUTP, (const float*)(ws + WS_MOD) + 2048};
        pg8::gemm_phase<pg8::EpiRes, pg8::StaticOrder, true>(glds, g, S, E, F.wave);
    }
    if (F.G == 256) {
        pg8::StaticOrder S; S.init(64, 4, F.G, F.blk, 0, 0); pg8::Unit u0; (void)S.next(0, u0);
        unsigned* pc = (unsigned*)(WSP + WS_BAR) + 4096 + 64 * u0.pm;
        asm volatile("s_waitcnt vmcnt(0)" ::: "memory");
        __syncthreads();
        if (F.tid == 0) {
            __builtin_amdgcn_fence(__ATOMIC_RELEASE, "agent"); asm volatile("s_waitcnt vmcnt(0)" ::: "memory");
            (void)__hip_atomic_fetch_add(pc, 1u, __ATOMIC_RELAXED, __HIP_MEMORY_SCOPE_AGENT);
            unsigned spins = 0;
            while (__hip_atomic_load(pc, __ATOMIC_RELAXED, __HIP_MEMORY_SCOPE_AGENT) < 4u && ++spins < (1u << 22)) __builtin_amdgcn_s_sleep(1);
            __builtin_amdgcn_fence(__ATOMIC_ACQUIRE, "agent"); asm volatile("s_waitcnt vmcnt(0)" ::: "memory");
        }
        __syncthreads();
        const Frame Fp = phase_frame(F);
        norm_mod_rows(Fp, OUTP, argp(F, 15), 3072, 4096, (bf16*)(WSP + WS_H), u0.pm * 256 + u0.pn * 64 + Fp.wave, u0.pm * 256 + u0.pn * 64 + 64, NWAVES);
    } else {
        GRID_SYNC();
        phase_norm_mod(phase_frame(F), OUTP, argp(F, 15), 3072, 4096, (bf16*)(WSP + WS_H));
    }
    GRID_SYNC();
    {
        unsigned char* ws = WSP;
        pg8::Gemm g{(const bf16*)(ws + WS_H), (const bf16*)(ws + WS_WUP), 1024, 1024, 1024, 0};
        pg8::StaticOrder S; S.init(64, 22, F.G, F.blk, (size_t)256 * 1024 * 2, (size_t)256 * 1024 * 2);
        pg8::EpiConv E{(bf16*)(ws + WS_U), (bf16*)(ws + WS_HALO), (bf16*)(ws + WS_HALO) + (size_t)64 * 2 * FF2, argp(F, 17), argp(F, 18), (LAS float*)(glds + 131072)};
        pg8::gemm_phase<pg8::EpiConv, pg8::StaticOrder, true>(glds, g, S, E, F.wave);
    }
    GRID_SYNC();
    {
        unsigned char* ws = WSP;
        pg8::Gemm g{(const bf16*)(ws + WS_U), (const bf16*)(ws + WS_WDN), FF, FF, FF, 0};
        pg8::StaticOrder S; S.init(64, 4, F.G, F.blk, (size_t)256 * FF * 2, (size_t)256 * FF * 2);
        { pg8::Unit u0; for (int i = 0; S.next(i, u0); ++i) conv_seam_rows(phase_frame(F), u0.pm); }
        pg8::EpiRes E{OUTP, OUTP, (const float*)(ws + WS_MOD) + 5120};
        pg8::gemm_phase<pg8::EpiRes, pg8::StaticOrder, true>(glds, g, S, E, F.wave);
    }
}

extern "C" void kernel_launch(void* const* d_in, const int* in_sizes, int n_in, void* d_out, int out_size, void* d_ws, size_t ws_size, hipStream_t stream) {
    static int grid = 0;
    if (grid == 0) {
        if (n_in != 20 || out_size != M * D || ws_size < WS_END) { fprintf(stderr, "kernel_launch: unexpected shapes (n_in %d out %d ws %zu)\n", n_in, out_size, ws_size); grid = -1; return; }
        int dev = 0, cus = 0, per_cu = 0;
        (void)hipGetDevice(&dev);
        (void)hipDeviceGetAttribute(&cus, hipDeviceAttributeMultiprocessorCount, dev);
        if (hipFuncSetAttribute((const void*)fwd_megakernel, hipFuncAttributeMaxDynamicSharedMemorySize, LDS_BYTES) != hipSuccess) { fprintf(stderr, "kernel_launch: hipFuncSetAttribute failed\n"); }
        if (hipOccupancyMaxActiveBlocksPerMultiprocessor(&per_cu, (const void*)fwd_megakernel, NTHR, LDS_BYTES) != hipSuccess || per_cu < 1) { fprintf(stderr, "kernel_launch: occupancy query says %d\n", per_cu); per_cu = 1; }
        (void)hipGetLastError();
        grid = cus * 1;
        if (grid > 256) grid = 256;
    }
    if (grid < 0) return;
    (void)hipMemsetAsync((char*)d_ws + WS_BAR, 0, 32768, stream);
    Args a{};
    for (int i = 0; i < 20; ++i) a.in[i] = (const float*)d_in[i];
    a.out = (float*)d_out; a.ws = (unsigned char*)d_ws;
    void* kargs[] = {&a};
    hipError_t e = hipLaunchCooperativeKernel((const void*)fwd_megakernel, dim3(grid), dim3(NTHR), kargs, LDS_BYTES, stream);
    if (e != hipSuccess) fprintf(stderr, "cooperative launch failed: %s (grid %d)\n", hipGetErrorString(e), grid);
}
```

```cpp
#include <hip/hip_runtime.h>
#include <hip/hip_cooperative_groups.h>
#include <cstdio>
#include <cstdint>
namespace cg = cooperative_groups;

__device__ __forceinline__ int opaque_lane() { unsigned ones = ~0u; asm volatile("" : "+s"(ones)); return (int)__builtin_amdgcn_mbcnt_hi(ones, __builtin_amdgcn_mbcnt_lo(ones, 0u)); }
namespace pg8 {
#define PG8_LAS __attribute__((address_space(3)))
typedef unsigned short bf16_t;
typedef short bf16x8 __attribute__((ext_vector_type(8)));
typedef float f32x4 __attribute__((ext_vector_type(4)));
typedef unsigned u32x4 __attribute__((ext_vector_type(4)));
constexpr int BM = 256, BK = 64, HALF = 128, HTB = HALF * BK * 2, STAGE_BYTES = 8 * HTB, NXCD = 8, WGM = 8;

__host__ __device__ __forceinline__ int lds_byte(int r, int c) { const int st = (r >> 4) * 2 + (c >> 5), rr = r & 15, cc = c & 31, ob = rr * 64 + cc * 2; return st * 1024 + (ob ^ (((ob >> 9) & 1) << 5)); }
__host__ __device__ __forceinline__ void stage_rc(int b, int& R, int& C) { const int st = b / 1024, sb = b % 1024, swz = sb ^ (((sb >> 9) & 1) << 5); R = (st >> 1) * 16 + swz / 64; C = (st & 1) * 32 + (swz % 64) / 2; }
__host__ __device__ __forceinline__ int perm32(int rho) { const int n = rho >> 4, i = rho & 15; return 8 * (i >> 2) + 4 * n + (i & 3); }

struct Unit { int pm, pn, z, pad; size_t aoff, boff; };
struct Gemm { const bf16_t* A; const bf16_t* Bt; int K, lda, ldb, pad; };

struct StaticOrder {
    int nM, nN, nwg, G, c; size_t tsA, tsB;
    __device__ void init(int nM_, int nN_, int G_, int c_, size_t tsA_, size_t tsB_) { nM = nM_; nN = nN_; nwg = nM * nN; G = G_; c = c_; tsA = tsA_; tsB = tsB_; }
    __device__ bool next(int i, Unit& u) const {
        const long L = (long)i * G + c; if (L >= nwg) return false;
        int wgid = (int)L; { const int q = nwg / NXCD, r = nwg % NXCD, xcd = wgid % NXCD, off = wgid / NXCD; wgid = (xcd < r ? xcd * (q + 1) : r * (q + 1) + (xcd - r) * q) + off; }
        const int nig = WGM * nN, gid = wgid / nig, fm = gid * WGM, gsz = (nM - fm) < WGM ? (nM - fm) : WGM;
        u.pm = fm + ((wgid % nig) % gsz); u.pn = (wgid % nig) / gsz; u.z = 0; u.pad = 0; u.aoff = (size_t)u.pm * tsA; u.boff = (size_t)u.pn * tsB; return true;
    }
    __device__ __forceinline__ void a_ready(const Unit&) const {}
    __device__ __forceinline__ void done(const Unit&) const {}
};
struct CmpOrder {
    int G, c; size_t vdelta;
    __device__ bool next(int i, Unit& u) const {
        const long L = (long)i * G + c; if (L >= 128) return false;
        const int mlp = (int)L / 64, rem = (int)L % 64, pm = rem / 8, ks = rem % 8;
        u.pm = pm; u.pn = 0; u.z = mlp * 8 + ks; u.pad = 0;
        u.aoff = (mlp ? vdelta : 0) + (size_t)pm * 256 * 1024 * 2 + (size_t)ks * 512;
        u.boff = (size_t)mlp * 256 * 2048 * 2 + (size_t)ks * 512; return true;
    }
    __device__ __forceinline__ void a_ready(const Unit&) const {}
    __device__ __forceinline__ void done(const Unit&) const {}
};

__device__ __forceinline__ unsigned cvt_pk_bf16(float lo, float hi) { unsigned r; asm volatile("v_cvt_pk_bf16_f32 %0, %1, %2" : "=v"(r) : "v"(lo), "v"(hi)); return r; }

struct EpiBf16 {
    static constexpr bool PERM = true, AFTER_DRAIN = false;
    bf16_t* O; int ldc; bf16_t* halo;
    __device__ __forceinline__ void operator()(const f32x4 (&acc)[2][2][4][2], const Unit& u, int wr, int wc, int fr, int fq) const {
        const int row0 = u.pm * BM + wr * 64 + fr; const int col0 = u.pn * BM + wc * 32 + 8 * fq;
#pragma unroll
        for (int ai = 0; ai < 2; ++ai)
#pragma unroll
            for (int m = 0; m < 4; ++m) { const int row = row0 + ai * HALF + m * 16; bf16_t* rowp = O + (size_t)row * ldc + col0;
#pragma unroll
                for (int bj = 0; bj < 2; ++bj) { const f32x4 v0 = acc[ai][bj][m][0], v1 = acc[ai][bj][m][1];
                    u32x4 w; w.x = cvt_pk_bf16(v0[0], v0[1]); w.y = cvt_pk_bf16(v0[2], v0[3]); w.z = cvt_pk_bf16(v1[0], v1[1]); w.w = cvt_pk_bf16(v1[2], v1[3]);
                    *(u32x4*)(rowp + bj * HALF) = w;
                    if (halo != nullptr && m == 3 && fr >= 14) *(u32x4*)(halo + ((size_t)(row >> 6) * 2 + (fr - 14)) * ldc + col0 + bj * HALF) = w; } }
    }
};
struct EpiRes {
    static constexpr bool PERM = false, AFTER_DRAIN = false;
    const float* base; float* out; const float* gate;
    __device__ __forceinline__ void operator()(const f32x4 (&acc)[2][2][4][2], const Unit& u, int wr, int wc, int fr, int fq) const {
        const int row0 = u.pm * BM + wr * 64 + fr, col0 = u.pn * BM + wc * 32 + 4 * fq; const int b = (u.pm * BM) / 2048;
        f32x4 gv[2][2];
#pragma unroll
        for (int bj = 0; bj < 2; ++bj)
#pragma unroll
            for (int n = 0; n < 2; ++n) gv[bj][n] = *(const f32x4*)(gate + (size_t)b * 6144 + col0 + bj * HALF + n * 16);
#pragma unroll
        for (int ai = 0; ai < 2; ++ai)
#pragma unroll
            for (int m = 0; m < 4; ++m) { const size_t ro = (size_t)(row0 + ai * HALF + m * 16) * 1024 + col0;
#pragma unroll
                for (int bj = 0; bj < 2; ++bj)
#pragma unroll
                    for (int n = 0; n < 2; ++n) { const f32x4 xv = *(const f32x4*)(base + ro + bj * HALF + n * 16); *(f32x4*)(out + ro + bj * HALF + n * 16) = xv + gv[bj][n] * acc[ai][bj][m][n]; } }
    }
};
struct EpiPart {
    static constexpr bool PERM = false, AFTER_DRAIN = false;
    float* P;
    __device__ __forceinline__ void operator()(const f32x4 (&acc)[2][2][4][2], const Unit& u, int wr, int wc, int fr, int fq) const {
        const int row0 = u.pm * BM + wr * 64 + fr, col0 = wc * 32 + 4 * fq;
#pragma unroll
        for (int ai = 0; ai < 2; ++ai)
#pragma unroll
            for (int m = 0; m < 4; ++m) { float* rowp = P + ((size_t)u.z * 2048 + row0 + ai * HALF + m * 16) * 256 + col0;
#pragma unroll
                for (int bj = 0; bj < 2; ++bj)
#pragma unroll
                    for (int n = 0; n < 2; ++n) *(f32x4*)(rowp + bj * HALF + n * 16) = acc[ai][bj][m][n]; }
    }
};


__device__ __forceinline__ float dpp_ror1(float x) { return __builtin_bit_cast(float, __builtin_amdgcn_update_dpp(0, __builtin_bit_cast(int, x), 0x121, 0xf, 0xf, false)); }
__device__ __forceinline__ float dpp_ror2(float x) { return __builtin_bit_cast(float, __builtin_amdgcn_update_dpp(0, __builtin_bit_cast(int, x), 0x122, 0xf, 0xf, false)); }
__device__ __forceinline__ float dpp_shr1(float old, float x) { return __builtin_bit_cast(float, __builtin_amdgcn_update_dpp(__builtin_bit_cast(int, old), __builtin_bit_cast(int, x), 0x111, 0xf, 0xf, false)); }
__device__ __forceinline__ float dpp_shr2(float old, float x) { return __builtin_bit_cast(float, __builtin_amdgcn_update_dpp(__builtin_bit_cast(int, old), __builtin_bit_cast(int, x), 0x112, 0xf, 0xf, false)); }
struct EpiConv {
    static constexpr bool PERM = true, AFTER_DRAIN = false;
    bf16_t* ACT; bf16_t* head; bf16_t* tail; const float* cw; const float* cb; PG8_LAS float* xb;
    __device__ __forceinline__ void operator()(const f32x4 (&acc)[2][2][4][2], const Unit& u, int wr, int wc, int fr, int fq) const {
        typedef __attribute__((address_space(1))) bf16_t gbf; typedef __attribute__((address_space(1))) unsigned gu32_;
        const int colh = wc * 32 + 8 * fq, FFc = 2816, FF2c = 5632;
        if (fr >= 14) {
#pragma unroll
            for (int ai = 0; ai < 2; ++ai)
#pragma unroll
                for (int bj = 0; bj < 2; ++bj)
#pragma unroll
                    for (int n = 0; n < 2; ++n) *(PG8_LAS f32x4*)(xb + ((ai * 2 + wr) * 2 + (fr - 14)) * 256 + bj * 128 + colh + 4 * n) = acc[ai][bj][3][n];
            if (wr == 1) {
#pragma unroll
                for (int bj = 0; bj < 2; ++bj)
#pragma unroll
                    for (int n = 0; n < 2; ++n) { const f32x4 v = acc[1][bj][3][n]; gu32_* p = (gu32_*)((gbf*)tail + ((size_t)u.pm * 2 + (fr - 14)) * FF2c + bj * FFc + u.pn * 128 + colh + 4 * n);
                        p[0] = cvt_pk_bf16(v[0], v[1]); p[1] = cvt_pk_bf16(v[2], v[3]); }
            }
        }
        if (fr < 2 && wr == 0) {
#pragma unroll
            for (int bj = 0; bj < 2; ++bj)
#pragma unroll
                for (int n = 0; n < 2; ++n) { const f32x4 v = acc[0][bj][0][n]; gu32_* p = (gu32_*)((gbf*)head + ((size_t)u.pm * 2 + fr) * FF2c + bj * FFc + u.pn * 128 + colh + 4 * n);
                    p[0] = cvt_pk_bf16(v[0], v[1]); p[1] = cvt_pk_bf16(v[2], v[3]); }
        }
        asm volatile("s_waitcnt lgkmcnt(0)" ::: "memory"); __builtin_amdgcn_s_barrier(); asm volatile("" ::: "memory");
#pragma unroll
        for (int n = 0; n < 2; ++n) {
            const int ca = u.pn * 128 + colh + 4 * n;
            typedef __attribute__((address_space(1))) f32x4 gf4;
            const f32x4 wa0 = *(const gf4*)(cw + ca), wa1 = *(const gf4*)(cw + FF2c + ca), wa2 = *(const gf4*)(cw + 2 * FF2c + ca), ba = *(const gf4*)(cb + ca);
            const f32x4 wv0 = *(const gf4*)(cw + FFc + ca), wv1 = *(const gf4*)(cw + FF2c + FFc + ca), wv2 = *(const gf4*)(cw + 2 * FF2c + FFc + ca), bv = *(const gf4*)(cb + FFc + ca);
#pragma unroll
            for (int ai = 0; ai < 2; ++ai) {
                const int sai = (ai == 0) ? 0 : (wr == 0 ? 0 : 1), swr = (ai == 0) ? 0 : (wr == 0 ? 1 : 0);
                const bool has = !(ai == 0 && wr == 0);
                f32x4 pa = {0.f, 0.f, 0.f, 0.f}, pv = {0.f, 0.f, 0.f, 0.f};
                if (fr >= 14 && has) { pa = *(const PG8_LAS f32x4*)(xb + ((sai * 2 + swr) * 2 + (fr - 14)) * 256 + colh + 4 * n); pv = *(const PG8_LAS f32x4*)(xb + ((sai * 2 + swr) * 2 + (fr - 14)) * 256 + 128 + colh + 4 * n); }
#pragma unroll
                for (int m = 0; m < 4; ++m) {
                    const f32x4 xa = acc[ai][0][m][n], xv = acc[ai][1][m][n];
                    float res[4];
#pragma unroll
                    for (int c = 0; c < 4; ++c) {
                        const float a1 = dpp_shr1(dpp_ror1(pa[c]), xa[c]), a2 = dpp_shr2(dpp_ror2(pa[c]), xa[c]);
                        const float v1 = dpp_shr1(dpp_ror1(pv[c]), xv[c]), v2 = dpp_shr2(dpp_ror2(pv[c]), xv[c]);
                        const float ya = ba[c] + wa0[c] * a2 + wa1[c] * a1 + wa2[c] * xa[c];
                        const float yv = bv[c] + wv0[c] * v2 + wv1[c] * v1 + wv2[c] * xv[c];
                        res[c] = ya * __builtin_amdgcn_rcpf(1.f + __builtin_amdgcn_exp2f(-1.4426950408889634f * ya)) * yv;
                    }
                    gu32_* p = (gu32_*)((gbf*)ACT + (size_t)(u.pm * BM + ai * HALF + wr * 64 + m * 16 + fr) * FFc + ca);
                    p[0] = cvt_pk_bf16(res[0], res[1]); p[1] = cvt_pk_bf16(res[2], res[3]);
                    pa = xa; pv = xv;
                }
            }
        }
    }
};

template <class Epi, class Sched, bool ALIGN_EPI>
__device__ __forceinline__ void gemm_phase(PG8_LAS unsigned char* lds, const Gemm g, const Sched& S, const Epi& E, int wave_id) {
    const int wid = wave_id, lane = opaque_lane(), tid = wid * 64 + lane, wr = wid >> 2, wc = wid & 3, fr = lane & 15, fq = lane >> 4;
    const int K = g.K, nt = K / BK;
    unsigned voffA[2], voffB[2];
#pragma unroll
    for (int i = 0; i < 2; ++i) { int R, C; stage_rc(tid * 16 + i * 8192, R, C); const int Rb = Epi::PERM ? ((R & ~31) + perm32(R & 31)) : R;
        voffA[i] = (unsigned)(R * g.lda + C) * 2u; voffB[i] = (unsigned)(Rb * g.ldb + C) * 2u; }
    const size_t kstep = (size_t)(BK * 2);
    const size_t hsA = (size_t)HALF * g.lda * 2, hsB = (size_t)HALF * g.ldb * 2;
    const unsigned ldsw = (unsigned)wid * 1024u;
    const int aoff = lds_byte(wr * 64 + fr, fq * 8), boff = lds_byte(wc * 32 + fr, fq * 8);
#define PG8_SA(b, h) (((b) * 2 + (h)) * HTB)
#define PG8_SB(b, h) ((4 + (b) * 2 + (h)) * HTB)
#define PG8_STAGE(bufoff, gbase, voff) do { _Pragma("unroll") for (int _i = 0; _i < 2; ++_i) \
        __builtin_amdgcn_global_load_lds((const unsigned*)((const char*)(gbase) + (voff)[_i]), (PG8_LAS unsigned*)(lds + (bufoff) + ldsw + _i * 8192), 16, 0, 0); } while (0)
#define PG8_LDA(dst, b, h) do { _Pragma("unroll") for (int m = 0; m < 4; ++m) _Pragma("unroll") for (int k = 0; k < 2; ++k) dst[m][k] = *(const PG8_LAS bf16x8*)(lds + PG8_SA(b, h) + aoff + m * 2048 + k * 1024); } while (0)
#define PG8_LDB(dst, b, h) do { _Pragma("unroll") for (int n = 0; n < 2; ++n) _Pragma("unroll") for (int k = 0; k < 2; ++k) dst[n][k] = *(const PG8_LAS bf16x8*)(lds + PG8_SB(b, h) + boff + n * 2048 + k * 1024); } while (0)
#define PG8_MMA(ai, bj, At, Bt) do { __builtin_amdgcn_s_setprio(1); _Pragma("unroll") for (int m = 0; m < 4; ++m) _Pragma("unroll") for (int n = 0; n < 2; ++n) _Pragma("unroll") for (int k = 0; k < 2; ++k) \
        acc[ai][bj][m][n] = __builtin_amdgcn_mfma_f32_16x16x32_bf16(Bt[n][k], At[m][k], acc[ai][bj][m][n], 0, 0, 0); __builtin_amdgcn_s_setprio(0); } while (0)
#define PG8_WAIT_V(n) asm volatile("s_waitcnt vmcnt(" #n ")" ::: "memory")
#define PG8_WAIT_L(n) asm volatile("s_waitcnt lgkmcnt(" #n ")" ::: "memory")
#define PG8_BAR __builtin_amdgcn_s_barrier()
#define PG8_SCHED __builtin_amdgcn_sched_barrier(0)
    Unit cur, nxt; int ui = 0;
    if (!S.next(0, cur)) return;
    f32x4 acc[2][2][4][2];
#pragma unroll
    for (int a = 0; a < 2; ++a)
#pragma unroll
        for (int b = 0; b < 2; ++b)
#pragma unroll
            for (int m = 0; m < 4; ++m)
#pragma unroll
                for (int n = 0; n < 2; ++n) acc[a][b][m][n] = (f32x4){0.f, 0.f, 0.f, 0.f};
    bf16x8 At[4][2], B0[2][2], B1[2][2];
    const char* cA = (const char*)g.A + cur.aoff; const char* cB = (const char*)g.Bt + cur.boff;
    S.a_ready(cur);
    PG8_STAGE(PG8_SB(0, 0), cB, voffB); PG8_STAGE(PG8_SB(0, 1), cB + hsB, voffB); PG8_STAGE(PG8_SA(0, 0), cA, voffA); PG8_STAGE(PG8_SA(0, 1), cA + hsA, voffA);
    if (wr == 1) PG8_BAR;
    PG8_WAIT_V(2); PG8_BAR;
    PG8_STAGE(PG8_SB(1, 0), cB + kstep, voffB); PG8_STAGE(PG8_SA(1, 0), cA + kstep, voffA); PG8_STAGE(PG8_SB(1, 1), cB + hsB + kstep, voffB);
    PG8_WAIT_V(6); PG8_BAR;
    for (;;) {
        const bool has_next = S.next(ui + 1, nxt);
        const char* nA = has_next ? (const char*)g.A + nxt.aoff : cA; const char* nB = has_next ? (const char*)g.Bt + nxt.boff : cB;
        for (int t = 0; t < nt; t += 2) {
            const bool last = (t == nt - 2);
            const char* a1 = cA + (size_t)(t + 1) * kstep;
            const char* a2 = last ? nA : cA + (size_t)(t + 2) * kstep; const char* b2 = last ? nB : cB + (size_t)(t + 2) * kstep;
            const char* a3 = a2 + kstep; const char* b3 = b2 + kstep;
            if (last && has_next) S.a_ready(nxt);
            PG8_LDB(B0, 0, 0); PG8_LDB(B1, 0, 1); PG8_SCHED; PG8_LDA(At, 0, 0); PG8_STAGE(PG8_SA(1, 1), a1 + hsA, voffA);
            PG8_WAIT_V(8); PG8_WAIT_L(0); PG8_BAR; PG8_MMA(0, 0, At, B0); PG8_MMA(0, 1, At, B1); PG8_BAR; PG8_SCHED;
            PG8_LDA(At, 0, 1); PG8_STAGE(PG8_SB(0, 0), b2, voffB); PG8_STAGE(PG8_SB(0, 1), b2 + hsB, voffB); PG8_STAGE(PG8_SA(0, 0), a2, voffA);
            PG8_WAIT_V(8); PG8_WAIT_L(0); PG8_BAR; PG8_MMA(1, 0, At, B0); PG8_MMA(1, 1, At, B1); PG8_BAR; PG8_SCHED;
            PG8_LDB(B0, 1, 0); PG8_LDB(B1, 1, 1); PG8_SCHED; PG8_LDA(At, 1, 0); PG8_STAGE(PG8_SA(0, 1), a2 + hsA, voffA);
            PG8_WAIT_V(8); PG8_WAIT_L(0); PG8_BAR; PG8_MMA(0, 0, At, B0); PG8_MMA(0, 1, At, B1); PG8_BAR; PG8_SCHED;
            PG8_LDA(At, 1, 1); PG8_STAGE(PG8_SB(1, 0), b3, voffB); PG8_STAGE(PG8_SB(1, 1), b3 + hsB, voffB); PG8_STAGE(PG8_SA(1, 0), a3, voffA);
            PG8_WAIT_V(8); PG8_WAIT_L(0); PG8_BAR; PG8_MMA(1, 0, At, B0); PG8_MMA(1, 1, At, B1); PG8_BAR; PG8_SCHED;
        }
        if constexpr (ALIGN_EPI) { if (wr == 0) PG8_BAR; }
        E(acc, cur, wr, wc, fr, fq); S.done(cur);
        if (!has_next) break;
#pragma unroll
        for (int a = 0; a < 2; ++a)
#pragma unroll
            for (int b = 0; b < 2; ++b)
#pragma unroll
                for (int m = 0; m < 4; ++m)
#pragma unroll
                    for (int n = 0; n < 2; ++n) acc[a][b][m][n] = (f32x4){0.f, 0.f, 0.f, 0.f};
        cur = nxt; cA = nA; cB = nB; ++ui;
        if constexpr (ALIGN_EPI) { if (wr == 1) PG8_BAR; }
    }
    PG8_WAIT_V(0);
    if constexpr (!ALIGN_EPI) { if (wr == 0) PG8_BAR; }
    PG8_BAR;
#undef PG8_SA
#undef PG8_SB
#undef PG8_STAGE
#undef PG8_LDA
#undef PG8_LDB
#undef PG8_MMA
#undef PG8_WAIT_V
#undef PG8_WAIT_L
#undef PG8_BAR
#undef PG8_SCHED
}
}

#define LAS __attribute__((address_space(3)))
#define GASQ __attribute__((address_space(1)))
#define GP(Tp, p) ((GASQ Tp*)(p))
#define GCP(Tp, p) ((const GASQ Tp*)(p))
typedef unsigned short bf16;
typedef float f32x4 __attribute__((ext_vector_type(4)));
typedef float f32x2 __attribute__((ext_vector_type(2)));
typedef unsigned v4u __attribute__((ext_vector_type(4)));
typedef unsigned v2u __attribute__((ext_vector_type(2)));

constexpr int NTHR = 512, NWAVES = 8;
constexpr int BSZ = 8, T = 2048, D = 1024, M = BSZ * T;
constexpr int ZLD = 3584, NZ = 3352, FF = 2816, FF2 = 5632, MODW = 6144;
constexpr int ZC_HQ = 0, ZC_HF = 512, ZC_HI = 1024, ZC_HG = 1536, ZC_NQ = 2048, ZC_KC = 2560, ZC_VC = 2688, ZC_KS = 2816, ZC_VS = 2944, ZC_KW = 3072, ZC_VW = 3200, ZC_NG = 3328;
constexpr float EPS = 1e-6f;
constexpr size_t MiB = 1u << 20;
constexpr size_t WS_WIN = 0, WS_WOUT = 7 * MiB, WS_WUP = 9 * MiB, WS_WDN = 20 * MiB, WS_WC1 = 26 * MiB;
constexpr size_t WS_MOD = 28 * MiB, WS_C1 = 28 * MiB + 256 * 1024, WS_KVCMP = 29 * MiB  , WS_HALO = 32 * MiB  ;
constexpr size_t WS_H = 40 * MiB  , WS_Z = 72 * MiB  ;
constexpr size_t WS_QN = 184 * MiB  , WS_KC = 200 * MiB, WS_VC = 205 * MiB, WS_KS = 210 * MiB, WS_VS = 215 * MiB, WS_KW = 220 * MiB, WS_VW = 225 * MiB;
constexpr size_t WS_U = 72 * MiB  , WS_END = 248 * MiB;
constexpr size_t WS_HGT = 229 * MiB  , WS_HVEC = 245 * MiB + 512 * 1024  ;
constexpr size_t WS_BAR = 39 * MiB;
constexpr int LDS_BYTES = 147456;

struct Args { const float* in[20]; float* out; unsigned char* ws; };

__device__ __forceinline__ unsigned f2bf(float f) { unsigned u = __builtin_bit_cast(unsigned, f); return (u + 0x7fffu + ((u >> 16) & 1u)) >> 16; }
__device__ __forceinline__ unsigned pk2(float lo, float hi) { return f2bf(lo) | (f2bf(hi) << 16); }
__device__ __forceinline__ float bf2f(unsigned short h) { return __builtin_bit_cast(float, (unsigned)h << 16); }
__device__ __forceinline__ float bflo(unsigned w) { return __builtin_bit_cast(float, w << 16); }
__device__ __forceinline__ float bfhi(unsigned w) { return __builtin_bit_cast(float, w & 0xffff0000u); }
#define DPPF(x, ctrl) __builtin_bit_cast(float, __builtin_amdgcn_update_dpp(0, __builtin_bit_cast(int, (x)), (ctrl), 0xf, 0xf, false))
__device__ __forceinline__ float wave_sum(float v) {
    v += DPPF(v, 0xB1); v += DPPF(v, 0x4E); v += DPPF(v, 0x141); v += DPPF(v, 0x140);
    v += __shfl_xor(v, 16);
    v += __shfl_xor(v, 32);
    return v;
}
__device__ __forceinline__ float wave_max(float v) {
    v = fmaxf(v, DPPF(v, 0xB1)); v = fmaxf(v, DPPF(v, 0x4E)); v = fmaxf(v, DPPF(v, 0x141)); v = fmaxf(v, DPPF(v, 0x140));
    v = fmaxf(v, __shfl_xor(v, 16));
    v = fmaxf(v, __shfl_xor(v, 32));
    return v;
}
__device__ __forceinline__ float xor32f(float x, int lane) { (void)lane; return __shfl_xor(x, 32); }
__device__ __forceinline__ float sigmoidf_(float x) { return __builtin_amdgcn_rcpf(1.f + __builtin_amdgcn_exp2f(-1.4426950408889634f * x)); }
__device__ __forceinline__ float siluf_(float x) { return x * __builtin_amdgcn_rcpf(1.f + __builtin_amdgcn_exp2f(-1.4426950408889634f * x)); }
#define LDS_FENCE() asm volatile("s_waitcnt lgkmcnt(0)" ::: "memory")
typedef short bf16x8 __attribute__((ext_vector_type(8)));
__device__ __forceinline__ float ex2(float x) { return __builtin_amdgcn_exp2f(x); }

struct Frame {
    LAS unsigned char* lds;
    int tid, lane, wave, G, blk;
};
constexpr int ARGTAB = 147200;
__device__ __forceinline__ const float* argp(const Frame& F, int k) {
    const LAS unsigned* tab = (const LAS unsigned*)(F.lds + ARGTAB);
    const unsigned lo = (unsigned)__builtin_amdgcn_readfirstlane((int)tab[2 * k]), hi = (unsigned)__builtin_amdgcn_readfirstlane((int)tab[2 * k + 1]);
    return (const float*)(((unsigned long long)hi << 32) | (unsigned long long)lo);
}
struct ArgsV { Frame F; struct InV { Frame F; __device__ __forceinline__ const float* operator[](int k) const { return argp(F, k); } } in; unsigned char* ws; float* out; };
__device__ __forceinline__ ArgsV args_view(const Frame& F) { ArgsV A; A.F = F; A.in.F = F; A.ws = (unsigned char*)argp(F, 21); A.out = (float*)argp(F, 20); return A; }
__device__ __forceinline__ Frame phase_frame(Frame F) { F.lane = opaque_lane(); F.tid = F.wave * 64 + F.lane; return F; }

template <bool UPMAP>
__device__ __forceinline__ void p0_transpose_item(const float* W, int K, int N, bf16* WT, LAS float* scr, int item, int nblk, int lane) {
    const int kb = item / nblk, nb = item % nblk, k0 = 64 * kb, n0 = 32 * nb;
    const int d0 = UPMAP ? ((n0 < FF) ? ((n0 >> 7) * 256 + (n0 & 127)) : ((((n0 - FF) >> 7) * 256) + 128 + ((n0 - FF) & 127))) : n0;
    const bool nok = (n0 + (lane & 31)) < N;
    float tv[32];
#pragma unroll
    for (int i = 0; i < 32; ++i) { const int kk = 2 * i + (lane >> 5); tv[i] = nok ? GCP(float, W)[(size_t)(k0 + kk) * N + n0 + (lane & 31)] : 0.f; }
#pragma unroll
    for (int i = 0; i < 32; ++i) { const int kk = 2 * i + (lane >> 5); scr[kk * 33 + (lane & 31)] = tv[i]; }
    if (false)
    for (int i = 0; i < 32; ++i) { const int kk = 2 * i + (lane >> 5); scr[kk * 33 + (lane & 31)] = nok ? GCP(float, W)[(size_t)(k0 + kk) * N + n0 + (lane & 31)] : 0.f; }
    LDS_FENCE();
    const int c = lane & 7;
#pragma unroll
    for (int j = 0; j < 4; ++j) { const int n = (lane >> 3) + 8 * j; const LAS float* s = scr + (8 * c) * 33 + n;
        v4u o; o.x = pk2(s[0 * 33], s[1 * 33]); o.y = pk2(s[2 * 33], s[3 * 33]); o.z = pk2(s[4 * 33], s[5 * 33]); o.w = pk2(s[6 * 33], s[7 * 33]);
        *GP(v4u, WT + (size_t)(d0 + n) * K + k0 + 8 * c) = o; }
    LDS_FENCE();
}

__device__ __forceinline__ void phase0(const Frame& F) {
    const ArgsV A = args_view(F); unsigned char* ws = A.ws;
    LAS float* sc = (LAS float*)F.lds;
    LAS float* red = (LAS float*)(F.lds + 32768);
    const float* c = A.in[1]; const float* w_ada = A.in[3]; const float* b_ada = A.in[4];
    float* mod = (float*)(ws + WS_MOD);
    { float cv[16];
#pragma unroll
      for (int i = 0; i < 16; ++i) cv[i] = GCP(float, c)[F.tid + i * NTHR];
#pragma unroll
      for (int i = 0; i < 16; ++i) sc[F.tid + i * NTHR] = siluf_(cv[i]); }
    __syncthreads();
    for (int cb = F.blk; cb < 256; cb += F.G) {
        const int n0 = cb * 24, col = F.tid % 24, kg = F.tid / 24;
        if (F.tid < 504) {
            float acc[8];
#pragma unroll
            for (int b = 0; b < 8; ++b) acc[b] = 0.f;
#pragma unroll 7
            for (int k = kg; k < 1024; k += 21) { const float w = GCP(float, w_ada)[(size_t)k * MODW + n0 + col];
#pragma unroll
                for (int b = 0; b < 8; ++b) acc[b] += sc[b * 1024 + k] * w; }
#pragma unroll
            for (int b = 0; b < 8; ++b) red[(kg * 24 + col) * 8 + b] = acc[b];
        }
        __syncthreads();
        if (F.tid < 192) { const int cc = F.tid % 24, b = F.tid / 24; float s = b_ada[n0 + cc];
            for (int g = 0; g < 21; ++g) s += red[(g * 24 + cc) * 8 + b];
            mod[b * MODW + n0 + cc] = s; }
        __syncthreads();
    }
    __syncthreads();
}
__device__ __forceinline__ void phase0b(const Frame& F) {
    const ArgsV A = args_view(F); unsigned char* ws = A.ws;
    LAS float* scr = (LAS float*)(F.lds + F.wave * 16384);
    const int gw = F.blk * NWAVES + F.wave, NGW = F.G * NWAVES;
    constexpr int I_IN = 16 * 105, I_OUT = 16 * 32, I_UP = 16 * 176, I_DN = 44 * 32, I_C1 = 32 * 8;
    constexpr int NITEMS = I_IN + I_OUT + I_UP + I_DN + 2 * I_C1;
    for (int it = gw; it < NITEMS; it += NGW) {
        int r = it;
        if (r < I_IN) { p0_transpose_item<false>(A.in[6], 1024, NZ, (bf16*)(ws + WS_WIN), scr, r, 105, F.lane); continue; } r -= I_IN;
        if (r < I_OUT) { p0_transpose_item<false>(A.in[14], 1024, 1024, (bf16*)(ws + WS_WOUT), scr, r, 32, F.lane); continue; } r -= I_OUT;
        if (r < I_UP) { p0_transpose_item<true>(A.in[16], 1024, FF2, (bf16*)(ws + WS_WUP), scr, r, 176, F.lane); continue; } r -= I_UP;
        if (r < I_DN) { p0_transpose_item<false>(A.in[19], FF, 1024, (bf16*)(ws + WS_WDN), scr, r, 32, F.lane); continue; } r -= I_DN;
        if (r < I_C1) { p0_transpose_item<false>(A.in[12], 2048, 256, (bf16*)(ws + WS_WC1), scr, r, 8, F.lane); continue; } r -= I_C1;
        p0_transpose_item<false>(A.in[12] + (size_t)2048 * 256, 2048, 256, (bf16*)(ws + WS_WC1) + (size_t)256 * 2048, scr, r, 8, F.lane);
    }
    { v4u* z = (v4u*)((bf16*)(ws + WS_WIN) + (size_t)3360 * 1024); const int n16 = 224 * 1024 * 2 / 16;
      for (int i = F.blk * NTHR + F.tid; i < n16; i += F.G * NTHR) z[i] = (v4u){0u, 0u, 0u, 0u}; }
}

__device__ __forceinline__ void phase_c1(const Frame& F, int blk0) {
    if (F.blk < blk0) return;
    const ArgsV A = args_view(F); unsigned char* ws = A.ws;
    const GASQ float* pe = GCP(float, A.in[11]); const GASQ float* w1 = GCP(float, A.in[12]); GASQ float* c1p = GP(float, ws + WS_C1);
    for (int it = (F.blk - blk0) * NWAVES + F.wave; it < 128; it += (F.G - blk0) * NWAVES) {
        const int ks = it >> 3, i = (it >> 2) & 1, j = (it & 3) * 64 + F.lane;
        float s = 0.f;
#pragma unroll 8
        for (int k = ks * 128; k < ks * 128 + 128; ++k) s += pe[i * 2048 + k] * w1[((size_t)i * 2048 + k) * 256 + j];
        c1p[(ks * 2 + i) * 256 + j] = s;
    }
}
__device__ __forceinline__ void norm_mod_rows(const Frame& F, const float* x, const float* g, int sh_off, int sc_off, bf16* H, int m_begin, int m_end, int m_step) {
    const float* mod = (const float*)((unsigned char*)argp(F, 21) + WS_MOD);
    for (int m0 = m_begin; m0 < m_end; m0 += 2 * m_step) {
        const int m1 = m0 + m_step; const bool two = m1 < m_end; const int mm[2] = {m0, two ? m1 : m0};
        f32x4 v[2][4]; float s[2] = {0.f, 0.f};
#pragma unroll
        for (int r = 0; r < 2; ++r) { const GASQ f32x4* xr = GCP(f32x4, x + (size_t)mm[r] * D) + F.lane;
#pragma unroll
            for (int j = 0; j < 4; ++j) v[r][j] = xr[64 * j]; }
#pragma unroll
        for (int r = 0; r < 2; ++r)
#pragma unroll
            for (int j = 0; j < 4; ++j) s[r] += (v[r][j].x * v[r][j].x + v[r][j].y * v[r][j].y) + (v[r][j].z * v[r][j].z + v[r][j].w * v[r][j].w);
#pragma unroll
        for (int r = 0; r < 2; ++r) {
            if (r == 1 && !two) break;
            const int m = mm[r], b = m / T;
            const float rstd = rsqrtf(wave_sum(s[r]) * (1.f / D) + EPS);
            GASQ v2u* o8 = GP(v2u, H + (size_t)m * D) + F.lane;
#pragma unroll
            for (int j = 0; j < 4; ++j) {
                const int k = (F.lane + 64 * j) * 4;
                const f32x4 gg = *GCP(f32x4, g + k), sc = *GCP(f32x4, mod + b * MODW + sc_off + k), sh = *GCP(f32x4, mod + b * MODW + sh_off + k);
                const f32x4 y = v[r][j] * rstd * gg * (sc + 1.f) + sh;
                v2u w; w.x = pk2(y.x, y.y); w.y = pk2(y.z, y.w); o8[64 * j] = w;
            }
        }
    }
}
__device__ __forceinline__ void phase_norm_mod(const Frame& F, const float* x, const float* g, int sh_off, int sc_off, bf16* H) {
    norm_mod_rows(F, x, g, sh_off, sc_off, H, F.blk * NWAVES + F.wave, M, F.G * NWAVES);
}
__device__ __forceinline__ void phase_nsa_prep(const Frame& F) {
    const ArgsV A = args_view(F); unsigned char* ws = A.ws;
    const GASQ bf16* Z = GCP(bf16, ws + WS_Z);
    const GASQ int* pos = GCP(int, A.in[2]);
    const int gw = F.blk * NWAVES + F.wave, NGW = F.G * NWAVES, lane = F.lane;
    const float invt[8] = {1.0f, 0.1939227432012558f, 0.03760603070259094f, 0.007292664609849453f, 0.0014142135623842478f, 0.00027424818836152554f, 5.3182957344688475e-05f, 1.0313385246263351e-05f};
    float inv = 0.f;
#pragma unroll
    for (int i = 0; i < 8; ++i) inv = ((lane & 7) == i) ? invt[i] : inv;
    const float gq = GCP(float, A.in[9])[lane], gk0 = GCP(float, A.in[10])[lane], gk1 = GCP(float, A.in[10])[64 + lane], gk2 = GCP(float, A.in[10])[128 + lane];
    for (int m = gw; m < M; m += NGW) {
        const int b = m / T, t = m % T;
        const GASQ bf16* zr = Z + (size_t)m * ZLD + ZC_NQ + lane;
        unsigned short zv[20];
#pragma unroll
        for (int v = 0; v < 20; ++v) zv[v] = (v == 14 || v == 15 || v == 18 || v == 19) ? (unsigned short)0 : zr[v * 64];
        const float rev = (float)pos[m] * inv * 0.15915494309189535f;
        const float fr = rev - floorf(rev);
        const float cs = __builtin_amdgcn_cosf(fr), sn = __builtin_amdgcn_sinf(fr);
#pragma unroll
        for (int v = 0; v < 20; ++v) {
            if (v == 14 || v == 15 || v == 18 || v == 19) continue;
            GASQ bf16* dst;
            if (v < 8) dst = GP(bf16, ws + WS_QN) + ((size_t)(b * 8 + v) * T + t) * 64;
            else { const size_t off = v < 10 ? WS_KC : v < 12 ? WS_VC : v < 14 ? WS_KS : WS_KW; dst = GP(bf16, ws + off) + ((size_t)(b * 2 + (v & 1)) * T + t) * 64; }
            if (v == 10 || v == 11) { dst[lane] = zv[v]; continue; }
            const float x = bf2f(zv[v]);
            const float ss = wave_sum(x * x);
            const float gsel = v < 8 ? gq : v < 10 ? gk0 : v < 14 ? gk1 : gk2;
            float y = x * rsqrtf(ss * (1.f / 64.f) + EPS) * gsel;
            const float partner = DPPF(y, 0x128);
            if (lane < 8) y = y * cs - partner * sn; else if (lane < 16) y = y * cs + partner * sn;
            dst[lane] = (bf16)f2bf(v < 8 ? y * 0.18033688011112042f   : y);
        }
    }
    for (int it = gw; it < BSZ * 2 * 2 * 32; it += NGW) {
        const int tb = it & 31, br = (it >> 5) & 1, gi = (it >> 6) & 1, b = it >> 7;
        const GASQ bf16* zr = Z + ((size_t)b * T + tb * 64) * ZLD + (br == 0 ? ZC_VS : ZC_VW) + gi * 64 + lane;
        GASQ bf16* dst = GP(bf16, ws + (br == 0 ? WS_VS : WS_VW)) + ((size_t)(b * 2 + gi) * 64 + lane) * T + tb * 64;
#pragma unroll
        for (int c8 = 0; c8 < 8; ++c8) {
            unsigned w[4];
#pragma unroll
            for (int e = 0; e < 4; ++e) { const unsigned lo = zr[(size_t)(c8 * 8 + 2 * e) * ZLD], hi = zr[(size_t)(c8 * 8 + 2 * e + 1) * ZLD]; w[e] = lo | (hi << 16); }
            *(GASQ v4u*)(dst + c8 * 8) = (v4u){w[0], w[1], w[2], w[3]};
        }
    }
}

constexpr int HG_P = 0, HG_G = 17408, HG_GT = 34816, HG_AM = 53248, HG_ST = 72704  , HG_VT = 66816, HG_TOT = 69120, HG_VEC = 71168;
#define MFMA16(a, b, c) __builtin_amdgcn_mfma_f32_16x16x32_bf16((a), (b), (c), 0, 0, 0)
__device__ __forceinline__ void phase_hg_prep(const Frame& F, float* OUTB) {
    const ArgsV A = args_view(F); const GASQ bf16* Z = GCP(bf16, A.ws + WS_Z);
    const float* lbl = A.in[7];
    GASQ bf16* Pg = GP(bf16, A.ws + WS_H); GASQ bf16* Gg = Pg + (size_t)1024 * 8192;
    GASQ bf16* GTg = GP(bf16, A.ws + WS_HGT); GASQ float* VECg = GP(float, A.ws + WS_HVEC);
    const int tid = F.tid; LAS float* TOT = (LAS float*)(F.lds + HG_TOT);
    const int k = tid & 127, rg = tid >> 7;
    const float lb0 = 1.f / (1.f + expf(lbl[512 + k] - lbl[k])), lb1 = 1.f / (1.f + expf(lbl[640 + k] - lbl[128 + k])), lb2 = 1.f / (1.f + expf(lbl[768 + k] - lbl[256 + k])), lb3 = 1.f / (1.f + expf(lbl[896 + k] - lbl[384 + k]));
#pragma unroll 1
    for (int it = F.blk; it < 1024; it += F.G) {
        const int bh = it >> 5, c = it & 31, b = bh >> 2, h = bh & 3, ch = h * 128 + k;
        const float lb = (h == 0) ? lb0 : (h == 1) ? lb1 : (h == 2) ? lb2 : lb3;
        const GASQ bf16* zb = Z + ((size_t)b * T + c * 64 + rg * 16) * ZLD + ch;
        unsigned short zf[16], zq[16];
#pragma unroll
        for (int i = 0; i < 16; ++i) { zf[i] = zb[i * ZLD + ZC_HF]; zq[i] = zb[i * ZLD + ZC_HQ]; }
        float cum[16], qv[16], kv[16]; float run = 0.f;
#pragma unroll
        for (int i = 0; i < 16; ++i) {
            const float z1 = bf2f(zf[i]), z2 = bf2f(zq[i]);
            const float sg = __builtin_amdgcn_rcpf(1.f + ex2(-1.4426950408889634f * z1));
            const float f = lb + (1.f - lb) * sg;
            run += __builtin_amdgcn_logf(f); cum[i] = run; kv[i] = 1.f - f;
            qv[i] = z2 * __builtin_amdgcn_rcpf(1.f + ex2(-1.4426950408889634f * z2));
        }
        __syncthreads();
        TOT[rg * 128 + k] = run;
        __syncthreads();
        const float t0 = TOT[k], t1 = TOT[128 + k], t2 = TOT[256 + k], t3 = TOT[384 + k];
        const float e0 = t0 + t1, Bt = e0 + (t2 + t3);
        const float off = (rg == 0) ? 0.f : (rg == 1) ? t0 : (rg == 2) ? e0 : (e0 + t2);
        unsigned gt[8];
#pragma unroll
        for (int i = 0; i < 16; ++i) {
            const float bt = off + cum[i];
            const float p = qv[i] * ex2(bt - e0), g = kv[i] * ex2(e0 - bt);
            const unsigned gb = f2bf(g);
            Pg[((size_t)it * 64 + rg * 16 + i) * 128 + k] = (bf16)f2bf(p);
            Gg[((size_t)it * 64 + rg * 16 + i) * 128 + k] = (bf16)gb;
            if (i & 1) gt[i >> 1] |= gb << 16; else gt[i >> 1] = gb;
        }
        *(GASQ v4u*)(GTg + ((size_t)it * 128 + k) * 64 + rg * 16) = (v4u){gt[0], gt[1], gt[2], gt[3]};
        *(GASQ v4u*)(GTg + ((size_t)it * 128 + k) * 64 + rg * 16 + 8) = (v4u){gt[4], gt[5], gt[6], gt[7]};
        if (rg == 0) { VECg[(size_t)it * 384 + k] = ex2(e0); VECg[(size_t)it * 384 + 128 + k] = ex2(Bt); VECg[(size_t)it * 384 + 256 + k] = ex2(Bt - e0); }
    }
    __syncthreads();
}
__device__ __forceinline__ void phase_hg_scan(const Frame& F, float* OHG) {
    const ArgsV A = args_view(F); const GASQ bf16* Z = GCP(bf16, A.ws + WS_Z);
    const GASQ bf16* Pg = GCP(bf16, A.ws + WS_H); const GASQ bf16* Gg = Pg + (size_t)1024 * 8192;
    const GASQ bf16* GTg = GCP(bf16, A.ws + WS_HGT); const GASQ float* VECg = GCP(float, A.ws + WS_HVEC);
    const int tid = F.tid, lane = F.lane, w = F.wave, fr = lane & 15, fq = lane >> 4;
    LAS unsigned char* L = F.lds;
    LAS float* VEC = (LAS float*)(L + HG_VEC);
#pragma unroll 1
    for (int item = F.blk; item < 256; item += F.G) {
        const int bh = (item & 7) * 4 + (item >> 6), vs = (item >> 3) & 7, b = bh >> 2, h = bh & 3, it0 = bh * 32, oitem = bh * 8 + vs;
        const GASQ bf16* zb = Z + (size_t)b * T * ZLD;
        const unsigned vo = (unsigned)((tid >> 4) * 2 * ZLD + ZC_HI + h * 128 + vs * 16 + (tid & 15));
        const int r0 = tid >> 4, c16 = tid & 15, k0 = tid >> 3, c8 = tid & 7;
        const unsigned pgo = (unsigned)(r0 * 128 + c16 * 8), gto = (unsigned)(k0 * 64 + c8 * 8);
        f32x4 S = {0.f, 0.f, 0.f, 0.f};
        v4u sp[2], sg[2], st[2]; f32x4 sv = {0.f, 0.f, 0.f, 0.f}; unsigned short vr[2];
#define HG_LOAD(cc) do { const size_t itc = (size_t)(it0 + (cc)); \
            sp[0] = *(const GASQ v4u*)(Pg + itc * 8192 + pgo); sp[1] = *(const GASQ v4u*)(Pg + itc * 8192 + 4096 + pgo); \
            sg[0] = *(const GASQ v4u*)(Gg + itc * 8192 + pgo); sg[1] = *(const GASQ v4u*)(Gg + itc * 8192 + 4096 + pgo); \
            st[0] = *(const GASQ v4u*)(GTg + itc * 8192 + gto); st[1] = *(const GASQ v4u*)(GTg + itc * 8192 + 4096 + gto); \
            if (tid < 96) sv = *(const GASQ f32x4*)(VECg + itc * 384 + tid * 4); \
            vr[0] = zb[(unsigned)((cc) * 64 * ZLD) + vo]; vr[1] = zb[(unsigned)((cc) * 64 * ZLD) + vo + ZLD]; } while (0)
        HG_LOAD(0);
#pragma unroll 1
        for (int c = 0; c < 32; ++c) {
            *(LAS v4u*)(L + HG_P + r0 * 272 + c16 * 16) = sp[0]; *(LAS v4u*)(L + HG_P + (r0 + 32) * 272 + c16 * 16) = sp[1];
            *(LAS v4u*)(L + HG_G + r0 * 272 + c16 * 16) = sg[0]; *(LAS v4u*)(L + HG_G + (r0 + 32) * 272 + c16 * 16) = sg[1];
            *(LAS v4u*)(L + HG_GT + k0 * 144 + c8 * 16) = st[0]; *(LAS v4u*)(L + HG_GT + (k0 + 64) * 144 + c8 * 16) = st[1];
            if (tid < 96) *(LAS f32x4*)(VEC + tid * 4) = sv;
            *(LAS unsigned*)(L + HG_VT + (tid & 15) * 144 + (tid >> 4) * 4) = (unsigned)vr[0] | ((unsigned)vr[1] << 16);
            if (c < 31) HG_LOAD(c + 1);
            __syncthreads();
            { const int kk = 16 * w + fq * 4; const f32x4 ev = *(const LAS f32x4*)(VEC + kk);
              v2u sw; sw.x = pk2(ev.x * S.x, ev.y * S.y); sw.y = pk2(ev.z * S.z, ev.w * S.w);
              *(LAS v2u*)(L + HG_ST + fr * 272 + kk * 2) = sw; }
#pragma unroll
            for (int q2 = 0; q2 < 2; ++q2) {
                const int tt = 2 * w + q2, ti = tt >> 2, tj = tt & 3;
                f32x4 acc = {0.f, 0.f, 0.f, 0.f};
#pragma unroll
                for (int ks = 0; ks < 4; ++ks) {
                    const bf16x8 pa = *(const LAS bf16x8*)(L + HG_P + (16 * ti + fr) * 272 + (ks * 32 + fq * 8) * 2);
                    const bf16x8 gb = *(const LAS bf16x8*)(L + HG_G + (16 * tj + fr) * 272 + (ks * 32 + fq * 8) * 2);
                    acc = MFMA16(pa, gb, acc);
                }
                asm volatile("s_nop 7\n\ts_nop 7" ::: "memory");
#pragma unroll
                for (int j = 0; j < 4; ++j) { const bool keep = (tj < ti) || ((tj == ti) && (fq * 4 + j >= fr)); acc[j] = keep ? acc[j] : 0.f; }
#pragma unroll
                for (int j = 0; j < 4; ++j) {
                    const unsigned ab = f2bf(acc[j]), ao = (unsigned)__builtin_amdgcn_update_dpp(0, (int)ab, 0xB1, 0xf, 0xf, false);
                    if ((j & 1) == (fr & 1)) *(LAS unsigned*)(L + HG_AM + (16 * ti + fq * 4 + j) * 144 + (16 * tj + (fr & ~1)) * 2) = (fr & 1) ? (ao | (ab << 16)) : (ab | (ao << 16));
                }
            }
            __syncthreads();
            {
                const int wr = w & 3;
                f32x4 o = {0.f, 0.f, 0.f, 0.f};
                if (w < 4) {
#pragma unroll
                    for (int ks = 0; ks < 4; ++ks) {
                        const bf16x8 pa = *(const LAS bf16x8*)(L + HG_P + (16 * wr + fr) * 272 + (ks * 32 + fq * 8) * 2);
                        const bf16x8 sb = *(const LAS bf16x8*)(L + HG_ST + fr * 272 + (ks * 32 + fq * 8) * 2);
                        o = MFMA16(pa, sb, o);
                    }
#pragma unroll
                    for (int ks = 0; ks < 2; ++ks) {
                        const bf16x8 aa = *(const LAS bf16x8*)(L + HG_AM + (16 * wr + fr) * 144 + (ks * 32 + fq * 8) * 2);
                        const bf16x8 vb = *(const LAS bf16x8*)(L + HG_VT + fr * 144 + (ks * 32 + fq * 8) * 2);
                        o = MFMA16(aa, vb, o);
                    }
                    asm volatile("s_nop 7\n\ts_nop 7" ::: "memory");
                    GASQ float* op = GP(float, OHG + ((size_t)oitem * T + c * 64 + 16 * wr + fq * 4) * 16 + fr);
#pragma unroll
                    for (int j = 0; j < 4; ++j) op[j * 16] = o[j];
                }
            }
            {
                f32x4 u = {0.f, 0.f, 0.f, 0.f};
#pragma unroll
                for (int ks = 0; ks < 2; ++ks) {
                    const bf16x8 ga = *(const LAS bf16x8*)(L + HG_GT + (16 * w + fr) * 144 + (ks * 32 + fq * 8) * 2);
                    const bf16x8 vb = *(const LAS bf16x8*)(L + HG_VT + fr * 144 + (ks * 32 + fq * 8) * 2);
                    u = MFMA16(ga, vb, u);
                }
                asm volatile("s_nop 7\n\ts_nop 7" ::: "memory");
                const int kk = 16 * w + fq * 4; const f32x4 eB = *(const LAS f32x4*)(VEC + 128 + kk), eD = *(const LAS f32x4*)(VEC + 256 + kk);
                S = eB * S + eD * u;
            }
            __syncthreads();
        }
#undef HG_LOAD
    }
}
__device__ __forceinline__ void phase_hg_scan_v1(const Frame& F, float* OHG) {
    const ArgsV A = args_view(F); const bf16* Z = (const bf16*)(A.ws + WS_Z);
    const float* lbl = A.in[7];
    LAS float* Fm = (LAS float*)F.lds;
    LAS float* Qm = (LAS float*)(F.lds + 32768);
    LAS float* Vm = (LAS float*)(F.lds + 65536);
    LAS float* Om = (LAS float*)(F.lds + 69632);
    const int tid = F.tid, lane = F.lane;
    for (int item = F.blk; item < 256; item += F.G) {
        const int b = item >> 5, h = (item >> 3) & 3, vs = item & 7;
        const int col = tid & 127; const int ch = h * 128 + col;
        const float lb = 1.f / (1.f + expf(lbl[512 + ch] - lbl[ch]));
        const int k0 = (lane & 31) * 4, vloc = F.wave * 2 + (lane >> 5);
        float S0 = 0.f, S1 = 0.f, S2 = 0.f, S3 = 0.f;
        for (int c = 0; c < 32; ++c) {
            __syncthreads();
            const size_t mbase = (size_t)b * T + c * 64;
#pragma unroll 4
            for (int i = 0; i < 16; ++i) { const int row = (tid >> 7) + 4 * i; const bf16* zr = Z + (mbase + row) * ZLD;
                const float zf = bf2f(zr[ZC_HF + ch]), zq = bf2f(zr[ZC_HQ + ch]);
                Fm[row * 128 + col] = lb + (1.f - lb) * sigmoidf_(zf); Qm[row * 128 + col] = siluf_(zq); }
#pragma unroll
            for (int i = 0; i < 2; ++i) { const int idx = tid + 512 * i, row = idx >> 4, vc = idx & 15; Vm[idx] = bf2f(Z[(mbase + row) * ZLD + ZC_HI + h * 128 + vs * 16 + vc]); }
            __syncthreads();
            for (int t = 0; t < 64; ++t) {
                const f32x4 f4 = *(const LAS f32x4*)(Fm + t * 128 + k0), q4 = *(const LAS f32x4*)(Qm + t * 128 + k0); const float vt = Vm[t * 16 + vloc];
                S0 = f4.x * S0 + (1.f - f4.x) * vt; S1 = f4.y * S1 + (1.f - f4.y) * vt; S2 = f4.z * S2 + (1.f - f4.z) * vt; S3 = f4.w * S3 + (1.f - f4.w) * vt;
                float p = (q4.x * S0 + q4.y * S1) + (q4.z * S2 + q4.w * S3);
                p += __shfl_xor(p, 1); p += __shfl_xor(p, 2); p += __shfl_xor(p, 4); p += __shfl_xor(p, 8); p += __shfl_xor(p, 16);
                if ((lane & 31) == 0) Om[t * 16 + vloc] = p;
            }
            __syncthreads();
#pragma unroll
            for (int i = 0; i < 2; ++i) { const int idx = tid + 512 * i, row = idx >> 4, vc = idx & 15; OHG[((size_t)item * T + c * 64 + row) * 16 + vc] = Om[idx]; }
        }
        __syncthreads();
    }
}
__device__ __forceinline__ void phase_hg_norm(const Frame& F, const float* OHG) {
    const ArgsV A = args_view(F); const bf16* Z = (const bf16*)(A.ws + WS_Z); bf16* MIX = (bf16*)(A.ws + WS_H);
    const int gw = F.blk * NWAVES + F.wave, NGW = F.G * NWAVES, lane = F.lane;
    const f32x2 ngv = *GCP(f32x2, A.in[8] + 2 * lane);
    for (int m = gw; m < M; m += NGW) {
        f32x2 o[4]; unsigned gz[4];
#pragma unroll
        for (int h = 0; h < 4; ++h) {
            o[h] = *GCP(f32x2, OHG + ((size_t)((m / T) * 32 + h * 8 + (lane >> 3)) * T + (m % T)) * 16 + 2 * (lane & 7));
            gz[h] = *GCP(unsigned, Z + (size_t)m * ZLD + ZC_HG + h * 128 + 2 * lane);
        }
#pragma unroll
        for (int h = 0; h < 4; ++h) {
            const float ss = wave_sum(o[h].x * o[h].x + o[h].y * o[h].y);
            const float r = rsqrtf(ss * (1.f / 128.f) + EPS);
            const float y0 = o[h].x * r * ngv.x * siluf_(bflo(gz[h])), y1 = o[h].y * r * ngv.y * siluf_(bfhi(gz[h]));
            *GP(unsigned, MIX + (size_t)m * D + h * 128 + 2 * lane) = pk2(y0, y1);
        }
    }
}

__device__ __forceinline__ void phase_cmp_finish(const Frame& F, const float* PART) {
    const ArgsV A = args_view(F); const float* c1 = (const float*)(A.ws + WS_C1); const float* w2 = A.in[13]; float* KV = (float*)(A.ws + WS_KVCMP);
    LAS float* hw = (LAS float*)(F.lds + F.wave * 2048);
    const int gw = F.blk * NWAVES + F.wave, NGW = F.G * NWAVES, lane = F.lane;
    GASQ bf16* KVb = GP(bf16, KV);
    for (int R = gw; R < 2048; R += NGW) {
        f32x4 s0 = {0.f, 0.f, 0.f, 0.f}, s1 = {0.f, 0.f, 0.f, 0.f};
#pragma unroll
        for (int kp = 0; kp < 16; ++kp) { s0 += *GCP(f32x4, c1 + (kp * 2 + 0) * 256 + lane * 4); s1 += *GCP(f32x4, c1 + (kp * 2 + 1) * 256 + lane * 4); }
#pragma unroll
        for (int ks = 0; ks < 8; ++ks) { s0 += *GCP(f32x4, PART + ((size_t)ks * 2048 + R) * 256 + lane * 4); s1 += *GCP(f32x4, PART + ((size_t)(8 + ks) * 2048 + R) * 256 + lane * 4); }
        f32x4 h0, h1;
        h0.x = siluf_(s0.x); h0.y = siluf_(s0.y); h0.z = siluf_(s0.z); h0.w = siluf_(s0.w);
        h1.x = siluf_(s1.x); h1.y = siluf_(s1.y); h1.z = siluf_(s1.z); h1.w = siluf_(s1.w);
        *(LAS f32x4*)(hw + lane * 4) = h0; *(LAS f32x4*)(hw + 256 + lane * 4) = h1;
        LDS_FENCE();
        const GASQ float* wp0 = GCP(float, w2 + lane); const GASQ float* wp1 = GCP(float, w2 + (size_t)256 * 64 + lane);
        f32x4 a0 = {0.f, 0.f, 0.f, 0.f}, a1 = {0.f, 0.f, 0.f, 0.f};
#pragma unroll 4
        for (int j4 = 0; j4 < 64; ++j4) {
            const f32x4 h0v = *(const LAS f32x4*)(hw + 4 * j4), h1v = *(const LAS f32x4*)(hw + 256 + 4 * j4);
            const f32x4 w0v = {wp0[(4 * j4) * 64], wp0[(4 * j4 + 1) * 64], wp0[(4 * j4 + 2) * 64], wp0[(4 * j4 + 3) * 64]};
            const f32x4 w1v = {wp1[(4 * j4) * 64], wp1[(4 * j4 + 1) * 64], wp1[(4 * j4 + 2) * 64], wp1[(4 * j4 + 3) * 64]};
            a0 += h0v * w0v; a1 += h1v * w1v;
        }
        float o0 = (a0.x + a0.y) + (a0.z + a0.w), o1 = (a1.x + a1.y) + (a1.z + a1.w);
        if ((R & 127) == 127) { o0 = 0.f; o1 = 0.f; }
        KVb[(size_t)R * 64 + lane] = (bf16)f2bf(o0);
        KVb[(size_t)2048 * 64 + ((size_t)(R >> 7) * 64 + lane) * 128 + (R & 127)] = (bf16)f2bf(o1);
        LDS_FENCE();
    }
}

typedef float f32x16 __attribute__((ext_vector_type(16)));
#define MFMA32(a, b, c) __builtin_amdgcn_mfma_f32_32x32x16_bf16((a), (b), (c), 0, 0, 0)
__device__ __forceinline__ unsigned cvtpk(float lo, float hi) { typedef float f2_t __attribute__((ext_vector_type(2))); typedef __bf16 b2_t __attribute__((ext_vector_type(2)));
    f2_t v = {lo, hi}; b2_t r = __builtin_convertvector(v, b2_t); return __builtin_bit_cast(unsigned, r); }
constexpr int AT_KB = 0, AT_VB = 18432, AT_IMP = 36864, AT_SEL = 69632, AT_OUT = 69888  , AT_ROW = 144;

template <int MM>
__device__ __forceinline__ void attn_block_mfma(const LAS unsigned char* Kb, const LAS unsigned char* Vb, const bf16x8 (&qf)[4], f32x16 (&O)[2], float& m, float& l, int lane, bool selbit, int tl) {
    const int r32 = lane & 31, h = lane >> 5;
    f32x16 S[2];
#pragma unroll
    for (int kt = 0; kt < 2; ++kt) {
#pragma unroll
        for (int i = 0; i < 16; ++i) S[kt][i] = 0.f;
#pragma unroll
        for (int ks = 0; ks < 4; ++ks) { const bf16x8 kf = *(const LAS bf16x8*)(Kb + (kt * 32 + r32) * AT_ROW + (ks * 16 + h * 8) * 2); S[kt] = MFMA32(kf, qf[ks], S[kt]); }
        __builtin_amdgcn_sched_barrier(0);
    }
    float mx = -INFINITY;
#pragma unroll
    for (int kt = 0; kt < 2; ++kt)
#pragma unroll
        for (int i = 0; i < 16; ++i) { const int kl = kt * 32 + 8 * (i >> 2) + 4 * h + (i & 3);
            bool ok = selbit; if (MM == 1) ok = ok && (kl <= tl); if (MM == 2) ok = ok && (kl > tl);
            const float s = ok ? S[kt][i] : -INFINITY; S[kt][i] = s; mx = fmaxf(mx, s); }
    mx = fmaxf(mx, xor32f(mx, lane));
    const float mn = fmaxf(m, mx), alpha = ex2(m - mn); m = mn;
    float rs = 0.f;
#pragma unroll
    for (int kt = 0; kt < 2; ++kt)
#pragma unroll
        for (int i = 0; i < 16; ++i) { const float p = ex2(S[kt][i] - mn); S[kt][i] = p; rs += p; }
    l = l * alpha + rs;
#pragma unroll
    for (int i = 0; i < 16; ++i) { O[0][i] *= alpha; O[1][i] *= alpha; }
    bf16x8 pf[4];
#pragma unroll
    for (int s = 0; s < 4; ++s) { const int kt = s >> 1, bb = 8 * (s & 1);
        v4u w; w.x = cvtpk(S[kt][bb + 0], S[kt][bb + 1]); w.y = cvtpk(S[kt][bb + 2], S[kt][bb + 3]); w.z = cvtpk(S[kt][bb + 4], S[kt][bb + 5]); w.w = cvtpk(S[kt][bb + 6], S[kt][bb + 7]);
        pf[s] = __builtin_bit_cast(bf16x8, w); }
#pragma unroll
    for (int dt = 0; dt < 2; ++dt)
#pragma unroll
        for (int s = 0; s < 4; ++s) { const LAS unsigned char* vp = Vb + (dt * 32 + r32) * AT_ROW + (16 * s + 4 * h) * 2;
            const v2u lo = *(const LAS v2u*)vp, hi = *(const LAS v2u*)(vp + 16);
            const v4u w = {lo.x, lo.y, hi.x, hi.y};
            O[dt] = MFMA32(__builtin_bit_cast(bf16x8, w), pf[s], O[dt]); if (s & 1) __builtin_amdgcn_sched_barrier(0); }
}

template <bool WIN>
__device__ __forceinline__ void attn_branch(const Frame& F, const bf16* Kx, const bf16* VTx, size_t bg, int qb, int jlo, int jhi, const bf16x8 (&qf)[4], f32x16 (&O)[2], float& m, float& l, unsigned mysel, int tl) {
    const int tid = F.tid, lane = F.lane, row = tid >> 3, ch = tid & 7;
    const GASQ bf16* kg = (const GASQ bf16*)(Kx + bg * T * 64); const GASQ bf16* vg = (const GASQ bf16*)(VTx + bg * 64 * T);
    const unsigned ko = (unsigned)(row * 64 + ch * 8), vo = (unsigned)(row * T + ch * 8);
    const int so = row * AT_ROW + ch * 16;
    v4u kr = *(const GASQ v4u*)(kg + (jlo * 4096 + ko)), vr = *(const GASQ v4u*)(vg + (jlo * 64 + vo));
    *(LAS v4u*)(F.lds + AT_KB + so) = kr; *(LAS v4u*)(F.lds + AT_VB + so) = vr;
    __syncthreads();
    int buf = 0;
    for (int jb = jlo; jb <= jhi; ++jb) {
        const bool more = jb < jhi;
        if (more) { kr = *(const GASQ v4u*)(kg + ((jb + 1) * 4096 + ko)); vr = *(const GASQ v4u*)(vg + ((jb + 1) * 64 + vo)); }
        const LAS unsigned char* Kb = F.lds + AT_KB + buf * 9216; const LAS unsigned char* Vb = F.lds + AT_VB + buf * 9216;
        const bool selbit = WIN ? true : (((mysel >> jb) & 1u) != 0u);
        if (jb == qb) attn_block_mfma<1>(Kb, Vb, qf, O, m, l, lane, selbit, tl);
        else if (WIN && jb == qb - 8) attn_block_mfma<2>(Kb, Vb, qf, O, m, l, lane, selbit, tl);
        else attn_block_mfma<0>(Kb, Vb, qf, O, m, l, lane, selbit, tl);
        buf ^= 1;
        if (more) { *(LAS v4u*)(F.lds + AT_KB + buf * 9216 + so) = kr; *(LAS v4u*)(F.lds + AT_VB + buf * 9216 + so) = vr; }
        __syncthreads();
    }
}

template <class Bar>
__device__ __forceinline__ void phase_nsa_attn(const Frame& F, const Bar* pending) {
    const ArgsV A = args_view(F); unsigned char* ws = A.ws;
    const bf16* Z = (const bf16*)(ws + WS_Z); const bf16* QN = (const bf16*)(ws + WS_QN);
    const bf16* KS = (const bf16*)(ws + WS_KS); const bf16* VST = (const bf16*)(ws + WS_VS); const bf16* KW = (const bf16*)(ws + WS_KW); const bf16* VWT = (const bf16*)(ws + WS_VW);
    const bf16* KC = (const bf16*)(ws + WS_KVCMP); const bf16* VCT = KC + (size_t)2048 * 64; bf16* MIX = (bf16*)(ws + WS_H);
    const int r = F.wave >> 1, tb = F.wave & 1;
    LAS float* IMP = (LAS float*)(F.lds + AT_IMP);
    LAS unsigned* SEL = (LAS unsigned*)(F.lds + AT_SEL);
    bool waiting = (pending != nullptr);
#pragma unroll 1
    for (int item = F.blk; item < 256; item += F.G) {
        const size_t bg = (size_t)((item & 7) * 2 + (item >> 7)); const int b = (int)(bg >> 1), g = (int)(bg & 1), pi = (item >> 3) & 15;
#pragma unroll 1
        for (int u2 = 0; u2 < 2; ++u2) {
            Frame Fu = F; Fu.lane = opaque_lane(); Fu.tid = F.wave * 64 + Fu.lane;
            const int tid = Fu.tid, lane = Fu.lane, r32 = lane & 31, h = lane >> 5, tl = tb * 32 + r32;
            const int qb = u2 ? (31 - pi) : pi;
            const int t = qb * 64 + tl; const size_t mrow = (size_t)b * T + t;
            bf16x8 qf[4];
            { const GASQ bf16* qp = (const GASQ bf16*)(QN + ((size_t)(b * 8 + g * 4 + r) * T + t) * 64 + h * 8);
#pragma unroll
              for (int ks = 0; ks < 4; ++ks) qf[ks] = *(const GASQ bf16x8*)(qp + ks * 16); }
            const GASQ bf16* gz = (const GASQ bf16*)(Z + mrow * ZLD + ZC_NG + (g * 4 + r) * 3);
            const float g0 = sigmoidf_(bf2f(gz[0])), g1 = sigmoidf_(bf2f(gz[1])), g2 = sigmoidf_(bf2f(gz[2]));
            LAS float* OL = (LAS float*)(F.lds + AT_OUT + F.wave * 8192) + lane;
            {
                f32x16 O[2]; float m = -1e30f, l = 0.f;
#pragma unroll
                for (int i = 0; i < 16; ++i) { O[0][i] = 0.f; O[1][i] = 0.f; }
                __syncthreads();
                attn_branch<true>(Fu, KW, VWT, bg, qb, qb >= 8 ? qb - 8 : 0, qb, qf, O, m, l, 0xffffffffu, tl);
                l += xor32f(l, lane);
                const float sc = g2 / l;
#pragma unroll
                for (int i = 0; i < 16; ++i) { OL[i * 64] = sc * O[0][i]; OL[(16 + i) * 64] = sc * O[1][i]; }
            }
            if (waiting) { xcd_wait(*pending); waiting = false; }
            __syncthreads();
            { const int row = tid >> 3, ch = tid & 7;
              const GASQ bf16* kcb = (const GASQ bf16*)(KC + bg * 8192); const GASQ bf16* vcb = (const GASQ bf16*)(VCT + bg * 8192);
#pragma unroll
              for (int i = 0; i < 2; ++i) { const v4u v = *(const GASQ v4u*)(kcb + (unsigned)((row + 64 * i) * 64 + ch * 8)); *(LAS v4u*)(F.lds + AT_KB + (row + 64 * i) * AT_ROW + ch * 16) = v; }
#pragma unroll
              for (int i = 0; i < 2; ++i) { const v4u v = *(const GASQ v4u*)(vcb + (unsigned)(row * 128 + (ch + 8 * i) * 8)); *(LAS v4u*)(F.lds + AT_VB + row * 272 + (ch + 8 * i) * 16) = v; } }
            __syncthreads();
            {
                const int nvalid = (t >= 31) ? (((t - 31) >> 4) + 1) : 0;
                float mx = -1e30f;
#pragma unroll
                for (int kt = 0; kt < 4; ++kt) {
                    f32x16 S;
#pragma unroll
                    for (int i = 0; i < 16; ++i) S[i] = 0.f;
#pragma unroll
                    for (int ks = 0; ks < 4; ++ks) { const bf16x8 kf = *(const LAS bf16x8*)(F.lds + AT_KB + (kt * 32 + r32) * AT_ROW + (ks * 16 + h * 8) * 2); S = MFMA32(kf, qf[ks], S); }
#pragma unroll
                    for (int i = 0; i < 16; ++i) { const int n = kt * 32 + 8 * (i >> 2) + 4 * h + (i & 3); mx = fmaxf(mx, (n < nvalid) ? S[i] : -INFINITY); }
                    __builtin_amdgcn_sched_barrier(0);
                }
                mx = fmaxf(mx, xor32f(mx, lane));
                f32x16 Oc[2];
#pragma unroll
                for (int i = 0; i < 16; ++i) { Oc[0][i] = 0.f; Oc[1][i] = 0.f; }
                float impv[16]; float rs = 0.f, yprev = 0.f;
#pragma unroll
                for (int kt = 0; kt < 4; ++kt) {
                    f32x16 S;
#pragma unroll
                    for (int i = 0; i < 16; ++i) S[i] = 0.f;
#pragma unroll
                    for (int ks = 0; ks < 4; ++ks) { const bf16x8 kf = *(const LAS bf16x8*)(F.lds + AT_KB + (kt * 32 + r32) * AT_ROW + (ks * 16 + h * 8) * 2); S = MFMA32(kf, qf[ks], S); }
#pragma unroll
                    for (int i = 0; i < 16; ++i) { const int n = kt * 32 + 8 * (i >> 2) + 4 * h + (i & 3); const float p = (n < nvalid) ? ex2(S[i] - mx) : 0.f; S[i] = p; rs += p; }
#pragma unroll
                    for (int a = 0; a < 4; ++a) {
                        const float x = S[4 * a + 3], y = xor32f(x, lane);
                        impv[kt * 4 + a] = (S[4 * a] + S[4 * a + 1] + S[4 * a + 2] + 0.5f * x) + 0.5f * (h ? y : yprev);
                        yprev = y;
                    }
#pragma unroll
                    for (int s2 = 0; s2 < 2; ++s2) { const int s = kt * 2 + s2, bb = 8 * s2;
                        v4u w; w.x = cvtpk(S[bb + 0], S[bb + 1]); w.y = cvtpk(S[bb + 2], S[bb + 3]); w.z = cvtpk(S[bb + 4], S[bb + 5]); w.w = cvtpk(S[bb + 6], S[bb + 7]);
                        const bf16x8 pf = __builtin_bit_cast(bf16x8, w);
#pragma unroll
                        for (int dt = 0; dt < 2; ++dt) { const LAS unsigned char* vp = F.lds + AT_VB + (dt * 32 + r32) * 272 + (16 * s + 4 * h) * 2;
                            const v2u lo = *(const LAS v2u*)vp, hi = *(const LAS v2u*)(vp + 16);
                            const v4u wv = {lo.x, lo.y, hi.x, hi.y};
                            Oc[dt] = MFMA32(__builtin_bit_cast(bf16x8, wv), pf, Oc[dt]); } }
                    __builtin_amdgcn_sched_barrier(0);
                }
                rs += xor32f(rs, lane);
                const float inv = rs > 0.f ? 1.f / rs : 0.f;
#pragma unroll
                for (int q = 0; q < 16; ++q) IMP[(r * 64 + tl) * 32 + 8 * (q >> 2) + 2 * (q & 3) + h] = impv[q] * inv;
                const float gi = g0 * inv;
#pragma unroll
                for (int i = 0; i < 16; ++i) { OL[i * 64] += gi * Oc[0][i]; OL[(16 + i) * 64] += gi * Oc[1][i]; }
            }
            __syncthreads();
#pragma unroll 1
            for (int i = 0; i < 4; ++i) {
                const int idx = tid + 512 * i, tok = idx >> 5, j = idx & 31;
                const float v = ((IMP[(0 * 64 + tok) * 32 + j] + IMP[(1 * 64 + tok) * 32 + j]) + IMP[(2 * 64 + tok) * 32 + j]) + IMP[(3 * 64 + tok) * 32 + j];
                const bool causal = j <= qb, forced = (j == 0) || (j == qb) || (j == qb - 1);
                const float val = causal ? (forced ? INFINITY : v) : -1.f;
                int rank = 0;
#pragma unroll
                for (int i2 = 0; i2 < 32; ++i2) { const int vb = __builtin_bit_cast(int, val); const float vlo = __builtin_bit_cast(float, __builtin_amdgcn_readlane(vb, i2)), vhi = __builtin_bit_cast(float, __builtin_amdgcn_readlane(vb, 32 + i2));
                    const float vi = (lane < 32) ? vlo : vhi; rank += ((vi > val) || (vi == val && i2 < j)) ? 1 : 0; }
                const unsigned long long bal = __ballot((rank < 16) && causal);
                if (lane == 0) SEL[tok] = (unsigned)bal;
                if (lane == 32) SEL[tok] = (unsigned)(bal >> 32);
            }
            __syncthreads();
            const unsigned mysel = SEL[tl];
            {
                f32x16 O[2]; float m = -1e30f, l = 0.f;
#pragma unroll
                for (int i = 0; i < 16; ++i) { O[0][i] = 0.f; O[1][i] = 0.f; }
                attn_branch<false>(Fu, KS, VST, bg, qb, 0, qb, qf, O, m, l, mysel, tl);
                l += xor32f(l, lane);
                const float sc = g1 / l;
                GASQ bf16* op = (GASQ bf16*)(MIX + mrow * D + 512 + (g * 4 + r) * 64 + 4 * h);
#pragma unroll
                for (int dt = 0; dt < 2; ++dt)
#pragma unroll
                    for (int a = 0; a < 4; ++a) { float o[4];
#pragma unroll
                        for (int c = 0; c < 4; ++c) o[c] = OL[(dt * 16 + 4 * a + c) * 64] + sc * O[dt][4 * a + c];
                        v2u w; w.x = cvtpk(o[0], o[1]); w.y = cvtpk(o[2], o[3]); *(GASQ v2u*)(op + dt * 32 + 8 * a) = w; }
            }
        }
    }
    if (waiting) xcd_wait(*pending);
}

__device__ __forceinline__ void conv_seam_rows(const Frame& F, int pm) {
    const ArgsV A = args_view(F); GASQ bf16* ACT = GP(bf16, A.ws + WS_U); const GASQ bf16* HEAD = GCP(bf16, A.ws + WS_HALO); const GASQ bf16* TAIL = HEAD + (size_t)64 * 2 * FF2;
    const GASQ float* cw = GCP(float, A.in[17]); const GASQ float* cb = GCP(float, A.in[18]);
#pragma unroll
    for (int it6 = 0; it6 < 6; ++it6) {
        const int c = F.tid + it6 * NTHR; if (c >= FF) break;
        const GASQ bf16* h0 = HEAD + ((size_t)pm * 2) * FF2; const GASQ bf16* h1 = h0 + FF2;
        const float a0 = bf2f(h0[c]), a1 = bf2f(h1[c]), v0 = bf2f(h0[FF + c]), v1 = bf2f(h1[FF + c]);
        float ta0 = 0.f, ta1 = 0.f, tv0 = 0.f, tv1 = 0.f;
        if (pm & 7) { const GASQ bf16* t0 = TAIL + ((size_t)(pm - 1) * 2) * FF2; const GASQ bf16* t1 = t0 + FF2; ta0 = bf2f(t0[c]); ta1 = bf2f(t1[c]); tv0 = bf2f(t0[FF + c]); tv1 = bf2f(t1[FF + c]); }
        const float wa0 = cw[c], wa1 = cw[FF2 + c], wa2 = cw[2 * FF2 + c], ba = cb[c], wv0 = cw[FF + c], wv1 = cw[FF2 + FF + c], wv2 = cw[2 * FF2 + FF + c], bv = cb[FF + c];
        const float ya0 = ba + wa0 * ta0 + wa1 * ta1 + wa2 * a0, yv0 = bv + wv0 * tv0 + wv1 * tv1 + wv2 * v0;
        const float ya1 = ba + wa0 * ta1 + wa1 * a0 + wa2 * a1, yv1 = bv + wv0 * tv1 + wv1 * v0 + wv2 * v1;
        ACT[((size_t)pm * 256) * FF + c] = (bf16)f2bf(siluf_(ya0) * yv0);
        ACT[((size_t)pm * 256 + 1) * FF + c] = (bf16)f2bf(siluf_(ya1) * yv1);
    }
    asm volatile("s_waitcnt vmcnt(0)" ::: "memory");
    __syncthreads();
}

#define XB_TMO      128
#define XB_XCNT(j)  (256  + 64 * (j))
#define XB_XSUB(j)  (1280 + 64 * (j))
#define XB_XGEN(j)  (2304 + 64 * (j))
#define XB_TOP      3328
#define XB_TOPGEN   3392
#define XCD_BAR_WORDS 3456
#define XB_SPIN_CAP (1u << 18)

__device__ __forceinline__ unsigned xb_ld(unsigned* p)              { return __hip_atomic_load(p, __ATOMIC_RELAXED, __HIP_MEMORY_SCOPE_AGENT); }
__device__ __forceinline__ unsigned xb_add(unsigned* p, unsigned v) { return __hip_atomic_fetch_add(p, v, __ATOMIC_RELAXED, __HIP_MEMORY_SCOPE_AGENT); }
__device__ __forceinline__ unsigned xb_xcc_id() { return (unsigned)__builtin_amdgcn_s_getreg((3 << 11) | 20) & 0xFu; }
#define XB_SPIN(cond, bar) do { unsigned _sp = 0; while (cond) { __builtin_amdgcn_s_sleep(1); \
    if ((++_sp & 255u) == 0u) { if (xb_ld(&(bar)[XB_TMO])) break; if (_sp > XB_SPIN_CAP) { atomicAdd(&(bar)[XB_TMO], 1u); break; } } } } while (0)

struct XcdBarrier {
    unsigned* bar; unsigned x;
    volatile LAS unsigned* st;
};

__device__ __forceinline__ XcdBarrier xcd_barrier_post(unsigned* bar, volatile LAS unsigned* st) {
    XcdBarrier b; b.bar = bar; b.x = xb_xcc_id(); b.st = st;
    if (threadIdx.x == 0) (void)xb_add(&bar[XB_XCNT(b.x)], 1u);
    return b;
}
__device__ __forceinline__ void xcd_barrier_complete(unsigned* bar, unsigned x, unsigned& nloc, unsigned& nx) {
    const unsigned G = gridDim.x * gridDim.y * gridDim.z;
    unsigned sum, cnt, mine, sp = 0u;
    for (;;) {
        sum = 0u; cnt = 0u; mine = 0u;
#pragma unroll
        for (unsigned j = 0; j < 16; ++j) { const unsigned c = xb_ld(&bar[XB_XCNT(j)]); sum += c; cnt += (c > 0u) ? 1u : 0u; mine = (j == x) ? c : mine; }
        if (sum == G) break;
        __builtin_amdgcn_s_sleep(1);
        if ((++sp & 255u) == 0u) { if (xb_ld(&bar[XB_TMO])) break; if (sp > XB_SPIN_CAP) { atomicAdd(&bar[XB_TMO], 1u); break; } }
    }
    nloc = mine > 0u ? mine : 1u; nx = cnt > 0u ? cnt : 1u;
}

__device__ __forceinline__ void xcd_arrive(const XcdBarrier& b) {
    asm volatile("s_waitcnt vmcnt(0)" ::: "memory");
    __syncthreads();
    if (threadIdx.x == 0) {
        unsigned* bar = b.bar;
        __builtin_amdgcn_s_waitcnt(0);
        unsigned nloc = b.st[0], nx = b.st[1];
        if (nloc == 0u) { xcd_barrier_complete(bar, b.x, nloc, nx); b.st[0] = nloc; b.st[1] = nx; }
        const unsigned old = xb_add(&bar[XB_XSUB(b.x)], 1u);
        const unsigned gen = old / nloc;
        if (old + 1u == (gen + 1u) * nloc) {
            __builtin_amdgcn_fence(__ATOMIC_RELEASE, "agent");
            asm volatile("s_waitcnt vmcnt(0)" ::: "memory");
            const unsigned og = xb_add(&bar[XB_TOP], 1u);
            const unsigned tg = og / nx;
            if (og + 1u == (tg + 1u) * nx) xb_add(&bar[XB_TOPGEN], 1u);
        }
        b.st[2] = gen;
    }
}
__device__ __forceinline__ void xcd_wait(const XcdBarrier& b) {
    if (threadIdx.x == 0) {
        unsigned* bar = b.bar; const unsigned gen = b.st[2];
        XB_SPIN(xb_ld(&bar[XB_TOPGEN]) == gen, bar);
        __builtin_amdgcn_fence(__ATOMIC_ACQUIRE, "agent");
        asm volatile("s_waitcnt vmcnt(0)" ::: "memory");
    }
    __syncthreads();
}
__device__ __forceinline__ void xcd_barrier(const XcdBarrier& b) { xcd_arrive(b); xcd_wait(b); }


__global__ void __launch_bounds__(NTHR, 2) fwd_megakernel(Args args) {
    extern __shared__ __attribute__((aligned(16))) unsigned char lds_raw[];
    cg::grid_group grid = cg::this_grid();
    Frame F;
    F.lds = (LAS unsigned char*)lds_raw;
    F.wave = __builtin_amdgcn_readfirstlane((int)(threadIdx.x >> 6)); F.lane = opaque_lane(); F.tid = F.wave * 64 + F.lane;
    F.G = gridDim.x; F.blk = blockIdx.x;
    if (F.tid < 22) { const unsigned long long p = (F.tid < 20) ? (unsigned long long)args.in[F.tid < 20 ? F.tid : 0] : (F.tid == 20 ? (unsigned long long)args.out : (unsigned long long)args.ws);
        LAS unsigned* tab = (LAS unsigned*)(F.lds + ARGTAB); tab[2 * F.tid] = (unsigned)p; tab[2 * F.tid + 1] = (unsigned)(p >> 32); }
    if (F.tid == 0) { ((LAS unsigned*)(F.lds + ARGTAB + 192))[0] = 0u; ((LAS unsigned*)(F.lds + ARGTAB + 192))[1] = 0u; ((LAS unsigned*)(F.lds + ARGTAB + 192))[2] = 0u; }
    __syncthreads();
    const XcdBarrier xbar = xcd_barrier_post((unsigned*)(args.ws + WS_BAR), (volatile LAS unsigned*)(F.lds + ARGTAB + 192));
#define WSP ((unsigned char*)argp(F, 21))
#define OUTP ((float*)argp(F, 20))
#define PARTP (OUTP + (size_t)8 * 1024 * 1024)
    LAS unsigned char* glds = (LAS unsigned char*)lds_raw;
#define GRID_SYNC_CG() do { __builtin_amdgcn_fence(__ATOMIC_RELEASE, "agent"); asm volatile("s_waitcnt vmcnt(0) lgkmcnt(0)" ::: "memory"); grid.sync(); \
        __builtin_amdgcn_fence(__ATOMIC_ACQUIRE, "agent"); asm volatile("s_waitcnt vmcnt(0)" ::: "memory"); } while (0)
#define GRID_SYNC() xcd_barrier(xbar)

    phase0(phase_frame(F));
    xcd_arrive(xbar);
    if (gridDim.x == 0x7fffffffu) GRID_SYNC_CG();
    phase0b(phase_frame(F));
    xcd_wait(xbar);
    phase_norm_mod(phase_frame(F), argp(F, 0), argp(F, 5), 0, 1024, (bf16*)(WSP + WS_H));
    GRID_SYNC();
    {
        unsigned char* ws = WSP;
        pg8::Gemm g{(const bf16*)(ws + WS_H), (const bf16*)(ws + WS_WIN), 1024, 1024, 1024, 0};
        pg8::StaticOrder S; S.init(64, 14, F.G, F.blk, (size_t)256 * 1024 * 2, (size_t)256 * 1024 * 2);
        pg8::EpiBf16 E{(bf16*)(ws + WS_Z), ZLD, nullptr};
        pg8::gemm_phase<pg8::EpiBf16, pg8::StaticOrder, true>(glds, g, S, E, F.wave);
    }
    phase_c1(phase_frame(F), (64 * 14) % F.G);
    GRID_SYNC();
    phase_nsa_prep(phase_frame(F));
    phase_hg_prep(phase_frame(F), OUTP);
    GRID_SYNC();
    phase_hg_scan(phase_frame(F), OUTP);
    __syncthreads();
    {
        unsigned char* ws = WSP;
        pg8::Gemm g{(const bf16*)(ws + WS_KC), (const bf16*)(ws + WS_WC1), 256, 1024, 2048, 0};
        pg8::CmpOrder S{F.G, F.blk, (size_t)(WS_VC - WS_KC)};
        pg8::EpiPart E{PARTP};
        pg8::gemm_phase<pg8::EpiPart, pg8::CmpOrder, false>(glds, g, S, E, F.wave);
    }
    GRID_SYNC();
    phase_hg_norm(phase_frame(F), OUTP);
    phase_cmp_finish(phase_frame(F), PARTP);
    xcd_arrive(xbar);
    phase_nsa_attn(phase_frame(F), &xbar);
    GRID_SYNC();
    {
        unsigned char* ws = WSP;
        pg8::Gemm g{(const bf16*)(ws + WS_H), (const bf16*)(ws + WS_WOUT), 1024, 1024, 1024, 0};
        pg8::StaticOrder S; S.init(64, 4, F.G, F.blk, (size_t)256 * 1024 * 2, (size_t)256 * 1024 * 2);
        pg8::EpiRes E{argp(F, 0), OUTP, (const float*)(ws + WS_MOD) + 2048};
        pg8::gemm_phase<pg8::EpiRes, pg8::StaticOrder, true>(glds, g, S, E, F.wave);
    }
    if (F.G == 256) {
        pg8::StaticOrder S; S.init(64, 4, F.G, F.blk, 0, 0); pg8::Unit u0; (void)S.next(0, u0);
        unsigned* pc = (unsigned*)(WSP + WS_BAR) + 4096 + 64 * u0.pm;
        asm volatile("s_waitcnt vmcnt(0)" ::: "memory");
        __syncthreads();
        if (F.tid == 0) {
            __builtin_amdgcn_fence(__ATOMIC_RELEASE, "agent"); asm volatile("s_waitcnt vmcnt(0)" ::: "memory");
            (void)__hip_atomic_fetch_add(pc, 1u, __ATOMIC_RELAXED, __HIP_MEMORY_SCOPE_AGENT);
            unsigned spins = 0;
            while (__hip_atomic_load(pc, __ATOMIC_RELAXED, __HIP_MEMORY_SCOPE_AGENT) < 4u && ++spins < (1u << 22)) __builtin_amdgcn_s_sleep(1);
            __builtin_amdgcn_fence(__ATOMIC_ACQUIRE, "agent"); asm volatile("s_waitcnt vmcnt(0)" ::: "memory");
        }
        __syncthreads();
        const Frame Fp = phase_frame(F);
        norm_mod_rows(Fp, OUTP, argp(F, 15), 3072, 4096, (bf16*)(WSP + WS_H), u0.pm * 256 + u0.pn * 64 + Fp.wave, u0.pm * 256 + u0.pn * 64 + 64, NWAVES);
    } else {
        GRID_SYNC();
        phase_norm_mod(phase_frame(F), OUTP, argp(F, 15), 3072, 4096, (bf16*)(WSP + WS_H));
    }
    GRID_SYNC();
    {
        unsigned char* ws = WSP;
        pg8::Gemm g{(const bf16*)(ws + WS_H), (const bf16*)(ws + WS_WUP), 1024, 1024, 1024, 0};
        pg8::StaticOrder S; S.init(64, 22, F.G, F.blk, (size_t)256 * 1024 * 2, (size_t)256 * 1024 * 2);
        pg8::EpiConv E{(bf16*)(ws + WS_U), (bf16*)(ws + WS_HALO), (bf16*)(ws + WS_HALO) + (size_t)64 * 2 * FF2, argp(F, 17), argp(F, 18), (LAS float*)(glds + 131072)};
        pg8::gemm_phase<pg8::EpiConv, pg8::StaticOrder, true>(glds, g, S, E, F.wave);
    }
    GRID_SYNC();
    {
        unsigned char* ws = WSP;
        pg8::Gemm g{(const bf16*)(ws + WS_U), (const bf16*)(ws + WS_WDN), FF, FF, FF, 0};
        pg8::StaticOrder S; S.init(64, 4, F.G, F.blk, (size_t)256 * FF * 2, (size_t)256 * FF * 2);
        { pg8::Unit u0; for (int i = 0; S.next(i, u0); ++i) conv_seam_rows(phase_frame(F), u0.pm); }
        pg8::EpiRes E{OUTP, OUTP, (const float*)(ws + WS_MOD) + 5120};
        pg8::gemm_phase<pg8::EpiRes, pg8::StaticOrder, true>(glds, g, S, E, F.wave);
    }
}

extern "C" void kernel_launch(void* const* d_in, const int* in_sizes, int n_in, void* d_out, int out_size, void* d_ws, size_t ws_size, hipStream_t stream) {
    static int grid = 0;
    if (grid == 0) {
        if (n_in != 20 || out_size != M * D || ws_size < WS_END) { fprintf(stderr, "kernel_launch: unexpected shapes (n_in %d out %d ws %zu)\n", n_in, out_size, ws_size); grid = -1; return; }
        int dev = 0, cus = 0, per_cu = 0;
        (void)hipGetDevice(&dev);
        (void)hipDeviceGetAttribute(&cus, hipDeviceAttributeMultiprocessorCount, dev);
        if (hipFuncSetAttribute((const void*)fwd_megakernel, hipFuncAttributeMaxDynamicSharedMemorySize, LDS_BYTES) != hipSuccess) { fprintf(stderr, "kernel_launch: hipFuncSetAttribute failed\n"); }
        if (hipOccupancyMaxActiveBlocksPerMultiprocessor(&per_cu, (const void*)fwd_megakernel, NTHR, LDS_BYTES) != hipSuccess || per_cu < 1) { fprintf(stderr, "kernel_launch: occupancy query says %d\n", per_cu); per_cu = 1; }
        (void)hipGetLastError();
        grid = cus * 1;
        if (grid > 256) grid = 256;
    }
    if (grid < 0) return;
    (void)hipMemsetAsync((char*)d_ws + WS_BAR, 0, 32768, stream);
    Args a{};
    for (int i = 0; i < 20; ++i) a.in[i] = (const float*)d_in[i];
    a.out = (float*)d_out; a.ws = (unsigned char*)d_ws;
    void* kargs[] = {&a};
    hipError_t e = hipLaunchCooperativeKernel((const void*)fwd_megakernel, dim3(grid), dim3(NTHR), kargs, LDS_BYTES, stream);
    if (e != hipSuccess) fprintf(stderr, "cooperative launch failed: %s (grid %d)\n", hipGetErrorString(e), grid);
}
```

```cpp
#include <hip/hip_runtime.h>
#include <hip/hip_cooperative_groups.h>
#include <cstdio>
#include <cstdint>
namespace cg = cooperative_groups;

__device__ __forceinline__ int opaque_lane() { unsigned ones = ~0u; asm volatile("" : "+s"(ones)); return (int)__builtin_amdgcn_mbcnt_hi(ones, __builtin_amdgcn_mbcnt_lo(ones, 0u)); }
namespace pg8 {
#define PG8_LAS __attribute__((address_space(3)))
typedef unsigned short bf16_t;
typedef short bf16x8 __attribute__((ext_vector_type(8)));
typedef float f32x4 __attribute__((ext_vector_type(4)));
typedef unsigned u32x4 __attribute__((ext_vector_type(4)));
constexpr int BM = 256, BK = 64, HALF = 128, HTB = HALF * BK * 2, STAGE_BYTES = 8 * HTB, NXCD = 8, WGM = 8;

__host__ __device__ __forceinline__ int lds_byte(int r, int c) { const int st = (r >> 4) * 2 + (c >> 5), rr = r & 15, cc = c & 31, ob = rr * 64 + cc * 2; return st * 1024 + (ob ^ (((ob >> 9) & 1) << 5)); }
__host__ __device__ __forceinline__ void stage_rc(int b, int& R, int& C) { const int st = b / 1024, sb = b % 1024, swz = sb ^ (((sb >> 9) & 1) << 5); R = (st >> 1) * 16 + swz / 64; C = (st & 1) * 32 + (swz % 64) / 2; }
__host__ __device__ __forceinline__ int perm32(int rho) { const int n = rho >> 4, i = rho & 15; return 8 * (i >> 2) + 4 * n + (i & 3); }

struct Unit { int pm, pn, z, pad; size_t aoff, boff; };
struct Gemm { const bf16_t* A; const bf16_t* Bt; int K, lda, ldb, pad; };

struct StaticOrder {
    int nM, nN, nwg, G, c; size_t tsA, tsB;
    __device__ void init(int nM_, int nN_, int G_, int c_, size_t tsA_, size_t tsB_) { nM = nM_; nN = nN_; nwg = nM * nN; G = G_; c = c_; tsA = tsA_; tsB = tsB_; }
    __device__ bool next(int i, Unit& u) const {
        const long L = (long)i * G + c; if (L >= nwg) return false;
        int wgid = (int)L; { const int q = nwg / NXCD, r = nwg % NXCD, xcd = wgid % NXCD, off = wgid / NXCD; wgid = (xcd < r ? xcd * (q + 1) : r * (q + 1) + (xcd - r) * q) + off; }
        const int nig = WGM * nN, gid = wgid / nig, fm = gid * WGM, gsz = (nM - fm) < WGM ? (nM - fm) : WGM;
        u.pm = fm + ((wgid % nig) % gsz); u.pn = (wgid % nig) / gsz; u.z = 0; u.pad = 0; u.aoff = (size_t)u.pm * tsA; u.boff = (size_t)u.pn * tsB; return true;
    }
    __device__ __forceinline__ void a_ready(const Unit&) const {}
    __device__ __forceinline__ void done(const Unit&) const {}
};
struct CmpOrder {
    int G, c; size_t vdelta;
    __device__ bool next(int i, Unit& u) const {
        const long L = (long)i * G + c; if (L >= 128) return false;
        const int mlp = (int)L / 64, rem = (int)L % 64, pm = rem / 8, ks = rem % 8;
        u.pm = pm; u.pn = 0; u.z = mlp * 8 + ks; u.pad = 0;
        u.aoff = (mlp ? vdelta : 0) + (size_t)pm * 256 * 1024 * 2 + (size_t)ks * 512;
        u.boff = (size_t)mlp * 256 * 2048 * 2 + (size_t)ks * 512; return true;
    }
    __device__ __forceinline__ void a_ready(const Unit&) const {}
    __device__ __forceinline__ void done(const Unit&) const {}
};

__device__ __forceinline__ unsigned cvt_pk_bf16(float lo, float hi) { unsigned r; asm volatile("v_cvt_pk_bf16_f32 %0, %1, %2" : "=v"(r) : "v"(lo), "v"(hi)); return r; }

struct EpiBf16 {
    static constexpr bool PERM = true, AFTER_DRAIN = false;
    bf16_t* O; int ldc; bf16_t* halo;
    __device__ __forceinline__ void operator()(const f32x4 (&acc)[2][2][4][2], const Unit& u, int wr, int wc, int fr, int fq) const {
        const int row0 = u.pm * BM + wr * 64 + fr; const int col0 = u.pn * BM + wc * 32 + 8 * fq;
#pragma unroll
        for (int ai = 0; ai < 2; ++ai)
#pragma unroll
            for (int m = 0; m < 4; ++m) { const int row = row0 + ai * HALF + m * 16; bf16_t* rowp = O + (size_t)row * ldc + col0;
#pragma unroll
                for (int bj = 0; bj < 2; ++bj) { const f32x4 v0 = acc[ai][bj][m][0], v1 = acc[ai][bj][m][1];
                    u32x4 w; w.x = cvt_pk_bf16(v0[0], v0[1]); w.y = cvt_pk_bf16(v0[2], v0[3]); w.z = cvt_pk_bf16(v1[0], v1[1]); w.w = cvt_pk_bf16(v1[2], v1[3]);
                    *(u32x4*)(rowp + bj * HALF) = w;
                    if (halo != nullptr && m == 3 && fr >= 14) *(u32x4*)(halo + ((size_t)(row >> 6) * 2 + (fr - 14)) * ldc + col0 + bj * HALF) = w; } }
    }
};
struct EpiRes {
    static constexpr bool PERM = false, AFTER_DRAIN = false;
    const float* base; float* out; const float* gate;
    __device__ __forceinline__ void operator()(const f32x4 (&acc)[2][2][4][2], const Unit& u, int wr, int wc, int fr, int fq) const {
        const int row0 = u.pm * BM + wr * 64 + fr, col0 = u.pn * BM + wc * 32 + 4 * fq; const int b = (u.pm * BM) / 2048;
        f32x4 gv[2][2];
#pragma unroll
        for (int bj = 0; bj < 2; ++bj)
#pragma unroll
            for (int n = 0; n < 2; ++n) gv[bj][n] = *(const f32x4*)(gate + (size_t)b * 6144 + col0 + bj * HALF + n * 16);
#pragma unroll
        for (int ai = 0; ai < 2; ++ai)
#pragma unroll
            for (int m = 0; m < 4; ++m) { const size_t ro = (size_t)(row0 + ai * HALF + m * 16) * 1024 + col0;
#pragma unroll
                for (int bj = 0; bj < 2; ++bj)
#pragma unroll
                    for (int n = 0; n < 2; ++n) { const f32x4 xv = *(const f32x4*)(base + ro + bj * HALF + n * 16); *(f32x4*)(out + ro + bj * HALF + n * 16) = xv + gv[bj][n] * acc[ai][bj][m][n]; } }
    }
};
struct EpiPart {
    static constexpr bool PERM = false, AFTER_DRAIN = false;
    float* P;
    __device__ __forceinline__ void operator()(const f32x4 (&acc)[2][2][4][2], const Unit& u, int wr, int wc, int fr, int fq) const {
        const int row0 = u.pm * BM + wr * 64 + fr, col0 = wc * 32 + 4 * fq;
#pragma unroll
        for (int ai = 0; ai < 2; ++ai)
#pragma unroll
            for (int m = 0; m < 4; ++m) { float* rowp = P + ((size_t)u.z * 2048 + row0 + ai * HALF + m * 16) * 256 + col0;
#pragma unroll
                for (int bj = 0; bj < 2; ++bj)
#pragma unroll
                    for (int n = 0; n < 2; ++n) *(f32x4*)(rowp + bj * HALF + n * 16) = acc[ai][bj][m][n]; }
    }
};


__device__ __forceinline__ float dpp_ror1(float x) { return __builtin_bit_cast(float, __builtin_amdgcn_update_dpp(0, __builtin_bit_cast(int, x), 0x121, 0xf, 0xf, false)); }
__device__ __forceinline__ float dpp_ror2(float x) { return __builtin_bit_cast(float, __builtin_amdgcn_update_dpp(0, __builtin_bit_cast(int, x), 0x122, 0xf, 0xf, false)); }
__device__ __forceinline__ float dpp_shr1(float old, float x) { return __builtin_bit_cast(float, __builtin_amdgcn_update_dpp(__builtin_bit_cast(int, old), __builtin_bit_cast(int, x), 0x111, 0xf, 0xf, false)); }
__device__ __forceinline__ float dpp_shr2(float old, float x) { return __builtin_bit_cast(float, __builtin_amdgcn_update_dpp(__builtin_bit_cast(int, old), __builtin_bit_cast(int, x), 0x112, 0xf, 0xf, false)); }
struct EpiConv {
    static constexpr bool PERM = true, AFTER_DRAIN = false;
    bf16_t* ACT; bf16_t* head; bf16_t* tail; const float* cw; const float* cb; PG8_LAS float* xb;
    __device__ __forceinline__ void operator()(const f32x4 (&acc)[2][2][4][2], const Unit& u, int wr, int wc, int fr, int fq) const {
        typedef __attribute__((address_space(1))) bf16_t gbf; typedef __attribute__((address_space(1))) unsigned gu32_;
        const int colh = wc * 32 + 8 * fq, FFc = 2816, FF2c = 5632;
        typedef __attribute__((address_space(1))) f32x4 gf4;
        f32x4 WA[2][3], WV[2][3], BA[2], BV[2];
#pragma unroll
        for (int n = 0; n < 2; ++n) { const int ca = u.pn * 128 + colh + 4 * n;
#pragma unroll
            for (int j = 0; j < 3; ++j) { WA[n][j] = *(const gf4*)(cw + j * FF2c + ca); WV[n][j] = *(const gf4*)(cw + j * FF2c + FFc + ca); }
            BA[n] = *(const gf4*)(cb + ca); BV[n] = *(const gf4*)(cb + FFc + ca); }
        if (fr >= 14) {
#pragma unroll
            for (int ai = 0; ai < 2; ++ai)
#pragma unroll
                for (int bj = 0; bj < 2; ++bj)
#pragma unroll
                    for (int n = 0; n < 2; ++n) *(PG8_LAS f32x4*)(xb + ((ai * 2 + wr) * 2 + (fr - 14)) * 256 + bj * 128 + colh + 4 * n) = acc[ai][bj][3][n];
            if (wr == 1) {
#pragma unroll
                for (int bj = 0; bj < 2; ++bj)
#pragma unroll
                    for (int n = 0; n < 2; ++n) { const f32x4 v = acc[1][bj][3][n]; gu32_* p = (gu32_*)((gbf*)tail + ((size_t)u.pm * 2 + (fr - 14)) * FF2c + bj * FFc + u.pn * 128 + colh + 4 * n);
                        p[0] = cvt_pk_bf16(v[0], v[1]); p[1] = cvt_pk_bf16(v[2], v[3]); }
            }
        }
        if (fr < 2 && wr == 0) {
#pragma unroll
            for (int bj = 0; bj < 2; ++bj)
#pragma unroll
                for (int n = 0; n < 2; ++n) { const f32x4 v = acc[0][bj][0][n]; gu32_* p = (gu32_*)((gbf*)head + ((size_t)u.pm * 2 + fr) * FF2c + bj * FFc + u.pn * 128 + colh + 4 * n);
                    p[0] = cvt_pk_bf16(v[0], v[1]); p[1] = cvt_pk_bf16(v[2], v[3]); }
        }
        asm volatile("s_waitcnt lgkmcnt(0)" ::: "memory"); __builtin_amdgcn_s_barrier(); asm volatile("" ::: "memory");
#pragma unroll
        for (int n = 0; n < 2; ++n) {
            const int ca = u.pn * 128 + colh + 4 * n;
            const f32x4 wa0 = WA[n][0], wa1 = WA[n][1], wa2 = WA[n][2], ba = BA[n], wv0 = WV[n][0], wv1 = WV[n][1], wv2 = WV[n][2], bv = BV[n];
#pragma unroll
            for (int ai = 0; ai < 2; ++ai) {
                const int sai = (ai == 0) ? 0 : (wr == 0 ? 0 : 1), swr = (ai == 0) ? 0 : (wr == 0 ? 1 : 0);
                const bool has = !(ai == 0 && wr == 0);
                f32x4 pa = {0.f, 0.f, 0.f, 0.f}, pv = {0.f, 0.f, 0.f, 0.f};
                if (fr >= 14 && has) { pa = *(const PG8_LAS f32x4*)(xb + ((sai * 2 + swr) * 2 + (fr - 14)) * 256 + colh + 4 * n); pv = *(const PG8_LAS f32x4*)(xb + ((sai * 2 + swr) * 2 + (fr - 14)) * 256 + 128 + colh + 4 * n); }
#pragma unroll
                for (int m = 0; m < 4; ++m) {
                    const f32x4 xa = acc[ai][0][m][n], xv = acc[ai][1][m][n];
                    float res[4];
#pragma unroll
                    for (int c = 0; c < 4; ++c) {
                        const float a1 = dpp_shr1(dpp_ror1(pa[c]), xa[c]), a2 = dpp_shr2(dpp_ror2(pa[c]), xa[c]);
                        const float v1 = dpp_shr1(dpp_ror1(pv[c]), xv[c]), v2 = dpp_shr2(dpp_ror2(pv[c]), xv[c]);
                        const float ya = ba[c] + wa0[c] * a2 + wa1[c] * a1 + wa2[c] * xa[c];
                        const float yv = bv[c] + wv0[c] * v2 + wv1[c] * v1 + wv2[c] * xv[c];
                        res[c] = ya * __builtin_amdgcn_rcpf(1.f + __builtin_amdgcn_exp2f(-1.4426950408889634f * ya)) * yv;
                    }
                    gu32_* p = (gu32_*)((gbf*)ACT + (size_t)(u.pm * BM + ai * HALF + wr * 64 + m * 16 + fr) * FFc + ca);
                    p[0] = cvt_pk_bf16(res[0], res[1]); p[1] = cvt_pk_bf16(res[2], res[3]);
                    pa = xa; pv = xv;
                }
            }
        }
    }
};

template <class Epi, class Sched, bool ALIGN_EPI>
__device__ __forceinline__ void gemm_phase(PG8_LAS unsigned char* lds, const Gemm g, const Sched& S, const Epi& E, int wave_id) {
    const int wid = wave_id, lane = opaque_lane(), tid = wid * 64 + lane, wr = wid >> 2, wc = wid & 3, fr = lane & 15, fq = lane >> 4;
    const int K = g.K, nt = K / BK;
    unsigned voffA[2], voffB[2];
#pragma unroll
    for (int i = 0; i < 2; ++i) { int R, C; stage_rc(tid * 16 + i * 8192, R, C); const int Rb = Epi::PERM ? ((R & ~31) + perm32(R & 31)) : R;
        voffA[i] = (unsigned)(R * g.lda + C) * 2u; voffB[i] = (unsigned)(Rb * g.ldb + C) * 2u; }
    const size_t kstep = (size_t)(BK * 2);
    const size_t hsA = (size_t)HALF * g.lda * 2, hsB = (size_t)HALF * g.ldb * 2;
    const unsigned ldsw = (unsigned)wid * 1024u;
    const int aoff = lds_byte(wr * 64 + fr, fq * 8), boff = lds_byte(wc * 32 + fr, fq * 8);
#define PG8_SA(b, h) (((b) * 2 + (h)) * HTB)
#define PG8_SB(b, h) ((4 + (b) * 2 + (h)) * HTB)
#define PG8_STAGE(bufoff, gbase, voff) do { _Pragma("unroll") for (int _i = 0; _i < 2; ++_i) \
        __builtin_amdgcn_global_load_lds((const unsigned*)((const char*)(gbase) + (voff)[_i]), (PG8_LAS unsigned*)(lds + (bufoff) + ldsw + _i * 8192), 16, 0, 0); } while (0)
#define PG8_LDA(dst, b, h) do { _Pragma("unroll") for (int m = 0; m < 4; ++m) _Pragma("unroll") for (int k = 0; k < 2; ++k) dst[m][k] = *(const PG8_LAS bf16x8*)(lds + PG8_SA(b, h) + aoff + m * 2048 + k * 1024); } while (0)
#define PG8_LDB(dst, b, h) do { _Pragma("unroll") for (int n = 0; n < 2; ++n) _Pragma("unroll") for (int k = 0; k < 2; ++k) dst[n][k] = *(const PG8_LAS bf16x8*)(lds + PG8_SB(b, h) + boff + n * 2048 + k * 1024); } while (0)
#define PG8_MMA(ai, bj, At, Bt) do { __builtin_amdgcn_s_setprio(1); _Pragma("unroll") for (int m = 0; m < 4; ++m) _Pragma("unroll") for (int n = 0; n < 2; ++n) _Pragma("unroll") for (int k = 0; k < 2; ++k) \
        acc[ai][bj][m][n] = __builtin_amdgcn_mfma_f32_16x16x32_bf16(Bt[n][k], At[m][k], acc[ai][bj][m][n], 0, 0, 0); __builtin_amdgcn_s_setprio(0); } while (0)
#define PG8_WAIT_V(n) asm volatile("s_waitcnt vmcnt(" #n ")" ::: "memory")
#define PG8_WAIT_L(n) asm volatile("s_waitcnt lgkmcnt(" #n ")" ::: "memory")
#define PG8_BAR __builtin_amdgcn_s_barrier()
#define PG8_SCHED __builtin_amdgcn_sched_barrier(0)
    Unit cur, nxt; int ui = 0;
    if (!S.next(0, cur)) return;
    f32x4 acc[2][2][4][2];
#pragma unroll
    for (int a = 0; a < 2; ++a)
#pragma unroll
        for (int b = 0; b < 2; ++b)
#pragma unroll
            for (int m = 0; m < 4; ++m)
#pragma unroll
                for (int n = 0; n < 2; ++n) acc[a][b][m][n] = (f32x4){0.f, 0.f, 0.f, 0.f};
    bf16x8 At[4][2], B0[2][2], B1[2][2];
    const char* cA = (const char*)g.A + cur.aoff; const char* cB = (const char*)g.Bt + cur.boff;
    S.a_ready(cur);
    PG8_STAGE(PG8_SB(0, 0), cB, voffB); PG8_STAGE(PG8_SB(0, 1), cB + hsB, voffB); PG8_STAGE(PG8_SA(0, 0), cA, voffA); PG8_STAGE(PG8_SA(0, 1), cA + hsA, voffA);
    if (wr == 1) PG8_BAR;
    PG8_WAIT_V(2); PG8_BAR;
    PG8_STAGE(PG8_SB(1, 0), cB + kstep, voffB); PG8_STAGE(PG8_SA(1, 0), cA + kstep, voffA); PG8_STAGE(PG8_SB(1, 1), cB + hsB + kstep, voffB);
    PG8_WAIT_V(6); PG8_BAR;
    for (;;) {
        const bool has_next = S.next(ui + 1, nxt);
        const char* nA = has_next ? (const char*)g.A + nxt.aoff : cA; const char* nB = has_next ? (const char*)g.Bt + nxt.boff : cB;
        for (int t = 0; t < nt; t += 2) {
            const bool last = (t == nt - 2);
            const char* a1 = cA + (size_t)(t + 1) * kstep;
            const char* a2 = last ? nA : cA + (size_t)(t + 2) * kstep; const char* b2 = last ? nB : cB + (size_t)(t + 2) * kstep;
            const char* a3 = a2 + kstep; const char* b3 = b2 + kstep;
            if (last && has_next) S.a_ready(nxt);
            PG8_LDB(B0, 0, 0); PG8_LDB(B1, 0, 1); PG8_SCHED; PG8_LDA(At, 0, 0); PG8_STAGE(PG8_SA(1, 1), a1 + hsA, voffA);
            PG8_WAIT_V(8); PG8_WAIT_L(0); PG8_BAR; PG8_MMA(0, 0, At, B0); PG8_MMA(0, 1, At, B1); PG8_BAR; PG8_SCHED;
            PG8_LDA(At, 0, 1); PG8_STAGE(PG8_SB(0, 0), b2, voffB); PG8_STAGE(PG8_SB(0, 1), b2 + hsB, voffB); PG8_STAGE(PG8_SA(0, 0), a2, voffA);
            PG8_WAIT_V(8); PG8_WAIT_L(0); PG8_BAR; PG8_MMA(1, 0, At, B0); PG8_MMA(1, 1, At, B1); PG8_BAR; PG8_SCHED;
            PG8_LDB(B0, 1, 0); PG8_LDB(B1, 1, 1); PG8_SCHED; PG8_LDA(At, 1, 0); PG8_STAGE(PG8_SA(0, 1), a2 + hsA, voffA);
            PG8_WAIT_V(8); PG8_WAIT_L(0); PG8_BAR; PG8_MMA(0, 0, At, B0); PG8_MMA(0, 1, At, B1); PG8_BAR; PG8_SCHED;
            PG8_LDA(At, 1, 1); PG8_STAGE(PG8_SB(1, 0), b3, voffB); PG8_STAGE(PG8_SB(1, 1), b3 + hsB, voffB); PG8_STAGE(PG8_SA(1, 0), a3, voffA);
            PG8_WAIT_V(8); PG8_WAIT_L(0); PG8_BAR; PG8_MMA(1, 0, At, B0); PG8_MMA(1, 1, At, B1); PG8_BAR; PG8_SCHED;
        }
        if constexpr (ALIGN_EPI) { if (wr == 0) PG8_BAR; }
        E(acc, cur, wr, wc, fr, fq); S.done(cur);
        if (!has_next) break;
#pragma unroll
        for (int a = 0; a < 2; ++a)
#pragma unroll
            for (int b = 0; b < 2; ++b)
#pragma unroll
                for (int m = 0; m < 4; ++m)
#pragma unroll
                    for (int n = 0; n < 2; ++n) acc[a][b][m][n] = (f32x4){0.f, 0.f, 0.f, 0.f};
        cur = nxt; cA = nA; cB = nB; ++ui;
        if constexpr (ALIGN_EPI) { if (wr == 1) PG8_BAR; }
    }
    PG8_WAIT_V(0);
    if constexpr (!ALIGN_EPI) { if (wr == 0) PG8_BAR; }
    PG8_BAR;
#undef PG8_SA
#undef PG8_SB
#undef PG8_STAGE
#undef PG8_LDA
#undef PG8_LDB
#undef PG8_MMA
#undef PG8_WAIT_V
#undef PG8_WAIT_L
#undef PG8_BAR
#undef PG8_SCHED
}
}

#define LAS __attribute__((address_space(3)))
#define GASQ __attribute__((address_space(1)))
#define GP(Tp, p) ((GASQ Tp*)(p))
#define GCP(Tp, p) ((const GASQ Tp*)(p))
typedef unsigned short bf16;
typedef float f32x4 __attribute__((ext_vector_type(4)));
typedef float f32x2 __attribute__((ext_vector_type(2)));
typedef unsigned v4u __attribute__((ext_vector_type(4)));
typedef unsigned v2u __attribute__((ext_vector_type(2)));

constexpr int NTHR = 512, NWAVES = 8;
constexpr int BSZ = 8, T = 2048, D = 1024, M = BSZ * T;
constexpr int ZLD = 3584, NZ = 3352, FF = 2816, FF2 = 5632, MODW = 6144;
constexpr int ZC_HQ = 0, ZC_HF = 512, ZC_HI = 1024, ZC_HG = 1536, ZC_NQ = 2048, ZC_KC = 2560, ZC_VC = 2688, ZC_KS = 2816, ZC_VS = 2944, ZC_KW = 3072, ZC_VW = 3200, ZC_NG = 3328;
constexpr float EPS = 1e-6f;
constexpr size_t MiB = 1u << 20;
constexpr size_t WS_WIN = 0, WS_WOUT = 7 * MiB, WS_WUP = 9 * MiB, WS_WDN = 20 * MiB, WS_WC1 = 26 * MiB;
constexpr size_t WS_MOD = 28 * MiB, WS_C1 = 28 * MiB + 256 * 1024, WS_KVCMP = 29 * MiB  , WS_HALO = 32 * MiB  ;
constexpr size_t WS_H = 40 * MiB  , WS_Z = 72 * MiB  ;
constexpr size_t WS_QN = 184 * MiB  , WS_KC = 200 * MiB, WS_VC = 205 * MiB, WS_KS = 210 * MiB, WS_VS = 215 * MiB, WS_KW = 220 * MiB, WS_VW = 225 * MiB;
constexpr size_t WS_U = 72 * MiB  , WS_END = 248 * MiB;
constexpr size_t WS_HGT = 229 * MiB  , WS_HVEC = 245 * MiB + 512 * 1024  ;
constexpr size_t WS_BAR = 39 * MiB;
constexpr int LDS_BYTES = 147456;

struct Args { const float* in[20]; float* out; unsigned char* ws; };

__device__ __forceinline__ unsigned f2bf(float f) { unsigned u = __builtin_bit_cast(unsigned, f); return (u + 0x7fffu + ((u >> 16) & 1u)) >> 16; }
__device__ __forceinline__ unsigned pk2(float lo, float hi) { return f2bf(lo) | (f2bf(hi) << 16); }
__device__ __forceinline__ float bf2f(unsigned short h) { return __builtin_bit_cast(float, (unsigned)h << 16); }
__device__ __forceinline__ float bflo(unsigned w) { return __builtin_bit_cast(float, w << 16); }
__device__ __forceinline__ float bfhi(unsigned w) { return __builtin_bit_cast(float, w & 0xffff0000u); }
#define DPPF(x, ctrl) __builtin_bit_cast(float, __builtin_amdgcn_update_dpp(0, __builtin_bit_cast(int, (x)), (ctrl), 0xf, 0xf, false))
__device__ __forceinline__ float wave_sum(float v) {
    v += DPPF(v, 0xB1); v += DPPF(v, 0x4E); v += DPPF(v, 0x141); v += DPPF(v, 0x140);
    v += __shfl_xor(v, 16);
    v += __shfl_xor(v, 32);
    return v;
}
__device__ __forceinline__ float wave_max(float v) {
    v = fmaxf(v, DPPF(v, 0xB1)); v = fmaxf(v, DPPF(v, 0x4E)); v = fmaxf(v, DPPF(v, 0x141)); v = fmaxf(v, DPPF(v, 0x140));
    v = fmaxf(v, __shfl_xor(v, 16));
    v = fmaxf(v, __shfl_xor(v, 32));
    return v;
}
__device__ __forceinline__ float xor32f(float x, int lane) { (void)lane; return __shfl_xor(x, 32); }
__device__ __forceinline__ float sigmoidf_(float x) { return __builtin_amdgcn_rcpf(1.f + __builtin_amdgcn_exp2f(-1.4426950408889634f * x)); }
__device__ __forceinline__ float siluf_(float x) { return x * __builtin_amdgcn_rcpf(1.f + __builtin_amdgcn_exp2f(-1.4426950408889634f * x)); }
#define LDS_FENCE() asm volatile("s_waitcnt lgkmcnt(0)" ::: "memory")
typedef short bf16x8 __attribute__((ext_vector_type(8)));
__device__ __forceinline__ float ex2(float x) { return __builtin_amdgcn_exp2f(x); }

struct Frame {
    LAS unsigned char* lds;
    int tid, lane, wave, G, blk;
};
constexpr int ARGTAB = 147200;
__device__ __forceinline__ const float* argp(const Frame& F, int k) {
    const LAS unsigned* tab = (const LAS unsigned*)(F.lds + ARGTAB);
    const unsigned lo = (unsigned)__builtin_amdgcn_readfirstlane((int)tab[2 * k]), hi = (unsigned)__builtin_amdgcn_readfirstlane((int)tab[2 * k + 1]);
    return (const float*)(((unsigned long long)hi << 32) | (unsigned long long)lo);
}
struct ArgsV { Frame F; struct InV { Frame F; __device__ __forceinline__ const float* operator[](int k) const { return argp(F, k); } } in; unsigned char* ws; float* out; };
__device__ __forceinline__ ArgsV args_view(const Frame& F) { ArgsV A; A.F = F; A.in.F = F; A.ws = (unsigned char*)argp(F, 21); A.out = (float*)argp(F, 20); return A; }
__device__ __forceinline__ Frame phase_frame(Frame F) { F.lane = opaque_lane(); F.tid = F.wave * 64 + F.lane; return F; }

template <bool UPMAP>
__device__ __forceinline__ void p0_transpose_item(const float* W, int K, int N, bf16* WT, LAS float* scr, int item, int nblk, int lane) {
    const int kb = item / nblk, nb = item % nblk, k0 = 64 * kb, n0 = 32 * nb;
    const int d0 = UPMAP ? ((n0 < FF) ? ((n0 >> 7) * 256 + (n0 & 127)) : ((((n0 - FF) >> 7) * 256) + 128 + ((n0 - FF) & 127))) : n0;
    const bool nok = (n0 + (lane & 31)) < N;
    float tv[32];
#pragma unroll
    for (int i = 0; i < 32; ++i) { const int kk = 2 * i + (lane >> 5); tv[i] = nok ? GCP(float, W)[(size_t)(k0 + kk) * N + n0 + (lane & 31)] : 0.f; }
#pragma unroll
    for (int i = 0; i < 32; ++i) { const int kk = 2 * i + (lane >> 5); scr[kk * 33 + (lane & 31)] = tv[i]; }
    if (false)
    for (int i = 0; i < 32; ++i) { const int kk = 2 * i + (lane >> 5); scr[kk * 33 + (lane & 31)] = nok ? GCP(float, W)[(size_t)(k0 + kk) * N + n0 + (lane & 31)] : 0.f; }
    LDS_FENCE();
    const int c = lane & 7;
#pragma unroll
    for (int j = 0; j < 4; ++j) { const int n = (lane >> 3) + 8 * j; const LAS float* s = scr + (8 * c) * 33 + n;
        v4u o; o.x = pk2(s[0 * 33], s[1 * 33]); o.y = pk2(s[2 * 33], s[3 * 33]); o.z = pk2(s[4 * 33], s[5 * 33]); o.w = pk2(s[6 * 33], s[7 * 33]);
        *GP(v4u, WT + (size_t)(d0 + n) * K + k0 + 8 * c) = o; }
    LDS_FENCE();
}

__device__ __forceinline__ void phase0(const Frame& F) {
    const ArgsV A = args_view(F); unsigned char* ws = A.ws;
    LAS float* sc = (LAS float*)F.lds;
    LAS float* red = (LAS float*)(F.lds + 32768);
    const float* c = A.in[1]; const float* w_ada = A.in[3]; const float* b_ada = A.in[4];
    float* mod = (float*)(ws + WS_MOD);
    { float cv[16];
#pragma unroll
      for (int i = 0; i < 16; ++i) cv[i] = GCP(float, c)[F.tid + i * NTHR];
#pragma unroll
      for (int i = 0; i < 16; ++i) sc[F.tid + i * NTHR] = siluf_(cv[i]); }
    __syncthreads();
    for (int cb = F.blk; cb < 256; cb += F.G) {
        const int n0 = cb * 24, col = F.tid % 24, kg = F.tid / 24;
        if (F.tid < 504) {
            float acc[8];
#pragma unroll
            for (int b = 0; b < 8; ++b) acc[b] = 0.f;
#pragma unroll 7
            for (int k = kg; k < 1024; k += 21) { const float w = GCP(float, w_ada)[(size_t)k * MODW + n0 + col];
#pragma unroll
                for (int b = 0; b < 8; ++b) acc[b] += sc[b * 1024 + k] * w; }
#pragma unroll
            for (int b = 0; b < 8; ++b) red[(kg * 24 + col) * 8 + b] = acc[b];
        }
        __syncthreads();
        if (F.tid < 192) { const int cc = F.tid % 24, b = F.tid / 24; float s = b_ada[n0 + cc];
            for (int g = 0; g < 21; ++g) s += red[(g * 24 + cc) * 8 + b];
            mod[b * MODW + n0 + cc] = s; }
        __syncthreads();
    }
    __syncthreads();
}
__device__ __forceinline__ void phase0b(const Frame& F) {
    const ArgsV A = args_view(F); unsigned char* ws = A.ws;
    LAS float* scr = (LAS float*)(F.lds + F.wave * 16384);
    const int gw = F.blk * NWAVES + F.wave, NGW = F.G * NWAVES;
    constexpr int I_IN = 16 * 105, I_OUT = 16 * 32, I_UP = 16 * 176, I_DN = 44 * 32, I_C1 = 32 * 8;
    constexpr int NITEMS = I_IN + I_OUT + I_UP + I_DN + 2 * I_C1;
    for (int it = gw; it < NITEMS; it += NGW) {
        int r = it;
        if (r < I_IN) { p0_transpose_item<false>(A.in[6], 1024, NZ, (bf16*)(ws + WS_WIN), scr, r, 105, F.lane); continue; } r -= I_IN;
        if (r < I_OUT) { p0_transpose_item<false>(A.in[14], 1024, 1024, (bf16*)(ws + WS_WOUT), scr, r, 32, F.lane); continue; } r -= I_OUT;
        if (r < I_UP) { p0_transpose_item<true>(A.in[16], 1024, FF2, (bf16*)(ws + WS_WUP), scr, r, 176, F.lane); continue; } r -= I_UP;
        if (r < I_DN) { p0_transpose_item<false>(A.in[19], FF, 1024, (bf16*)(ws + WS_WDN), scr, r, 32, F.lane); continue; } r -= I_DN;
        if (r < I_C1) { p0_transpose_item<false>(A.in[12], 2048, 256, (bf16*)(ws + WS_WC1), scr, r, 8, F.lane); continue; } r -= I_C1;
        p0_transpose_item<false>(A.in[12] + (size_t)2048 * 256, 2048, 256, (bf16*)(ws + WS_WC1) + (size_t)256 * 2048, scr, r, 8, F.lane);
    }
    { v4u* z = (v4u*)((bf16*)(ws + WS_WIN) + (size_t)3360 * 1024); const int n16 = 224 * 1024 * 2 / 16;
      for (int i = F.blk * NTHR + F.tid; i < n16; i += F.G * NTHR) z[i] = (v4u){0u, 0u, 0u, 0u}; }
}

__device__ __forceinline__ void phase_c1(const Frame& F, int blk0) {
    if (F.blk < blk0) return;
    const ArgsV A = args_view(F); unsigned char* ws = A.ws;
    const GASQ float* pe = GCP(float, A.in[11]); const GASQ float* w1 = GCP(float, A.in[12]); GASQ float* c1p = GP(float, ws + WS_C1);
    for (int it = (F.blk - blk0) * NWAVES + F.wave; it < 128; it += (F.G - blk0) * NWAVES) {
        const int ks = it >> 3, i = (it >> 2) & 1, j = (it & 3) * 64 + F.lane;
        float s = 0.f;
#pragma unroll 8
        for (int k = ks * 128; k < ks * 128 + 128; ++k) s += pe[i * 2048 + k] * w1[((size_t)i * 2048 + k) * 256 + j];
        c1p[(ks * 2 + i) * 256 + j] = s;
    }
}
__device__ __forceinline__ void norm_mod_rows(const Frame& F, const float* x, const float* g, int sh_off, int sc_off, bf16* H, int m_begin, int m_end, int m_step) {
    const float* mod = (const float*)((unsigned char*)argp(F, 21) + WS_MOD);
    for (int m0 = m_begin; m0 < m_end; m0 += 2 * m_step) {
        const int m1 = m0 + m_step; const bool two = m1 < m_end; const int mm[2] = {m0, two ? m1 : m0};
        f32x4 v[2][4]; float s[2] = {0.f, 0.f};
#pragma unroll
        for (int r = 0; r < 2; ++r) { const GASQ f32x4* xr = GCP(f32x4, x + (size_t)mm[r] * D) + F.lane;
#pragma unroll
            for (int j = 0; j < 4; ++j) v[r][j] = xr[64 * j]; }
#pragma unroll
        for (int r = 0; r < 2; ++r)
#pragma unroll
            for (int j = 0; j < 4; ++j) s[r] += (v[r][j].x * v[r][j].x + v[r][j].y * v[r][j].y) + (v[r][j].z * v[r][j].z + v[r][j].w * v[r][j].w);
#pragma unroll
        for (int r = 0; r < 2; ++r) {
            if (r == 1 && !two) break;
            const int m = mm[r], b = m / T;
            const float rstd = rsqrtf(wave_sum(s[r]) * (1.f / D) + EPS);
            GASQ v2u* o8 = GP(v2u, H + (size_t)m * D) + F.lane;
#pragma unroll
            for (int j = 0; j < 4; ++j) {
                const int k = (F.lane + 64 * j) * 4;
                const f32x4 gg = *GCP(f32x4, g + k), sc = *GCP(f32x4, mod + b * MODW + sc_off + k), sh = *GCP(f32x4, mod + b * MODW + sh_off + k);
                const f32x4 y = v[r][j] * rstd * gg * (sc + 1.f) + sh;
                v2u w; w.x = pk2(y.x, y.y); w.y = pk2(y.z, y.w); o8[64 * j] = w;
            }
        }
    }
}
__device__ __forceinline__ void phase_norm_mod(const Frame& F, const float* x, const float* g, int sh_off, int sc_off, bf16* H) {
    norm_mod_rows(F, x, g, sh_off, sc_off, H, F.blk * NWAVES + F.wave, M, F.G * NWAVES);
}
__device__ __forceinline__ void phase_nsa_prep(const Frame& F) {
    const ArgsV A = args_view(F); unsigned char* ws = A.ws;
    const GASQ bf16* Z = GCP(bf16, ws + WS_Z);
    const GASQ int* pos = GCP(int, A.in[2]);
    const int gw = F.blk * NWAVES + F.wave, NGW = F.G * NWAVES, lane = F.lane;
    const float invt[8] = {1.0f, 0.1939227432012558f, 0.03760603070259094f, 0.007292664609849453f, 0.0014142135623842478f, 0.00027424818836152554f, 5.3182957344688475e-05f, 1.0313385246263351e-05f};
    float inv = 0.f;
#pragma unroll
    for (int i = 0; i < 8; ++i) inv = ((lane & 7) == i) ? invt[i] : inv;
    const float gq = GCP(float, A.in[9])[lane], gk0 = GCP(float, A.in[10])[lane], gk1 = GCP(float, A.in[10])[64 + lane], gk2 = GCP(float, A.in[10])[128 + lane];
    for (int m = gw; m < M; m += NGW) {
        const int b = m / T, t = m % T;
        const GASQ bf16* zr = Z + (size_t)m * ZLD + ZC_NQ + lane;
        unsigned short zv[20];
#pragma unroll
        for (int v = 0; v < 20; ++v) zv[v] = (v == 14 || v == 15 || v == 18 || v == 19) ? (unsigned short)0 : zr[v * 64];
        const float rev = (float)pos[m] * inv * 0.15915494309189535f;
        const float fr = rev - floorf(rev);
        const float cs = __builtin_amdgcn_cosf(fr), sn = __builtin_amdgcn_sinf(fr);
#pragma unroll
        for (int v = 0; v < 20; ++v) {
            if (v == 14 || v == 15 || v == 18 || v == 19) continue;
            GASQ bf16* dst;
            if (v < 8) dst = GP(bf16, ws + WS_QN) + ((size_t)(b * 8 + v) * T + t) * 64;
            else { const size_t off = v < 10 ? WS_KC : v < 12 ? WS_VC : v < 14 ? WS_KS : WS_KW; dst = GP(bf16, ws + off) + ((size_t)(b * 2 + (v & 1)) * T + t) * 64; }
            if (v == 10 || v == 11) { dst[lane] = zv[v]; continue; }
            const float x = bf2f(zv[v]);
            const float ss = wave_sum(x * x);
            const float gsel = v < 8 ? gq : v < 10 ? gk0 : v < 14 ? gk1 : gk2;
            float y = x * rsqrtf(ss * (1.f / 64.f) + EPS) * gsel;
            const float partner = DPPF(y, 0x128);
            if (lane < 8) y = y * cs - partner * sn; else if (lane < 16) y = y * cs + partner * sn;
            dst[lane] = (bf16)f2bf(v < 8 ? y * 0.18033688011112042f   : y);
        }
    }
    for (int it = gw; it < BSZ * 2 * 2 * 32; it += NGW) {
        const int tb = it & 31, br = (it >> 5) & 1, gi = (it >> 6) & 1, b = it >> 7;
        const GASQ bf16* zr = Z + ((size_t)b * T + tb * 64) * ZLD + (br == 0 ? ZC_VS : ZC_VW) + gi * 64 + lane;
        GASQ bf16* dst = GP(bf16, ws + (br == 0 ? WS_VS : WS_VW)) + ((size_t)(b * 2 + gi) * 64 + lane) * T + tb * 64;
#pragma unroll
        for (int c8 = 0; c8 < 8; ++c8) {
            unsigned w[4];
#pragma unroll
            for (int e = 0; e < 4; ++e) { const unsigned lo = zr[(size_t)(c8 * 8 + 2 * e) * ZLD], hi = zr[(size_t)(c8 * 8 + 2 * e + 1) * ZLD]; w[e] = lo | (hi << 16); }
            *(GASQ v4u*)(dst + c8 * 8) = (v4u){w[0], w[1], w[2], w[3]};
        }
    }
}

constexpr int HG_P = 0, HG_G = 17408, HG_GT = 34816, HG_AM = 53248, HG_ST = 72704  , HG_VT = 66816, HG_TOT = 69120, HG_VEC = 71168;
#define MFMA16(a, b, c) __builtin_amdgcn_mfma_f32_16x16x32_bf16((a), (b), (c), 0, 0, 0)
__device__ __forceinline__ void phase_hg_prep(const Frame& F, float* OUTB) {
    const ArgsV A = args_view(F); const GASQ bf16* Z = GCP(bf16, A.ws + WS_Z);
    const float* lbl = A.in[7];
    GASQ bf16* Pg = GP(bf16, A.ws + WS_H); GASQ bf16* Gg = Pg + (size_t)1024 * 8192;
    GASQ bf16* GTg = GP(bf16, A.ws + WS_HGT); GASQ float* VECg = GP(float, A.ws + WS_HVEC);
    const int tid = F.tid; LAS float* TOT = (LAS float*)(F.lds + HG_TOT);
    const int k = tid & 127, rg = tid >> 7;
    const float lb0 = 1.f / (1.f + expf(lbl[512 + k] - lbl[k])), lb1 = 1.f / (1.f + expf(lbl[640 + k] - lbl[128 + k])), lb2 = 1.f / (1.f + expf(lbl[768 + k] - lbl[256 + k])), lb3 = 1.f / (1.f + expf(lbl[896 + k] - lbl[384 + k]));
#pragma unroll 1
    for (int it = F.blk; it < 1024; it += F.G) {
        const int bh = it >> 5, c = it & 31, b = bh >> 2, h = bh & 3, ch = h * 128 + k;
        const float lb = (h == 0) ? lb0 : (h == 1) ? lb1 : (h == 2) ? lb2 : lb3;
        const GASQ bf16* zb = Z + ((size_t)b * T + c * 64 + rg * 16) * ZLD + ch;
        unsigned short zf[16], zq[16];
#pragma unroll
        for (int i = 0; i < 16; ++i) { zf[i] = zb[i * ZLD + ZC_HF]; zq[i] = zb[i * ZLD + ZC_HQ]; }
        float cum[16], qv[16], kv[16]; float run = 0.f;
#pragma unroll
        for (int i = 0; i < 16; ++i) {
            const float z1 = bf2f(zf[i]), z2 = bf2f(zq[i]);
            const float sg = __builtin_amdgcn_rcpf(1.f + ex2(-1.4426950408889634f * z1));
            const float f = lb + (1.f - lb) * sg;
            run += __builtin_amdgcn_logf(f); cum[i] = run; kv[i] = 1.f - f;
            qv[i] = z2 * __builtin_amdgcn_rcpf(1.f + ex2(-1.4426950408889634f * z2));
        }
        __syncthreads();
        TOT[rg * 128 + k] = run;
        __syncthreads();
        const float t0 = TOT[k], t1 = TOT[128 + k], t2 = TOT[256 + k], t3 = TOT[384 + k];
        const float e0 = t0 + t1, Bt = e0 + (t2 + t3);
        const float off = (rg == 0) ? 0.f : (rg == 1) ? t0 : (rg == 2) ? e0 : (e0 + t2);
        unsigned gt[8];
#pragma unroll
        for (int i = 0; i < 16; ++i) {
            const float bt = off + cum[i];
            const float p = qv[i] * ex2(bt - e0), g = kv[i] * ex2(e0 - bt);
            const unsigned gb = f2bf(g);
            Pg[((size_t)it * 64 + rg * 16 + i) * 128 + k] = (bf16)f2bf(p);
            Gg[((size_t)it * 64 + rg * 16 + i) * 128 + k] = (bf16)gb;
            if (i & 1) gt[i >> 1] |= gb << 16; else gt[i >> 1] = gb;
        }
        *(GASQ v4u*)(GTg + ((size_t)it * 128 + k) * 64 + rg * 16) = (v4u){gt[0], gt[1], gt[2], gt[3]};
        *(GASQ v4u*)(GTg + ((size_t)it * 128 + k) * 64 + rg * 16 + 8) = (v4u){gt[4], gt[5], gt[6], gt[7]};
        if (rg == 0) { VECg[(size_t)it * 384 + k] = ex2(e0); VECg[(size_t)it * 384 + 128 + k] = ex2(Bt); VECg[(size_t)it * 384 + 256 + k] = ex2(Bt - e0); }
    }
    __syncthreads();
}
__device__ __forceinline__ void phase_hg_scan(const Frame& F, float* OHG) {
    const ArgsV A = args_view(F); const GASQ bf16* Z = GCP(bf16, A.ws + WS_Z);
    const GASQ bf16* Pg = GCP(bf16, A.ws + WS_H); const GASQ bf16* Gg = Pg + (size_t)1024 * 8192;
    const GASQ bf16* GTg = GCP(bf16, A.ws + WS_HGT); const GASQ float* VECg = GCP(float, A.ws + WS_HVEC);
    const int tid = F.tid, lane = F.lane, w = F.wave, fr = lane & 15, fq = lane >> 4;
    LAS unsigned char* L = F.lds;
    LAS float* VEC = (LAS float*)(L + HG_VEC);
#pragma unroll 1
    for (int item = F.blk; item < 256; item += F.G) {
        const int bh = (item & 7) * 4 + (item >> 6), vs = (item >> 3) & 7, b = bh >> 2, h = bh & 3, it0 = bh * 32, oitem = bh * 8 + vs;
        const GASQ bf16* zb = Z + (size_t)b * T * ZLD;
        const unsigned vo = (unsigned)((tid >> 4) * 2 * ZLD + ZC_HI + h * 128 + vs * 16 + (tid & 15));
        const int r0 = tid >> 4, c16 = tid & 15, k0 = tid >> 3, c8 = tid & 7;
        const unsigned pgo = (unsigned)(r0 * 128 + c16 * 8), gto = (unsigned)(k0 * 64 + c8 * 8);
        f32x4 S = {0.f, 0.f, 0.f, 0.f};
        v4u sp[2], sg[2], st[2]; f32x4 sv = {0.f, 0.f, 0.f, 0.f}; unsigned short vr[2];
#define HG_LOAD(cc) do { const size_t itc = (size_t)(it0 + (cc)); \
            sp[0] = *(const GASQ v4u*)(Pg + itc * 8192 + pgo); sp[1] = *(const GASQ v4u*)(Pg + itc * 8192 + 4096 + pgo); \
            sg[0] = *(const GASQ v4u*)(Gg + itc * 8192 + pgo); sg[1] = *(const GASQ v4u*)(Gg + itc * 8192 + 4096 + pgo); \
            st[0] = *(const GASQ v4u*)(GTg + itc * 8192 + gto); st[1] = *(const GASQ v4u*)(GTg + itc * 8192 + 4096 + gto); \
            if (tid < 96) sv = *(const GASQ f32x4*)(VECg + itc * 384 + tid * 4); \
            vr[0] = zb[(unsigned)((cc) * 64 * ZLD) + vo]; vr[1] = zb[(unsigned)((cc) * 64 * ZLD) + vo + ZLD]; } while (0)
        HG_LOAD(0);
#pragma unroll 1
        for (int c = 0; c < 32; ++c) {
            *(LAS v4u*)(L + HG_P + r0 * 272 + c16 * 16) = sp[0]; *(LAS v4u*)(L + HG_P + (r0 + 32) * 272 + c16 * 16) = sp[1];
            *(LAS v4u*)(L + HG_G + r0 * 272 + c16 * 16) = sg[0]; *(LAS v4u*)(L + HG_G + (r0 + 32) * 272 + c16 * 16) = sg[1];
            *(LAS v4u*)(L + HG_GT + k0 * 144 + c8 * 16) = st[0]; *(LAS v4u*)(L + HG_GT + (k0 + 64) * 144 + c8 * 16) = st[1];
            if (tid < 96) *(LAS f32x4*)(VEC + tid * 4) = sv;
            *(LAS unsigned*)(L + HG_VT + (tid & 15) * 144 + (tid >> 4) * 4) = (unsigned)vr[0] | ((unsigned)vr[1] << 16);
            if (c < 31) HG_LOAD(c + 1);
            __syncthreads();
            { const int kk = 16 * w + fq * 4; const f32x4 ev = *(const LAS f32x4*)(VEC + kk);
              v2u sw; sw.x = pk2(ev.x * S.x, ev.y * S.y); sw.y = pk2(ev.z * S.z, ev.w * S.w);
              *(LAS v2u*)(L + HG_ST + fr * 272 + kk * 2) = sw; }
#pragma unroll
            for (int q2 = 0; q2 < 2; ++q2) {
                const int tt = 2 * w + q2, ti = tt >> 2, tj = tt & 3;
                f32x4 acc = {0.f, 0.f, 0.f, 0.f};
#pragma unroll
                for (int ks = 0; ks < 4; ++ks) {
                    const bf16x8 pa = *(const LAS bf16x8*)(L + HG_P + (16 * ti + fr) * 272 + (ks * 32 + fq * 8) * 2);
                    const bf16x8 gb = *(const LAS bf16x8*)(L + HG_G + (16 * tj + fr) * 272 + (ks * 32 + fq * 8) * 2);
                    acc = MFMA16(pa, gb, acc);
                }
                asm volatile("s_nop 7\n\ts_nop 7" ::: "memory");
#pragma unroll
                for (int j = 0; j < 4; ++j) { const bool keep = (tj < ti) || ((tj == ti) && (fq * 4 + j >= fr)); acc[j] = keep ? acc[j] : 0.f; }
#pragma unroll
                for (int j = 0; j < 4; ++j) {
                    const unsigned ab = f2bf(acc[j]), ao = (unsigned)__builtin_amdgcn_update_dpp(0, (int)ab, 0xB1, 0xf, 0xf, false);
                    if ((j & 1) == (fr & 1)) *(LAS unsigned*)(L + HG_AM + (16 * ti + fq * 4 + j) * 144 + (16 * tj + (fr & ~1)) * 2) = (fr & 1) ? (ao | (ab << 16)) : (ab | (ao << 16));
                }
            }
            __syncthreads();
            {
                const int wr = w & 3;
                f32x4 o = {0.f, 0.f, 0.f, 0.f};
                if (w < 4) {
#pragma unroll
                    for (int ks = 0; ks < 4; ++ks) {
                        const bf16x8 pa = *(const LAS bf16x8*)(L + HG_P + (16 * wr + fr) * 272 + (ks * 32 + fq * 8) * 2);
                        const bf16x8 sb = *(const LAS bf16x8*)(L + HG_ST + fr * 272 + (ks * 32 + fq * 8) * 2);
                        o = MFMA16(pa, sb, o);
                    }
#pragma unroll
                    for (int ks = 0; ks < 2; ++ks) {
                        const bf16x8 aa = *(const LAS bf16x8*)(L + HG_AM + (16 * wr + fr) * 144 + (ks * 32 + fq * 8) * 2);
                        const bf16x8 vb = *(const LAS bf16x8*)(L + HG_VT + fr * 144 + (ks * 32 + fq * 8) * 2);
                        o = MFMA16(aa, vb, o);
                    }
                    asm volatile("s_nop 7\n\ts_nop 7" ::: "memory");
                    GASQ float* op = GP(float, OHG + ((size_t)oitem * T + c * 64 + 16 * wr + fq * 4) * 16 + fr);
#pragma unroll
                    for (int j = 0; j < 4; ++j) op[j * 16] = o[j];
                }
            }
            {
                f32x4 u = {0.f, 0.f, 0.f, 0.f};
#pragma unroll
                for (int ks = 0; ks < 2; ++ks) {
                    const bf16x8 ga = *(const LAS bf16x8*)(L + HG_GT + (16 * w + fr) * 144 + (ks * 32 + fq * 8) * 2);
                    const bf16x8 vb = *(const LAS bf16x8*)(L + HG_VT + fr * 144 + (ks * 32 + fq * 8) * 2);
                    u = MFMA16(ga, vb, u);
                }
                asm volatile("s_nop 7\n\ts_nop 7" ::: "memory");
                const int kk = 16 * w + fq * 4; const f32x4 eB = *(const LAS f32x4*)(VEC + 128 + kk), eD = *(const LAS f32x4*)(VEC + 256 + kk);
                S = eB * S + eD * u;
            }
            __syncthreads();
        }
#undef HG_LOAD
    }
}
__device__ __forceinline__ void phase_hg_scan_v1(const Frame& F, float* OHG) {
    const ArgsV A = args_view(F); const bf16* Z = (const bf16*)(A.ws + WS_Z);
    const float* lbl = A.in[7];
    LAS float* Fm = (LAS float*)F.lds;
    LAS float* Qm = (LAS float*)(F.lds + 32768);
    LAS float* Vm = (LAS float*)(F.lds + 65536);
    LAS float* Om = (LAS float*)(F.lds + 69632);
    const int tid = F.tid, lane = F.lane;
    for (int item = F.blk; item < 256; item += F.G) {
        const int b = item >> 5, h = (item >> 3) & 3, vs = item & 7;
        const int col = tid & 127; const int ch = h * 128 + col;
        const float lb = 1.f / (1.f + expf(lbl[512 + ch] - lbl[ch]));
        const int k0 = (lane & 31) * 4, vloc = F.wave * 2 + (lane >> 5);
        float S0 = 0.f, S1 = 0.f, S2 = 0.f, S3 = 0.f;
        for (int c = 0; c < 32; ++c) {
            __syncthreads();
            const size_t mbase = (size_t)b * T + c * 64;
#pragma unroll 4
            for (int i = 0; i < 16; ++i) { const int row = (tid >> 7) + 4 * i; const bf16* zr = Z + (mbase + row) * ZLD;
                const float zf = bf2f(zr[ZC_HF + ch]), zq = bf2f(zr[ZC_HQ + ch]);
                Fm[row * 128 + col] = lb + (1.f - lb) * sigmoidf_(zf); Qm[row * 128 + col] = siluf_(zq); }
#pragma unroll
            for (int i = 0; i < 2; ++i) { const int idx = tid + 512 * i, row = idx >> 4, vc = idx & 15; Vm[idx] = bf2f(Z[(mbase + row) * ZLD + ZC_HI + h * 128 + vs * 16 + vc]); }
            __syncthreads();
            for (int t = 0; t < 64; ++t) {
                const f32x4 f4 = *(const LAS f32x4*)(Fm + t * 128 + k0), q4 = *(const LAS f32x4*)(Qm + t * 128 + k0); const float vt = Vm[t * 16 + vloc];
                S0 = f4.x * S0 + (1.f - f4.x) * vt; S1 = f4.y * S1 + (1.f - f4.y) * vt; S2 = f4.z * S2 + (1.f - f4.z) * vt; S3 = f4.w * S3 + (1.f - f4.w) * vt;
                float p = (q4.x * S0 + q4.y * S1) + (q4.z * S2 + q4.w * S3);
                p += __shfl_xor(p, 1); p += __shfl_xor(p, 2); p += __shfl_xor(p, 4); p += __shfl_xor(p, 8); p += __shfl_xor(p, 16);
                if ((lane & 31) == 0) Om[t * 16 + vloc] = p;
            }
            __syncthreads();
#pragma unroll
            for (int i = 0; i < 2; ++i) { const int idx = tid + 512 * i, row = idx >> 4, vc = idx & 15; OHG[((size_t)item * T + c * 64 + row) * 16 + vc] = Om[idx]; }
        }
        __syncthreads();
    }
}
__device__ __forceinline__ void phase_hg_norm(const Frame& F, const float* OHG) {
    const ArgsV A = args_view(F); const bf16* Z = (const bf16*)(A.ws + WS_Z); bf16* MIX = (bf16*)(A.ws + WS_H);
    const int gw = F.blk * NWAVES + F.wave, NGW = F.G * NWAVES, lane = F.lane;
    const f32x2 ngv = *GCP(f32x2, A.in[8] + 2 * lane);
    for (int m = gw; m < M; m += NGW) {
        f32x2 o[4]; unsigned gz[4];
#pragma unroll
        for (int h = 0; h < 4; ++h) {
            o[h] = *GCP(f32x2, OHG + ((size_t)((m / T) * 32 + h * 8 + (lane >> 3)) * T + (m % T)) * 16 + 2 * (lane & 7));
            gz[h] = *GCP(unsigned, Z + (size_t)m * ZLD + ZC_HG + h * 128 + 2 * lane);
        }
#pragma unroll
        for (int h = 0; h < 4; ++h) {
            const float ss = wave_sum(o[h].x * o[h].x + o[h].y * o[h].y);
            const float r = rsqrtf(ss * (1.f / 128.f) + EPS);
            const float y0 = o[h].x * r * ngv.x * siluf_(bflo(gz[h])), y1 = o[h].y * r * ngv.y * siluf_(bfhi(gz[h]));
            *GP(unsigned, MIX + (size_t)m * D + h * 128 + 2 * lane) = pk2(y0, y1);
        }
    }
}

__device__ __forceinline__ void phase_cmp_finish(const Frame& F, const float* PART) {
    const ArgsV A = args_view(F); const float* c1 = (const float*)(A.ws + WS_C1); const float* w2 = A.in[13]; float* KV = (float*)(A.ws + WS_KVCMP);
    LAS float* hw = (LAS float*)(F.lds + F.wave * 2048);
    const int gw = F.blk * NWAVES + F.wave, NGW = F.G * NWAVES, lane = F.lane;
    GASQ bf16* KVb = GP(bf16, KV);
    for (int R = gw; R < 2048; R += NGW) {
        f32x4 s0 = {0.f, 0.f, 0.f, 0.f}, s1 = {0.f, 0.f, 0.f, 0.f};
#pragma unroll
        for (int kp = 0; kp < 16; ++kp) { s0 += *GCP(f32x4, c1 + (kp * 2 + 0) * 256 + lane * 4); s1 += *GCP(f32x4, c1 + (kp * 2 + 1) * 256 + lane * 4); }
#pragma unroll
        for (int ks = 0; ks < 8; ++ks) { s0 += *GCP(f32x4, PART + ((size_t)ks * 2048 + R) * 256 + lane * 4); s1 += *GCP(f32x4, PART + ((size_t)(8 + ks) * 2048 + R) * 256 + lane * 4); }
        f32x4 h0, h1;
        h0.x = siluf_(s0.x); h0.y = siluf_(s0.y); h0.z = siluf_(s0.z); h0.w = siluf_(s0.w);
        h1.x = siluf_(s1.x); h1.y = siluf_(s1.y); h1.z = siluf_(s1.z); h1.w = siluf_(s1.w);
        *(LAS f32x4*)(hw + lane * 4) = h0; *(LAS f32x4*)(hw + 256 + lane * 4) = h1;
        LDS_FENCE();
        const GASQ float* wp0 = GCP(float, w2 + lane); const GASQ float* wp1 = GCP(float, w2 + (size_t)256 * 64 + lane);
        f32x4 a0 = {0.f, 0.f, 0.f, 0.f}, a1 = {0.f, 0.f, 0.f, 0.f};
#pragma unroll 4
        for (int j4 = 0; j4 < 64; ++j4) {
            const f32x4 h0v = *(const LAS f32x4*)(hw + 4 * j4), h1v = *(const LAS f32x4*)(hw + 256 + 4 * j4);
            const f32x4 w0v = {wp0[(4 * j4) * 64], wp0[(4 * j4 + 1) * 64], wp0[(4 * j4 + 2) * 64], wp0[(4 * j4 + 3) * 64]};
            const f32x4 w1v = {wp1[(4 * j4) * 64], wp1[(4 * j4 + 1) * 64], wp1[(4 * j4 + 2) * 64], wp1[(4 * j4 + 3) * 64]};
            a0 += h0v * w0v; a1 += h1v * w1v;
        }
        float o0 = (a0.x + a0.y) + (a0.z + a0.w), o1 = (a1.x + a1.y) + (a1.z + a1.w);
        if ((R & 127) == 127) { o0 = 0.f; o1 = 0.f; }
        KVb[(size_t)R * 64 + lane] = (bf16)f2bf(o0);
        KVb[(size_t)2048 * 64 + ((size_t)(R >> 7) * 64 + lane) * 128 + (R & 127)] = (bf16)f2bf(o1);
        LDS_FENCE();
    }
}

typedef float f32x16 __attribute__((ext_vector_type(16)));
#define MFMA32(a, b, c) __builtin_amdgcn_mfma_f32_32x32x16_bf16((a), (b), (c), 0, 0, 0)
__device__ __forceinline__ unsigned cvtpk(float lo, float hi) { typedef float f2_t __attribute__((ext_vector_type(2))); typedef __bf16 b2_t __attribute__((ext_vector_type(2)));
    f2_t v = {lo, hi}; b2_t r = __builtin_convertvector(v, b2_t); return __builtin_bit_cast(unsigned, r); }
constexpr int AT_KB = 0, AT_VB = 18432, AT_IMP = 36864, AT_SEL = 69632, AT_OUT = 69888  , AT_ROW = 144;

template <int MM>
__device__ __forceinline__ void attn_block_mfma(const LAS unsigned char* Kb, const LAS unsigned char* Vb, const bf16x8 (&qf)[4], f32x16 (&O)[2], float& m, float& l, int lane, bool selbit, int tl) {
    const int r32 = lane & 31, h = lane >> 5;
    f32x16 S[2];
#pragma unroll
    for (int kt = 0; kt < 2; ++kt) {
#pragma unroll
        for (int i = 0; i < 16; ++i) S[kt][i] = 0.f;
#pragma unroll
        for (int ks = 0; ks < 4; ++ks) { const bf16x8 kf = *(const LAS bf16x8*)(Kb + (kt * 32 + r32) * AT_ROW + (ks * 16 + h * 8) * 2); S[kt] = MFMA32(kf, qf[ks], S[kt]); }
        __builtin_amdgcn_sched_barrier(0);
    }
    float mx = -INFINITY;
#pragma unroll
    for (int kt = 0; kt < 2; ++kt)
#pragma unroll
        for (int i = 0; i < 16; ++i) { const int kl = kt * 32 + 8 * (i >> 2) + 4 * h + (i & 3);
            bool ok = selbit; if (MM == 1) ok = ok && (kl <= tl); if (MM == 2) ok = ok && (kl > tl);
            const float s = ok ? S[kt][i] : -INFINITY; S[kt][i] = s; mx = fmaxf(mx, s); }
    mx = fmaxf(mx, xor32f(mx, lane));
    const float mn = fmaxf(m, mx), alpha = ex2(m - mn); m = mn;
    float rs = 0.f;
#pragma unroll
    for (int kt = 0; kt < 2; ++kt)
#pragma unroll
        for (int i = 0; i < 16; ++i) { const float p = ex2(S[kt][i] - mn); S[kt][i] = p; rs += p; }
    l = l * alpha + rs;
#pragma unroll
    for (int i = 0; i < 16; ++i) { O[0][i] *= alpha; O[1][i] *= alpha; }
    bf16x8 pf[4];
#pragma unroll
    for (int s = 0; s < 4; ++s) { const int kt = s >> 1, bb = 8 * (s & 1);
        v4u w; w.x = cvtpk(S[kt][bb + 0], S[kt][bb + 1]); w.y = cvtpk(S[kt][bb + 2], S[kt][bb + 3]); w.z = cvtpk(S[kt][bb + 4], S[kt][bb + 5]); w.w = cvtpk(S[kt][bb + 6], S[kt][bb + 7]);
        pf[s] = __builtin_bit_cast(bf16x8, w); }
#pragma unroll
    for (int dt = 0; dt < 2; ++dt)
#pragma unroll
        for (int s = 0; s < 4; ++s) { const LAS unsigned char* vp = Vb + (dt * 32 + r32) * AT_ROW + (16 * s + 4 * h) * 2;
            const v2u lo = *(const LAS v2u*)vp, hi = *(const LAS v2u*)(vp + 16);
            const v4u w = {lo.x, lo.y, hi.x, hi.y};
            O[dt] = MFMA32(__builtin_bit_cast(bf16x8, w), pf[s], O[dt]); if (s & 1) __builtin_amdgcn_sched_barrier(0); }
}

template <bool WIN>
__device__ __forceinline__ void attn_branch(const Frame& F, const bf16* Kx, const bf16* VTx, size_t bg, int qb, int jlo, int jhi, const bf16x8 (&qf)[4], f32x16 (&O)[2], float& m, float& l, unsigned mysel, int tl) {
    const int tid = F.tid, lane = F.lane, row = tid >> 3, ch = tid & 7;
    const GASQ bf16* kg = (const GASQ bf16*)(Kx + bg * T * 64); const GASQ bf16* vg = (const GASQ bf16*)(VTx + bg * 64 * T);
    const unsigned ko = (unsigned)(row * 64 + ch * 8), vo = (unsigned)(row * T + ch * 8);
    const int so = row * AT_ROW + ch * 16;
    v4u kr = *(const GASQ v4u*)(kg + (jlo * 4096 + ko)), vr = *(const GASQ v4u*)(vg + (jlo * 64 + vo));
    *(LAS v4u*)(F.lds + AT_KB + so) = kr; *(LAS v4u*)(F.lds + AT_VB + so) = vr;
    __syncthreads();
    int buf = 0;
    for (int jb = jlo; jb <= jhi; ++jb) {
        const bool more = jb < jhi;
        if (more) { kr = *(const GASQ v4u*)(kg + ((jb + 1) * 4096 + ko)); vr = *(const GASQ v4u*)(vg + ((jb + 1) * 64 + vo)); }
        const LAS unsigned char* Kb = F.lds + AT_KB + buf * 9216; const LAS unsigned char* Vb = F.lds + AT_VB + buf * 9216;
        const bool selbit = WIN ? true : (((mysel >> jb) & 1u) != 0u);
        if (jb == qb) attn_block_mfma<1>(Kb, Vb, qf, O, m, l, lane, selbit, tl);
        else if (WIN && jb == qb - 8) attn_block_mfma<2>(Kb, Vb, qf, O, m, l, lane, selbit, tl);
        else attn_block_mfma<0>(Kb, Vb, qf, O, m, l, lane, selbit, tl);
        buf ^= 1;
        if (more) { *(LAS v4u*)(F.lds + AT_KB + buf * 9216 + so) = kr; *(LAS v4u*)(F.lds + AT_VB + buf * 9216 + so) = vr; }
        __syncthreads();
    }
}

template <class Bar>
__device__ __forceinline__ void phase_nsa_attn(const Frame& F, const Bar* pending) {
    const ArgsV A = args_view(F); unsigned char* ws = A.ws;
    const bf16* Z = (const bf16*)(ws + WS_Z); const bf16* QN = (const bf16*)(ws + WS_QN);
    const bf16* KS = (const bf16*)(ws + WS_KS); const bf16* VST = (const bf16*)(ws + WS_VS); const bf16* KW = (const bf16*)(ws + WS_KW); const bf16* VWT = (const bf16*)(ws + WS_VW);
    const bf16* KC = (const bf16*)(ws + WS_KVCMP); const bf16* VCT = KC + (size_t)2048 * 64; bf16* MIX = (bf16*)(ws + WS_H);
    const int r = F.wave >> 1, tb = F.wave & 1;
    LAS float* IMP = (LAS float*)(F.lds + AT_IMP);
    LAS unsigned* SEL = (LAS unsigned*)(F.lds + AT_SEL);
    bool waiting = (pending != nullptr);
#pragma unroll 1
    for (int item = F.blk; item < 256; item += F.G) {
        const size_t bg = (size_t)((item & 7) * 2 + (item >> 7)); const int b = (int)(bg >> 1), g = (int)(bg & 1), pi = (item >> 3) & 15;
#pragma unroll 1
        for (int u2 = 0; u2 < 2; ++u2) {
            Frame Fu = F; Fu.lane = opaque_lane(); Fu.tid = F.wave * 64 + Fu.lane;
            const int tid = Fu.tid, lane = Fu.lane, r32 = lane & 31, h = lane >> 5, tl = tb * 32 + r32;
            const int qb = u2 ? (31 - pi) : pi;
            const int t = qb * 64 + tl; const size_t mrow = (size_t)b * T + t;
            bf16x8 qf[4];
            { const GASQ bf16* qp = (const GASQ bf16*)(QN + ((size_t)(b * 8 + g * 4 + r) * T + t) * 64 + h * 8);
#pragma unroll
              for (int ks = 0; ks < 4; ++ks) qf[ks] = *(const GASQ bf16x8*)(qp + ks * 16); }
            const GASQ bf16* gz = (const GASQ bf16*)(Z + mrow * ZLD + ZC_NG + (g * 4 + r) * 3);
            const float g0 = sigmoidf_(bf2f(gz[0])), g1 = sigmoidf_(bf2f(gz[1])), g2 = sigmoidf_(bf2f(gz[2]));
            LAS float* OL = (LAS float*)(F.lds + AT_OUT + F.wave * 8192) + lane;
            {
                f32x16 O[2]; float m = -1e30f, l = 0.f;
#pragma unroll
                for (int i = 0; i < 16; ++i) { O[0][i] = 0.f; O[1][i] = 0.f; }
                __syncthreads();
                attn_branch<true>(Fu, KW, VWT, bg, qb, qb >= 8 ? qb - 8 : 0, qb, qf, O, m, l, 0xffffffffu, tl);
                l += xor32f(l, lane);
                const float sc = g2 / l;
#pragma unroll
                for (int i = 0; i < 16; ++i) { OL[i * 64] = sc * O[0][i]; OL[(16 + i) * 64] = sc * O[1][i]; }
            }
            if (waiting) { xcd_wait(*pending); waiting = false; }
            __syncthreads();
            { const int row = tid >> 3, ch = tid & 7;
              const GASQ bf16* kcb = (const GASQ bf16*)(KC + bg * 8192); const GASQ bf16* vcb = (const GASQ bf16*)(VCT + bg * 8192);
#pragma unroll
              for (int i = 0; i < 2; ++i) { const v4u v = *(const GASQ v4u*)(kcb + (unsigned)((row + 64 * i) * 64 + ch * 8)); *(LAS v4u*)(F.lds + AT_KB + (row + 64 * i) * AT_ROW + ch * 16) = v; }
#pragma unroll
              for (int i = 0; i < 2; ++i) { const v4u v = *(const GASQ v4u*)(vcb + (unsigned)(row * 128 + (ch + 8 * i) * 8)); *(LAS v4u*)(F.lds + AT_VB + row * 272 + (ch + 8 * i) * 16) = v; } }
            __syncthreads();
            {
                const int nvalid = (t >= 31) ? (((t - 31) >> 4) + 1) : 0;
                float mx = -1e30f;
#pragma unroll
                for (int kt = 0; kt < 4; ++kt) {
                    f32x16 S;
#pragma unroll
                    for (int i = 0; i < 16; ++i) S[i] = 0.f;
#pragma unroll
                    for (int ks = 0; ks < 4; ++ks) { const bf16x8 kf = *(const LAS bf16x8*)(F.lds + AT_KB + (kt * 32 + r32) * AT_ROW + (ks * 16 + h * 8) * 2); S = MFMA32(kf, qf[ks], S); }
#pragma unroll
                    for (int i = 0; i < 16; ++i) { const int n = kt * 32 + 8 * (i >> 2) + 4 * h + (i & 3); mx = fmaxf(mx, (n < nvalid) ? S[i] : -INFINITY); }
                    __builtin_amdgcn_sched_barrier(0);
                }
                mx = fmaxf(mx, xor32f(mx, lane));
                f32x16 Oc[2];
#pragma unroll
                for (int i = 0; i < 16; ++i) { Oc[0][i] = 0.f; Oc[1][i] = 0.f; }
                float impv[16]; float rs = 0.f, yprev = 0.f;
#pragma unroll
                for (int kt = 0; kt < 4; ++kt) {
                    f32x16 S;
#pragma unroll
                    for (int i = 0; i < 16; ++i) S[i] = 0.f;
#pragma unroll
                    for (int ks = 0; ks < 4; ++ks) { const bf16x8 kf = *(const LAS bf16x8*)(F.lds + AT_KB + (kt * 32 + r32) * AT_ROW + (ks * 16 + h * 8) * 2); S = MFMA32(kf, qf[ks], S); }
#pragma unroll
                    for (int i = 0; i < 16; ++i) { const int n = kt * 32 + 8 * (i >> 2) + 4 * h + (i & 3); const float p = (n < nvalid) ? ex2(S[i] - mx) : 0.f; S[i] = p; rs += p; }
#pragma unroll
                    for (int a = 0; a < 4; ++a) {
                        const float x = S[4 * a + 3], y = xor32f(x, lane);
                        impv[kt * 4 + a] = (S[4 * a] + S[4 * a + 1] + S[4 * a + 2] + 0.5f * x) + 0.5f * (h ? y : yprev);
                        yprev = y;
                    }
#pragma unroll
                    for (int s2 = 0; s2 < 2; ++s2) { const int s = kt * 2 + s2, bb = 8 * s2;
                        v4u w; w.x = cvtpk(S[bb + 0], S[bb + 1]); w.y = cvtpk(S[bb + 2], S[bb + 3]); w.z = cvtpk(S[bb + 4], S[bb + 5]); w.w = cvtpk(S[bb + 6], S[bb + 7]);
                        const bf16x8 pf = __builtin_bit_cast(bf16x8, w);
#pragma unroll
                        for (int dt = 0; dt < 2; ++dt) { const LAS unsigned char* vp = F.lds + AT_VB + (dt * 32 + r32) * 272 + (16 * s + 4 * h) * 2;
                            const v2u lo = *(const LAS v2u*)vp, hi = *(const LAS v2u*)(vp + 16);
                            const v4u wv = {lo.x, lo.y, hi.x, hi.y};
                            Oc[dt] = MFMA32(__builtin_bit_cast(bf16x8, wv), pf, Oc[dt]); } }
                    __builtin_amdgcn_sched_barrier(0);
                }
                rs += xor32f(rs, lane);
                const float inv = rs > 0.f ? 1.f / rs : 0.f;
#pragma unroll
                for (int q = 0; q < 16; ++q) IMP[(r * 64 + tl) * 32 + 8 * (q >> 2) + 2 * (q & 3) + h] = impv[q] * inv;
                const float gi = g0 * inv;
#pragma unroll
                for (int i = 0; i < 16; ++i) { OL[i * 64] += gi * Oc[0][i]; OL[(16 + i) * 64] += gi * Oc[1][i]; }
            }
            __syncthreads();
#pragma unroll 1
            for (int i = 0; i < 4; ++i) {
                const int idx = tid + 512 * i, tok = idx >> 5, j = idx & 31;
                const float v = ((IMP[(0 * 64 + tok) * 32 + j] + IMP[(1 * 64 + tok) * 32 + j]) + IMP[(2 * 64 + tok) * 32 + j]) + IMP[(3 * 64 + tok) * 32 + j];
                const bool causal = j <= qb, forced = (j == 0) || (j == qb) || (j == qb - 1);
                const float val = causal ? (forced ? INFINITY : v) : -1.f;
                int rank = 0;
#pragma unroll
                for (int i2 = 0; i2 < 32; ++i2) { const int vb = __builtin_bit_cast(int, val); const float vlo = __builtin_bit_cast(float, __builtin_amdgcn_readlane(vb, i2)), vhi = __builtin_bit_cast(float, __builtin_amdgcn_readlane(vb, 32 + i2));
                    const float vi = (lane < 32) ? vlo : vhi; rank += ((vi > val) || (vi == val && i2 < j)) ? 1 : 0; }
                const unsigned long long bal = __ballot((rank < 16) && causal);
                if (lane == 0) SEL[tok] = (unsigned)bal;
                if (lane == 32) SEL[tok] = (unsigned)(bal >> 32);
            }
            __syncthreads();
            const unsigned mysel = SEL[tl];
            {
                f32x16 O[2]; float m = -1e30f, l = 0.f;
#pragma unroll
                for (int i = 0; i < 16; ++i) { O[0][i] = 0.f; O[1][i] = 0.f; }
                attn_branch<false>(Fu, KS, VST, bg, qb, 0, qb, qf, O, m, l, mysel, tl);
                l += xor32f(l, lane);
                const float sc = g1 / l;
                GASQ bf16* op = (GASQ bf16*)(MIX + mrow * D + 512 + (g * 4 + r) * 64 + 4 * h);
#pragma unroll
                for (int dt = 0; dt < 2; ++dt)
#pragma unroll
                    for (int a = 0; a < 4; ++a) { float o[4];
#pragma unroll
                        for (int c = 0; c < 4; ++c) o[c] = OL[(dt * 16 + 4 * a + c) * 64] + sc * O[dt][4 * a + c];
                        v2u w; w.x = cvtpk(o[0], o[1]); w.y = cvtpk(o[2], o[3]); *(GASQ v2u*)(op + dt * 32 + 8 * a) = w; }
            }
        }
    }
    if (waiting) xcd_wait(*pending);
}

__device__ __forceinline__ void conv_seam_rows(const Frame& F, int pm) {
    const ArgsV A = args_view(F); GASQ bf16* ACT = GP(bf16, A.ws + WS_U); const GASQ bf16* HEAD = GCP(bf16, A.ws + WS_HALO); const GASQ bf16* TAIL = HEAD + (size_t)64 * 2 * FF2;
    const GASQ float* cw = GCP(float, A.in[17]); const GASQ float* cb = GCP(float, A.in[18]);
#pragma unroll
    for (int it6 = 0; it6 < 6; ++it6) {
        const int c = F.tid + it6 * NTHR; if (c >= FF) break;
        const GASQ bf16* h0 = HEAD + ((size_t)pm * 2) * FF2; const GASQ bf16* h1 = h0 + FF2;
        const float a0 = bf2f(h0[c]), a1 = bf2f(h1[c]), v0 = bf2f(h0[FF + c]), v1 = bf2f(h1[FF + c]);
        float ta0 = 0.f, ta1 = 0.f, tv0 = 0.f, tv1 = 0.f;
        if (pm & 7) { const GASQ bf16* t0 = TAIL + ((size_t)(pm - 1) * 2) * FF2; const GASQ bf16* t1 = t0 + FF2; ta0 = bf2f(t0[c]); ta1 = bf2f(t1[c]); tv0 = bf2f(t0[FF + c]); tv1 = bf2f(t1[FF + c]); }
        const float wa0 = cw[c], wa1 = cw[FF2 + c], wa2 = cw[2 * FF2 + c], ba = cb[c], wv0 = cw[FF + c], wv1 = cw[FF2 + FF + c], wv2 = cw[2 * FF2 + FF + c], bv = cb[FF + c];
        const float ya0 = ba + wa0 * ta0 + wa1 * ta1 + wa2 * a0, yv0 = bv + wv0 * tv0 + wv1 * tv1 + wv2 * v0;
        const float ya1 = ba + wa0 * ta1 + wa1 * a0 + wa2 * a1, yv1 = bv + wv0 * tv1 + wv1 * v0 + wv2 * v1;
        ACT[((size_t)pm * 256) * FF + c] = (bf16)f2bf(siluf_(ya0) * yv0);
        ACT[((size_t)pm * 256 + 1) * FF + c] = (bf16)f2bf(siluf_(ya1) * yv1);
    }
    asm volatile("s_waitcnt vmcnt(0)" ::: "memory");
    __syncthreads();
}

#define XB_TMO      128
#define XB_XCNT(j)  (256  + 64 * (j))
#define XB_XSUB(j)  (1280 + 64 * (j))
#define XB_XGEN(j)  (2304 + 64 * (j))
#define XB_TOP      3328
#define XB_TOPGEN   3392
#define XCD_BAR_WORDS 3456
#define XB_SPIN_CAP (1u << 18)

__device__ __forceinline__ unsigned xb_ld(unsigned* p)              { return __hip_atomic_load(p, __ATOMIC_RELAXED, __HIP_MEMORY_SCOPE_AGENT); }
__device__ __forceinline__ unsigned xb_add(unsigned* p, unsigned v) { return __hip_atomic_fetch_add(p, v, __ATOMIC_RELAXED, __HIP_MEMORY_SCOPE_AGENT); }
__device__ __forceinline__ unsigned xb_xcc_id() { return (unsigned)__builtin_amdgcn_s_getreg((3 << 11) | 20) & 0xFu; }
#define XB_SPIN(cond, bar) do { unsigned _sp = 0; while (cond) { __builtin_amdgcn_s_sleep(1); \
    if ((++_sp & 255u) == 0u) { if (xb_ld(&(bar)[XB_TMO])) break; if (_sp > XB_SPIN_CAP) { atomicAdd(&(bar)[XB_TMO], 1u); break; } } } } while (0)

struct XcdBarrier {
    unsigned* bar; unsigned x;
    volatile LAS unsigned* st;
};

__device__ __forceinline__ XcdBarrier xcd_barrier_post(unsigned* bar, volatile LAS unsigned* st) {
    XcdBarrier b; b.bar = bar; b.x = xb_xcc_id(); b.st = st;
    if (threadIdx.x == 0) (void)xb_add(&bar[XB_XCNT(b.x)], 1u);
    return b;
}
__device__ __forceinline__ void xcd_barrier_complete(unsigned* bar, unsigned x, unsigned& nloc, unsigned& nx) {
    const unsigned G = gridDim.x * gridDim.y * gridDim.z;
    unsigned sum, cnt, mine, sp = 0u;
    for (;;) {
        sum = 0u; cnt = 0u; mine = 0u;
#pragma unroll
        for (unsigned j = 0; j < 16; ++j) { const unsigned c = xb_ld(&bar[XB_XCNT(j)]); sum += c; cnt += (c > 0u) ? 1u : 0u; mine = (j == x) ? c : mine; }
        if (sum == G) break;
        __builtin_amdgcn_s_sleep(1);
        if ((++sp & 255u) == 0u) { if (xb_ld(&bar[XB_TMO])) break; if (sp > XB_SPIN_CAP) { atomicAdd(&bar[XB_TMO], 1u); break; } }
    }
    nloc = mine > 0u ? mine : 1u; nx = cnt > 0u ? cnt : 1u;
}

__device__ __forceinline__ void xcd_arrive(const XcdBarrier& b) {
    asm volatile("s_waitcnt vmcnt(0)" ::: "memory");
    __syncthreads();
    if (threadIdx.x == 0) {
        unsigned* bar = b.bar;
        __builtin_amdgcn_s_waitcnt(0);
        unsigned nloc = b.st[0], nx = b.st[1];
        if (nloc == 0u) { xcd_barrier_complete(bar, b.x, nloc, nx); b.st[0] = nloc; b.st[1] = nx; }
        const unsigned old = xb_add(&bar[XB_XSUB(b.x)], 1u);
        const unsigned gen = old / nloc;
        if (old + 1u == (gen + 1u) * nloc) {
            __builtin_amdgcn_fence(__ATOMIC_RELEASE, "agent");
            asm volatile("s_waitcnt vmcnt(0)" ::: "memory");
            const unsigned og = xb_add(&bar[XB_TOP], 1u);
            const unsigned tg = og / nx;
            if (og + 1u == (tg + 1u) * nx) xb_add(&bar[XB_TOPGEN], 1u);
        }
        b.st[2] = gen;
    }
}
__device__ __forceinline__ void xcd_wait(const XcdBarrier& b) {
    if (threadIdx.x == 0) {
        unsigned* bar = b.bar; const unsigned gen = b.st[2];
        XB_SPIN(xb_ld(&bar[XB_TOPGEN]) == gen, bar);
        __builtin_amdgcn_fence(__ATOMIC_ACQUIRE, "agent");
        asm volatile("s_waitcnt vmcnt(0)" ::: "memory");
    }
    __syncthreads();
}
__device__ __forceinline__ void xcd_barrier(const XcdBarrier& b) { xcd_arrive(b); xcd_wait(b); }


__global__ void __launch_bounds__(NTHR, 2) fwd_megakernel(Args args) {
    extern __shared__ __attribute__((aligned(16))) unsigned char lds_raw[];
    cg::grid_group grid = cg::this_grid();
    Frame F;
    F.lds = (LAS unsigned char*)lds_raw;
    F.wave = __builtin_amdgcn_readfirstlane((int)(threadIdx.x >> 6)); F.lane = opaque_lane(); F.tid = F.wave * 64 + F.lane;
    F.G = gridDim.x; F.blk = blockIdx.x;
    if (F.tid < 22) { const unsigned long long p = (F.tid < 20) ? (unsigned long long)args.in[F.tid < 20 ? F.tid : 0] : (F.tid == 20 ? (unsigned long long)args.out : (unsigned long long)args.ws);
        LAS unsigned* tab = (LAS unsigned*)(F.lds + ARGTAB); tab[2 * F.tid] = (unsigned)p; tab[2 * F.tid + 1] = (unsigned)(p >> 32); }
    if (F.tid == 0) { ((LAS unsigned*)(F.lds + ARGTAB + 192))[0] = 0u; ((LAS unsigned*)(F.lds + ARGTAB + 192))[1] = 0u; ((LAS unsigned*)(F.lds + ARGTAB + 192))[2] = 0u; }
    __syncthreads();
    const XcdBarrier xbar = xcd_barrier_post((unsigned*)(args.ws + WS_BAR), (volatile LAS unsigned*)(F.lds + ARGTAB + 192));
#define WSP ((unsigned char*)argp(F, 21))
#define OUTP ((float*)argp(F, 20))
#define PARTP (OUTP + (size_t)8 * 1024 * 1024)
    LAS unsigned char* glds = (LAS unsigned char*)lds_raw;
#define GRID_SYNC_CG() do { __builtin_amdgcn_fence(__ATOMIC_RELEASE, "agent"); asm volatile("s_waitcnt vmcnt(0) lgkmcnt(0)" ::: "memory"); grid.sync(); \
        __builtin_amdgcn_fence(__ATOMIC_ACQUIRE, "agent"); asm volatile("s_waitcnt vmcnt(0)" ::: "memory"); } while (0)
#define GRID_SYNC() xcd_barrier(xbar)

    phase0(phase_frame(F));
    xcd_arrive(xbar);
    if (gridDim.x == 0x7fffffffu) GRID_SYNC_CG();
    phase0b(phase_frame(F));
    xcd_wait(xbar);
    phase_norm_mod(phase_frame(F), argp(F, 0), argp(F, 5), 0, 1024, (bf16*)(WSP + WS_H));
    GRID_SYNC();
    {
        unsigned char* ws = WSP;
        pg8::Gemm g{(const bf16*)(ws + WS_H), (const bf16*)(ws + WS_WIN), 1024, 1024, 1024, 0};
        pg8::StaticOrder S; S.init(64, 14, F.G, F.blk, (size_t)256 * 1024 * 2, (size_t)256 * 1024 * 2);
        pg8::EpiBf16 E{(bf16*)(ws + WS_Z), ZLD, nullptr};
        pg8::gemm_phase<pg8::EpiBf16, pg8::StaticOrder, true>(glds, g, S, E, F.wave);
    }
    phase_c1(phase_frame(F), (64 * 14) % F.G);
    GRID_SYNC();
    phase_nsa_prep(phase_frame(F));
    phase_hg_prep(phase_frame(F), OUTP);
    GRID_SYNC();
    phase_hg_scan(phase_frame(F), OUTP);
    __syncthreads();
    {
        unsigned char* ws = WSP;
        pg8::Gemm g{(const bf16*)(ws + WS_KC), (const bf16*)(ws + WS_WC1), 256, 1024, 2048, 0};
        pg8::CmpOrder S{F.G, F.blk, (size_t)(WS_VC - WS_KC)};
        pg8::EpiPart E{PARTP};
        pg8::gemm_phase<pg8::EpiPart, pg8::CmpOrder, false>(glds, g, S, E, F.wave);
    }
    GRID_SYNC();
    phase_hg_norm(phase_frame(F), OUTP);
    phase_cmp_finish(phase_frame(F), PARTP);
    xcd_arrive(xbar);
    phase_nsa_attn(phase_frame(F), &xbar);
    GRID_SYNC();
    {
        unsigned char* ws = WSP;
        pg8::Gemm g{(const bf16*)(ws + WS_H), (const bf16*)(ws + WS_WOUT), 1024, 1024, 1024, 0};
        pg8::StaticOrder S; S.init(64, 4, F.G, F.blk, (size_t)256 * 1024 * 2, (size_t)256 * 1024 * 2);
        pg8::EpiRes E{argp(F, 0), OUTP, (const float*)(ws + WS_MOD) + 2048};
        pg8::gemm_phase<pg8::EpiRes, pg8::StaticOrder, true>(glds, g, S, E, F.wave);
    }
    if (F.G == 256) {
        pg8::StaticOrder S; S.init(64, 4, F.G, F.blk, 0, 0); pg8::Unit u0; (void)S.next(0, u0);
        unsigned* pc = (unsigned*)(WSP + WS_BAR) + 4096 + 64 * u0.pm;
        asm volatile("s_waitcnt vmcnt(0)" ::: "memory");
        __syncthreads();
        if (F.tid == 0) {
            __builtin_amdgcn_fence(__ATOMIC_RELEASE, "agent"); asm volatile("s_waitcnt vmcnt(0)" ::: "memory");
            (void)__hip_atomic_fetch_add(pc, 1u, __ATOMIC_RELAXED, __HIP_MEMORY_SCOPE_AGENT);
            unsigned spins = 0;
            while (__hip_atomic_load(pc, __ATOMIC_RELAXED, __HIP_MEMORY_SCOPE_AGENT) < 4u && ++spins < (1u << 22)) __builtin_amdgcn_s_sleep(1);
            __builtin_amdgcn_fence(__ATOMIC_ACQUIRE, "agent"); asm volatile("s_waitcnt vmcnt(0)" ::: "memory");
        }
        __syncthreads();
        const Frame Fp = phase_frame(F);
        norm_mod_rows(Fp, OUTP, argp(F, 15), 3072, 4096, (bf16*)(WSP + WS_H), u0.pm * 256 + u0.pn * 64 + Fp.wave, u0.pm * 256 + u0.pn * 64 + 64, NWAVES);
    } else {
        GRID_SYNC();
        phase_norm_mod(phase_frame(F), OUTP, argp(F, 15), 3072, 4096, (bf16*)(WSP + WS_H));
    }
    GRID_SYNC();
    {
        unsigned char* ws = WSP;
        pg8::Gemm g{(const bf16*)(ws + WS_H), (const bf16*)(ws + WS_WUP), 1024, 1024, 1024, 0};
        pg8::StaticOrder S; S.init(64, 22, F.G, F.blk, (size_t)256 * 1024 * 2, (size_t)256 * 1024 * 2);
        pg8::EpiConv E{(bf16*)(ws + WS_U), (bf16*)(ws + WS_HALO), (bf16*)(ws + WS_HALO) + (size_t)64 * 2 * FF2, argp(F, 17), argp(F, 18), (LAS float*)(glds + 131072)};
        pg8::gemm_phase<pg8::EpiConv, pg8::StaticOrder, true>(glds, g, S, E, F.wave);
    }
    GRID_SYNC();
    {
        unsigned char* ws = WSP;
        pg8::Gemm g{(const bf16*)(ws + WS_U), (const bf16*)(ws + WS_WDN), FF, FF, FF, 0};
        pg8::StaticOrder S; S.init(64, 4, F.G, F.blk, (size_t)256 * FF * 2, (size_t)256 * FF * 2);
        { pg8::Unit u0; for (int i = 0; S.next(i, u0); ++i) conv_seam_rows(phase_frame(F), u0.pm); }
        pg8::EpiRes E{OUTP, OUTP, (const float*)(ws + WS_MOD) + 5120};
        pg8::gemm_phase<pg8::EpiRes, pg8::StaticOrder, true>(glds, g, S, E, F.wave);
    }
}

extern "C" void kernel_launch(void* const* d_in, const int* in_sizes, int n_in, void* d_out, int out_size, void* d_ws, size_t ws_size, hipStream_t stream) {
    static int grid = 0;
    if (grid == 0) {
        if (n_in != 20 || out_size != M * D || ws_size < WS_END) { fprintf(stderr, "kernel_launch: unexpected shapes (n_in %d out %d ws %zu)\n", n_in, out_size, ws_size); grid = -1; return; }
        int dev = 0, cus = 0, per_cu = 0;
        (void)hipGetDevice(&dev);
        (void)hipDeviceGetAttribute(&cus, hipDeviceAttributeMultiprocessorCount, dev);
        if (hipFuncSetAttribute((const void*)fwd_megakernel, hipFuncAttributeMaxDynamicSharedMemorySize, LDS_BYTES) != hipSuccess) { fprintf(stderr, "kernel_launch: hipFuncSetAttribute failed\n"); }
        if (hipOccupancyMaxActiveBlocksPerMultiprocessor(&per_cu, (const void*)fwd_megakernel, NTHR, LDS_BYTES) != hipSuccess || per_cu < 1) { fprintf(stderr, "kernel_launch: occupancy query says %d\n", per_cu); per_cu = 1; }
        (void)hipGetLastError();
        grid = cus * 1;
        if (grid > 256) grid = 256;
    }
    if (grid < 0) return;
    (void)hipMemsetAsync((char*)d_ws + WS_BAR, 0, 32768, stream);
    Args a{};
    for (int i = 0; i < 20; ++i) a.in[i] = (const float*)d_in[i];
    a.out = (float*)d_out; a.ws = (unsigned char*)d_ws;
    void* kargs[] = {&a};
    hipError_t e = hipLaunchCooperativeKernel((const void*)fwd_megakernel, dim3(grid), dim3(NTHR), kargs, LDS_BYTES, stream);
    if (e != hipSuccess) fprintf(stderr, "cooperative launch failed: %s (grid %d)\n", hipGetErrorString(e), grid);
}
```

```cpp
#include <hip/hip_runtime.h>
#include <hip/hip_cooperative_groups.h>
#include <cstdio>
#include <cstdint>
namespace cg = cooperative_groups;

__device__ __forceinline__ int opaque_lane() { unsigned ones = ~0u; asm volatile("" : "+s"(ones)); return (int)__builtin_amdgcn_mbcnt_hi(ones, __builtin_amdgcn_mbcnt_lo(ones, 0u)); }
namespace pg8 {
#define PG8_LAS __attribute__((address_space(3)))
typedef unsigned short bf16_t;
typedef short bf16x8 __attribute__((ext_vector_type(8)));
typedef float f32x4 __attribute__((ext_vector_type(4)));
typedef unsigned u32x4 __attribute__((ext_vector_type(4)));
constexpr int BM = 256, BK = 64, HALF = 128, HTB = HALF * BK * 2, STAGE_BYTES = 8 * HTB, NXCD = 8, WGM = 8;

__host__ __device__ __forceinline__ int lds_byte(int r, int c) { const int st = (r >> 4) * 2 + (c >> 5), rr = r & 15, cc = c & 31, ob = rr * 64 + cc * 2; return st * 1024 + (ob ^ (((ob >> 9) & 1) << 5)); }
__host__ __device__ __forceinline__ void stage_rc(int b, int& R, int& C) { const int st = b / 1024, sb = b % 1024, swz = sb ^ (((sb >> 9) & 1) << 5); R = (st >> 1) * 16 + swz / 64; C = (st & 1) * 32 + (swz % 64) / 2; }
__host__ __device__ __forceinline__ int perm32(int rho) { const int n = rho >> 4, i = rho & 15; return 8 * (i >> 2) + 4 * n + (i & 3); }

struct Unit { int pm, pn, z, pad; size_t aoff, boff; };
struct Gemm { const bf16_t* A; const bf16_t* Bt; int K, lda, ldb, pad; };

struct StaticOrder {
    int nM, nN, nwg, G, c; size_t tsA, tsB;
    __device__ void init(int nM_, int nN_, int G_, int c_, size_t tsA_, size_t tsB_) { nM = nM_; nN = nN_; nwg = nM * nN; G = G_; c = c_; tsA = tsA_; tsB = tsB_; }
    __device__ bool next(int i, Unit& u) const {
        const long L = (long)i * G + c; if (L >= nwg) return false;
        int wgid = (int)L; { const int q = nwg / NXCD, r = nwg % NXCD, xcd = wgid % NXCD, off = wgid / NXCD; wgid = (xcd < r ? xcd * (q + 1) : r * (q + 1) + (xcd - r) * q) + off; }
        const int nig = WGM * nN, gid = wgid / nig, fm = gid * WGM, gsz = (nM - fm) < WGM ? (nM - fm) : WGM;
        u.pm = fm + ((wgid % nig) % gsz); u.pn = (wgid % nig) / gsz; u.z = 0; u.pad = 0; u.aoff = (size_t)u.pm * tsA; u.boff = (size_t)u.pn * tsB; return true;
    }
    __device__ __forceinline__ void a_ready(const Unit&) const {}
    __device__ __forceinline__ void done(const Unit&) const {}
};
struct CmpOrder {
    int G, c; size_t vdelta;
    __device__ bool next(int i, Unit& u) const {
        const long L = (long)i * G + c; if (L >= 128) return false;
        const int mlp = (int)L / 64, rem = (int)L % 64, pm = rem / 8, ks = rem % 8;
        u.pm = pm; u.pn = 0; u.z = mlp * 8 + ks; u.pad = 0;
        u.aoff = (mlp ? vdelta : 0) + (size_t)pm * 256 * 1024 * 2 + (size_t)ks * 512;
        u.boff = (size_t)mlp * 256 * 2048 * 2 + (size_t)ks * 512; return true;
    }
    __device__ __forceinline__ void a_ready(const Unit&) const {}
    __device__ __forceinline__ void done(const Unit&) const {}
};

__device__ __forceinline__ unsigned cvt_pk_bf16(float lo, float hi) { unsigned r; asm volatile("v_cvt_pk_bf16_f32 %0, %1, %2" : "=v"(r) : "v"(lo), "v"(hi)); return r; }

struct EpiBf16 {
    static constexpr bool PERM = true, AFTER_DRAIN = false;
    bf16_t* O; int ldc; bf16_t* halo;
    __device__ __forceinline__ void operator()(const f32x4 (&acc)[2][2][4][2], const Unit& u, int wr, int wc, int fr, int fq) const {
        const int row0 = u.pm * BM + wr * 64 + fr; const int col0 = u.pn * BM + wc * 32 + 8 * fq;
#pragma unroll
        for (int ai = 0; ai < 2; ++ai)
#pragma unroll
            for (int m = 0; m < 4; ++m) { const int row = row0 + ai * HALF + m * 16; bf16_t* rowp = O + (size_t)row * ldc + col0;
#pragma unroll
                for (int bj = 0; bj < 2; ++bj) { const f32x4 v0 = acc[ai][bj][m][0], v1 = acc[ai][bj][m][1];
                    u32x4 w; w.x = cvt_pk_bf16(v0[0], v0[1]); w.y = cvt_pk_bf16(v0[2], v0[3]); w.z = cvt_pk_bf16(v1[0], v1[1]); w.w = cvt_pk_bf16(v1[2], v1[3]);
                    *(u32x4*)(rowp + bj * HALF) = w;
                    if (halo != nullptr && m == 3 && fr >= 14) *(u32x4*)(halo + ((size_t)(row >> 6) * 2 + (fr - 14)) * ldc + col0 + bj * HALF) = w; } }
    }
};
struct EpiRes {
    static constexpr bool PERM = false, AFTER_DRAIN = false;
    const float* base; float* out; const float* gate;
    __device__ __forceinline__ void operator()(const f32x4 (&acc)[2][2][4][2], const Unit& u, int wr, int wc, int fr, int fq) const {
        const int row0 = u.pm * BM + wr * 64 + fr, col0 = u.pn * BM + wc * 32 + 4 * fq; const int b = (u.pm * BM) / 2048;
        f32x4 gv[2][2];
#pragma unroll
        for (int bj = 0; bj < 2; ++bj)
#pragma unroll
            for (int n = 0; n < 2; ++n) gv[bj][n] = *(const f32x4*)(gate + (size_t)b * 6144 + col0 + bj * HALF + n * 16);
#pragma unroll
        for (int ai = 0; ai < 2; ++ai) {
            f32x4 xv[4][2][2];
#pragma unroll
            for (int m = 0; m < 4; ++m) { const size_t ro = (size_t)(row0 + ai * HALF + m * 16) * 1024 + col0;
#pragma unroll
                for (int bj = 0; bj < 2; ++bj)
#pragma unroll
                    for (int n = 0; n < 2; ++n) xv[m][bj][n] = *(const f32x4*)(base + ro + bj * HALF + n * 16); }
#pragma unroll
            for (int m = 0; m < 4; ++m) { const size_t ro = (size_t)(row0 + ai * HALF + m * 16) * 1024 + col0;
#pragma unroll
                for (int bj = 0; bj < 2; ++bj)
#pragma unroll
                    for (int n = 0; n < 2; ++n) *(f32x4*)(out + ro + bj * HALF + n * 16) = xv[m][bj][n] + gv[bj][n] * acc[ai][bj][m][n]; }
        }
    }
};
struct EpiPart {
    static constexpr bool PERM = false, AFTER_DRAIN = false;
    float* P;
    __device__ __forceinline__ void operator()(const f32x4 (&acc)[2][2][4][2], const Unit& u, int wr, int wc, int fr, int fq) const {
        const int row0 = u.pm * BM + wr * 64 + fr, col0 = wc * 32 + 4 * fq;
#pragma unroll
        for (int ai = 0; ai < 2; ++ai)
#pragma unroll
            for (int m = 0; m < 4; ++m) { float* rowp = P + ((size_t)u.z * 2048 + row0 + ai * HALF + m * 16) * 256 + col0;
#pragma unroll
                for (int bj = 0; bj < 2; ++bj)
#pragma unroll
                    for (int n = 0; n < 2; ++n) *(f32x4*)(rowp + bj * HALF + n * 16) = acc[ai][bj][m][n]; }
    }
};


__device__ __forceinline__ float dpp_ror1(float x) { return __builtin_bit_cast(float, __builtin_amdgcn_update_dpp(0, __builtin_bit_cast(int, x), 0x121, 0xf, 0xf, false)); }
__device__ __forceinline__ float dpp_ror2(float x) { return __builtin_bit_cast(float, __builtin_amdgcn_update_dpp(0, __builtin_bit_cast(int, x), 0x122, 0xf, 0xf, false)); }
__device__ __forceinline__ float dpp_shr1(float old, float x) { return __builtin_bit_cast(float, __builtin_amdgcn_update_dpp(__builtin_bit_cast(int, old), __builtin_bit_cast(int, x), 0x111, 0xf, 0xf, false)); }
__device__ __forceinline__ float dpp_shr2(float old, float x) { return __builtin_bit_cast(float, __builtin_amdgcn_update_dpp(__builtin_bit_cast(int, old), __builtin_bit_cast(int, x), 0x112, 0xf, 0xf, false)); }
struct EpiConv {
    static constexpr bool PERM = true, AFTER_DRAIN = false;
    bf16_t* ACT; bf16_t* head; bf16_t* tail; const float* cw; const float* cb; PG8_LAS float* xb;
    __device__ __forceinline__ void operator()(const f32x4 (&acc)[2][2][4][2], const Unit& u, int wr, int wc, int fr, int fq) const {
        typedef __attribute__((address_space(1))) bf16_t gbf; typedef __attribute__((address_space(1))) unsigned gu32_;
        const int colh = wc * 32 + 8 * fq, FFc = 2816, FF2c = 5632;
        typedef __attribute__((address_space(1))) f32x4 gf4;
        f32x4 WA[2][3], WV[2][3], BA[2], BV[2];
#pragma unroll
        for (int n = 0; n < 2; ++n) { const int ca = u.pn * 128 + colh + 4 * n;
#pragma unroll
            for (int j = 0; j < 3; ++j) { WA[n][j] = *(const gf4*)(cw + j * FF2c + ca); WV[n][j] = *(const gf4*)(cw + j * FF2c + FFc + ca); }
            BA[n] = *(const gf4*)(cb + ca); BV[n] = *(const gf4*)(cb + FFc + ca); }
        if (fr >= 14) {
#pragma unroll
            for (int ai = 0; ai < 2; ++ai)
#pragma unroll
                for (int bj = 0; bj < 2; ++bj)
#pragma unroll
                    for (int n = 0; n < 2; ++n) *(PG8_LAS f32x4*)(xb + ((ai * 2 + wr) * 2 + (fr - 14)) * 256 + bj * 128 + colh + 4 * n) = acc[ai][bj][3][n];
            if (wr == 1) {
#pragma unroll
                for (int bj = 0; bj < 2; ++bj)
#pragma unroll
                    for (int n = 0; n < 2; ++n) { const f32x4 v = acc[1][bj][3][n]; gu32_* p = (gu32_*)((gbf*)tail + ((size_t)u.pm * 2 + (fr - 14)) * FF2c + bj * FFc + u.pn * 128 + colh + 4 * n);
                        p[0] = cvt_pk_bf16(v[0], v[1]); p[1] = cvt_pk_bf16(v[2], v[3]); }
            }
        }
        if (fr < 2 && wr == 0) {
#pragma unroll
            for (int bj = 0; bj < 2; ++bj)
#pragma unroll
                for (int n = 0; n < 2; ++n) { const f32x4 v = acc[0][bj][0][n]; gu32_* p = (gu32_*)((gbf*)head + ((size_t)u.pm * 2 + fr) * FF2c + bj * FFc + u.pn * 128 + colh + 4 * n);
                    p[0] = cvt_pk_bf16(v[0], v[1]); p[1] = cvt_pk_bf16(v[2], v[3]); }
        }
        asm volatile("s_waitcnt lgkmcnt(0)" ::: "memory"); __builtin_amdgcn_s_barrier(); asm volatile("" ::: "memory");
#pragma unroll
        for (int n = 0; n < 2; ++n) {
            const int ca = u.pn * 128 + colh + 4 * n;
            const f32x4 wa0 = WA[n][0], wa1 = WA[n][1], wa2 = WA[n][2], ba = BA[n], wv0 = WV[n][0], wv1 = WV[n][1], wv2 = WV[n][2], bv = BV[n];
#pragma unroll
            for (int ai = 0; ai < 2; ++ai) {
                const int sai = (ai == 0) ? 0 : (wr == 0 ? 0 : 1), swr = (ai == 0) ? 0 : (wr == 0 ? 1 : 0);
                const bool has = !(ai == 0 && wr == 0);
                f32x4 pa = {0.f, 0.f, 0.f, 0.f}, pv = {0.f, 0.f, 0.f, 0.f};
                if (fr >= 14 && has) { pa = *(const PG8_LAS f32x4*)(xb + ((sai * 2 + swr) * 2 + (fr - 14)) * 256 + colh + 4 * n); pv = *(const PG8_LAS f32x4*)(xb + ((sai * 2 + swr) * 2 + (fr - 14)) * 256 + 128 + colh + 4 * n); }
#pragma unroll
                for (int m = 0; m < 4; ++m) {
                    const f32x4 xa = acc[ai][0][m][n], xv = acc[ai][1][m][n];
                    float res[4];
#pragma unroll
                    for (int c = 0; c < 4; ++c) {
                        const float a1 = dpp_shr1(dpp_ror1(pa[c]), xa[c]), a2 = dpp_shr2(dpp_ror2(pa[c]), xa[c]);
                        const float v1 = dpp_shr1(dpp_ror1(pv[c]), xv[c]), v2 = dpp_shr2(dpp_ror2(pv[c]), xv[c]);
                        const float ya = ba[c] + wa0[c] * a2 + wa1[c] * a1 + wa2[c] * xa[c];
                        const float yv = bv[c] + wv0[c] * v2 + wv1[c] * v1 + wv2[c] * xv[c];
                        res[c] = ya * __builtin_amdgcn_rcpf(1.f + __builtin_amdgcn_exp2f(-1.4426950408889634f * ya)) * yv;
                    }
                    gu32_* p = (gu32_*)((gbf*)ACT + (size_t)(u.pm * BM + ai * HALF + wr * 64 + m * 16 + fr) * FFc + ca);
                    p[0] = cvt_pk_bf16(res[0], res[1]); p[1] = cvt_pk_bf16(res[2], res[3]);
                    pa = xa; pv = xv;
                }
            }
        }
    }
};

template <class Epi, class Sched, bool ALIGN_EPI>
__device__ __forceinline__ void gemm_phase(PG8_LAS unsigned char* lds, const Gemm g, const Sched& S, const Epi& E, int wave_id) {
    const int wid = wave_id, lane = opaque_lane(), tid = wid * 64 + lane, wr = wid >> 2, wc = wid & 3, fr = lane & 15, fq = lane >> 4;
    const int K = g.K, nt = K / BK;
    unsigned voffA[2], voffB[2];
#pragma unroll
    for (int i = 0; i < 2; ++i) { int R, C; stage_rc(tid * 16 + i * 8192, R, C); const int Rb = Epi::PERM ? ((R & ~31) + perm32(R & 31)) : R;
        voffA[i] = (unsigned)(R * g.lda + C) * 2u; voffB[i] = (unsigned)(Rb * g.ldb + C) * 2u; }
    const size_t kstep = (size_t)(BK * 2);
    const size_t hsA = (size_t)HALF * g.lda * 2, hsB = (size_t)HALF * g.ldb * 2;
    const unsigned ldsw = (unsigned)wid * 1024u;
    const int aoff = lds_byte(wr * 64 + fr, fq * 8), boff = lds_byte(wc * 32 + fr, fq * 8);
#define PG8_SA(b, h) (((b) * 2 + (h)) * HTB)
#define PG8_SB(b, h) ((4 + (b) * 2 + (h)) * HTB)
#define PG8_STAGE(bufoff, gbase, voff) do { _Pragma("unroll") for (int _i = 0; _i < 2; ++_i) \
        __builtin_amdgcn_global_load_lds((const unsigned*)((const char*)(gbase) + (voff)[_i]), (PG8_LAS unsigned*)(lds + (bufoff) + ldsw + _i * 8192), 16, 0, 0); } while (0)
#define PG8_LDA(dst, b, h) do { _Pragma("unroll") for (int m = 0; m < 4; ++m) _Pragma("unroll") for (int k = 0; k < 2; ++k) dst[m][k] = *(const PG8_LAS bf16x8*)(lds + PG8_SA(b, h) + aoff + m * 2048 + k * 1024); } while (0)
#define PG8_LDB(dst, b, h) do { _Pragma("unroll") for (int n = 0; n < 2; ++n) _Pragma("unroll") for (int k = 0; k < 2; ++k) dst[n][k] = *(const PG8_LAS bf16x8*)(lds + PG8_SB(b, h) + boff + n * 2048 + k * 1024); } while (0)
#define PG8_MMA(ai, bj, At, Bt) do { __builtin_amdgcn_s_setprio(1); _Pragma("unroll") for (int m = 0; m < 4; ++m) _Pragma("unroll") for (int n = 0; n < 2; ++n) _Pragma("unroll") for (int k = 0; k < 2; ++k) \
        acc[ai][bj][m][n] = __builtin_amdgcn_mfma_f32_16x16x32_bf16(Bt[n][k], At[m][k], acc[ai][bj][m][n], 0, 0, 0); __builtin_amdgcn_s_setprio(0); } while (0)
#define PG8_WAIT_V(n) asm volatile("s_waitcnt vmcnt(" #n ")" ::: "memory")
#define PG8_WAIT_L(n) asm volatile("s_waitcnt lgkmcnt(" #n ")" ::: "memory")
#define PG8_BAR __builtin_amdgcn_s_barrier()
#define PG8_SCHED __builtin_amdgcn_sched_barrier(0)
    Unit cur, nxt; int ui = 0;
    if (!S.next(0, cur)) return;
    f32x4 acc[2][2][4][2];
#pragma unroll
    for (int a = 0; a < 2; ++a)
#pragma unroll
        for (int b = 0; b < 2; ++b)
#pragma unroll
            for (int m = 0; m < 4; ++m)
#pragma unroll
                for (int n = 0; n < 2; ++n) acc[a][b][m][n] = (f32x4){0.f, 0.f, 0.f, 0.f};
    bf16x8 At[4][2], B0[2][2], B1[2][2];
    const char* cA = (const char*)g.A + cur.aoff; const char* cB = (const char*)g.Bt + cur.boff;
    S.a_ready(cur);
    PG8_STAGE(PG8_SB(0, 0), cB, voffB); PG8_STAGE(PG8_SB(0, 1), cB + hsB, voffB); PG8_STAGE(PG8_SA(0, 0), cA, voffA); PG8_STAGE(PG8_SA(0, 1), cA + hsA, voffA);
    if (wr == 1) PG8_BAR;
    PG8_WAIT_V(2); PG8_BAR;
    PG8_STAGE(PG8_SB(1, 0), cB + kstep, voffB); PG8_STAGE(PG8_SA(1, 0), cA + kstep, voffA); PG8_STAGE(PG8_SB(1, 1), cB + hsB + kstep, voffB);
    PG8_WAIT_V(6); PG8_BAR;
    for (;;) {
        const bool has_next = S.next(ui + 1, nxt);
        const char* nA = has_next ? (const char*)g.A + nxt.aoff : cA; const char* nB = has_next ? (const char*)g.Bt + nxt.boff : cB;
        for (int t = 0; t < nt; t += 2) {
            const bool last = (t == nt - 2);
            const char* a1 = cA + (size_t)(t + 1) * kstep;
            const char* a2 = last ? nA : cA + (size_t)(t + 2) * kstep; const char* b2 = last ? nB : cB + (size_t)(t + 2) * kstep;
            const char* a3 = a2 + kstep; const char* b3 = b2 + kstep;
            if (last && has_next) S.a_ready(nxt);
            PG8_LDB(B0, 0, 0); PG8_LDB(B1, 0, 1); PG8_SCHED; PG8_LDA(At, 0, 0); PG8_STAGE(PG8_SA(1, 1), a1 + hsA, voffA);
            PG8_WAIT_V(8); PG8_WAIT_L(0); PG8_BAR; PG8_MMA(0, 0, At, B0); PG8_MMA(0, 1, At, B1); PG8_BAR; PG8_SCHED;
            PG8_LDA(At, 0, 1); PG8_STAGE(PG8_SB(0, 0), b2, voffB); PG8_STAGE(PG8_SB(0, 1), b2 + hsB, voffB); PG8_STAGE(PG8_SA(0, 0), a2, voffA);
            PG8_WAIT_V(8); PG8_WAIT_L(0); PG8_BAR; PG8_MMA(1, 0, At, B0); PG8_MMA(1, 1, At, B1); PG8_BAR; PG8_SCHED;
            PG8_LDB(B0, 1, 0); PG8_LDB(B1, 1, 1); PG8_SCHED; PG8_LDA(At, 1, 0); PG8_STAGE(PG8_SA(0, 1), a2 + hsA, voffA);
            PG8_WAIT_V(8); PG8_WAIT_L(0); PG8_BAR; PG8_MMA(0, 0, At, B0); PG8_MMA(0, 1, At, B1); PG8_BAR; PG8_SCHED;
            PG8_LDA(At, 1, 1); PG8_STAGE(PG8_SB(1, 0), b3, voffB); PG8_STAGE(PG8_SB(1, 1), b3 + hsB, voffB); PG8_STAGE(PG8_SA(1, 0), a3, voffA);
            PG8_WAIT_V(8); PG8_WAIT_L(0); PG8_BAR; PG8_MMA(1, 0, At, B0); PG8_MMA(1, 1, At, B1); PG8_BAR; PG8_SCHED;
        }
        if constexpr (ALIGN_EPI) { if (wr == 0) PG8_BAR; }
        E(acc, cur, wr, wc, fr, fq); S.done(cur);
        if (!has_next) break;
#pragma unroll
        for (int a = 0; a < 2; ++a)
#pragma unroll
            for (int b = 0; b < 2; ++b)
#pragma unroll
                for (int m = 0; m < 4; ++m)
#pragma unroll
                    for (int n = 0; n < 2; ++n) acc[a][b][m][n] = (f32x4){0.f, 0.f, 0.f, 0.f};
        cur = nxt; cA = nA; cB = nB; ++ui;
        if constexpr (ALIGN_EPI) { if (wr == 1) PG8_BAR; }
    }
    PG8_WAIT_V(0);
    if constexpr (!ALIGN_EPI) { if (wr == 0) PG8_BAR; }
    PG8_BAR;
#undef PG8_SA
#undef PG8_SB
#undef PG8_STAGE
#undef PG8_LDA
#undef PG8_LDB
#undef PG8_MMA
#undef PG8_WAIT_V
#undef PG8_WAIT_L
#undef PG8_BAR
#undef PG8_SCHED
}
}

#define LAS __attribute__((address_space(3)))
#define GASQ __attribute__((address_space(1)))
#define GP(Tp, p) ((GASQ Tp*)(p))
#define GCP(Tp, p) ((const GASQ Tp*)(p))
typedef unsigned short bf16;
typedef float f32x4 __attribute__((ext_vector_type(4)));
typedef float f32x2 __attribute__((ext_vector_type(2)));
typedef unsigned v4u __attribute__((ext_vector_type(4)));
typedef unsigned v2u __attribute__((ext_vector_type(2)));

constexpr int NTHR = 512, NWAVES = 8;
constexpr int BSZ = 8, T = 2048, D = 1024, M = BSZ * T;
constexpr int ZLD = 3584, NZ = 3352, FF = 2816, FF2 = 5632, MODW = 6144;
constexpr int ZC_HQ = 0, ZC_HF = 512, ZC_HI = 1024, ZC_HG = 1536, ZC_NQ = 2048, ZC_KC = 2560, ZC_VC = 2688, ZC_KS = 2816, ZC_VS = 2944, ZC_KW = 3072, ZC_VW = 3200, ZC_NG = 3328;
constexpr float EPS = 1e-6f;
constexpr size_t MiB = 1u << 20;
constexpr size_t WS_WIN = 0, WS_WOUT = 7 * MiB, WS_WUP = 9 * MiB, WS_WDN = 20 * MiB, WS_WC1 = 26 * MiB;
constexpr size_t WS_MOD = 28 * MiB, WS_C1 = 28 * MiB + 256 * 1024, WS_KVCMP = 29 * MiB  , WS_HALO = 32 * MiB  ;
constexpr size_t WS_H = 40 * MiB  , WS_Z = 72 * MiB  ;
constexpr size_t WS_QN = 184 * MiB  , WS_KC = 200 * MiB, WS_VC = 205 * MiB, WS_KS = 210 * MiB, WS_VS = 215 * MiB, WS_KW = 220 * MiB, WS_VW = 225 * MiB;
constexpr size_t WS_U = 72 * MiB  , WS_END = 248 * MiB;
constexpr size_t WS_HGT = 229 * MiB  , WS_HVEC = 245 * MiB + 512 * 1024  ;
constexpr size_t WS_BAR = 39 * MiB;
constexpr int LDS_BYTES = 147456;

struct Args { const float* in[20]; float* out; unsigned char* ws; };

__device__ __forceinline__ unsigned f2bf(float f) { unsigned u = __builtin_bit_cast(unsigned, f); return (u + 0x7fffu + ((u >> 16) & 1u)) >> 16; }
__device__ __forceinline__ unsigned pk2(float lo, float hi) { return f2bf(lo) | (f2bf(hi) << 16); }
__device__ __forceinline__ float bf2f(unsigned short h) { return __builtin_bit_cast(float, (unsigned)h << 16); }
__device__ __forceinline__ float bflo(unsigned w) { return __builtin_bit_cast(float, w << 16); }
__device__ __forceinline__ float bfhi(unsigned w) { return __builtin_bit_cast(float, w & 0xffff0000u); }
#define DPPF(x, ctrl) __builtin_bit_cast(float, __builtin_amdgcn_update_dpp(0, __builtin_bit_cast(int, (x)), (ctrl), 0xf, 0xf, false))
__device__ __forceinline__ float wave_sum(float v) {
    v += DPPF(v, 0xB1); v += DPPF(v, 0x4E); v += DPPF(v, 0x141); v += DPPF(v, 0x140);
    v += __shfl_xor(v, 16);
    v += __shfl_xor(v, 32);
    return v;
}
__device__ __forceinline__ float wave_max(float v) {
    v = fmaxf(v, DPPF(v, 0xB1)); v = fmaxf(v, DPPF(v, 0x4E)); v = fmaxf(v, DPPF(v, 0x141)); v = fmaxf(v, DPPF(v, 0x140));
    v = fmaxf(v, __shfl_xor(v, 16));
    v = fmaxf(v, __shfl_xor(v, 32));
    return v;
}
__device__ __forceinline__ float xor32f(float x, int lane) { (void)lane; return __shfl_xor(x, 32); }
__device__ __forceinline__ float sigmoidf_(float x) { return __builtin_amdgcn_rcpf(1.f + __builtin_amdgcn_exp2f(-1.4426950408889634f * x)); }
__device__ __forceinline__ float siluf_(float x) { return x * __builtin_amdgcn_rcpf(1.f + __builtin_amdgcn_exp2f(-1.4426950408889634f * x)); }
#define LDS_FENCE() asm volatile("s_waitcnt lgkmcnt(0)" ::: "memory")
typedef short bf16x8 __attribute__((ext_vector_type(8)));
__device__ __forceinline__ float ex2(float x) { return __builtin_amdgcn_exp2f(x); }

struct Frame {
    LAS unsigned char* lds;
    int tid, lane, wave, G, blk;
};
constexpr int ARGTAB = 147200;
__device__ __forceinline__ const float* argp(const Frame& F, int k) {
    const LAS unsigned* tab = (const LAS unsigned*)(F.lds + ARGTAB);
    const unsigned lo = (unsigned)__builtin_amdgcn_readfirstlane((int)tab[2 * k]), hi = (unsigned)__builtin_amdgcn_readfirstlane((int)tab[2 * k + 1]);
    return (const float*)(((unsigned long long)hi << 32) | (unsigned long long)lo);
}
struct ArgsV { Frame F; struct InV { Frame F; __device__ __forceinline__ const float* operator[](int k) const { return argp(F, k); } } in; unsigned char* ws; float* out; };
__device__ __forceinline__ ArgsV args_view(const Frame& F) { ArgsV A; A.F = F; A.in.F = F; A.ws = (unsigned char*)argp(F, 21); A.out = (float*)argp(F, 20); return A; }
__device__ __forceinline__ Frame phase_frame(Frame F) { F.lane = opaque_lane(); F.tid = F.wave * 64 + F.lane; return F; }

template <bool UPMAP>
__device__ __forceinline__ void p0_transpose_item(const float* W, int K, int N, bf16* WT, LAS float* scr, int item, int nblk, int lane) {
    const int kb = item / nblk, nb = item % nblk, k0 = 64 * kb, n0 = 32 * nb;
    const int d0 = UPMAP ? ((n0 < FF) ? ((n0 >> 7) * 256 + (n0 & 127)) : ((((n0 - FF) >> 7) * 256) + 128 + ((n0 - FF) & 127))) : n0;
    const bool nok = (n0 + (lane & 31)) < N;
    float tv[32];
#pragma unroll
    for (int i = 0; i < 32; ++i) { const int kk = 2 * i + (lane >> 5); tv[i] = nok ? GCP(float, W)[(size_t)(k0 + kk) * N + n0 + (lane & 31)] : 0.f; }
#pragma unroll
    for (int i = 0; i < 32; ++i) { const int kk = 2 * i + (lane >> 5); scr[kk * 33 + (lane & 31)] = tv[i]; }
    if (false)
    for (int i = 0; i < 32; ++i) { const int kk = 2 * i + (lane >> 5); scr[kk * 33 + (lane & 31)] = nok ? GCP(float, W)[(size_t)(k0 + kk) * N + n0 + (lane & 31)] : 0.f; }
    LDS_FENCE();
    const int c = lane & 7;
#pragma unroll
    for (int j = 0; j < 4; ++j) { const int n = (lane >> 3) + 8 * j; const LAS float* s = scr + (8 * c) * 33 + n;
        v4u o; o.x = pk2(s[0 * 33], s[1 * 33]); o.y = pk2(s[2 * 33], s[3 * 33]); o.z = pk2(s[4 * 33], s[5 * 33]); o.w = pk2(s[6 * 33], s[7 * 33]);
        *GP(v4u, WT + (size_t)(d0 + n) * K + k0 + 8 * c) = o; }
    LDS_FENCE();
}

__device__ __forceinline__ void phase0(const Frame& F) {
    const ArgsV A = args_view(F); unsigned char* ws = A.ws;
    LAS float* sc = (LAS float*)F.lds;
    LAS float* red = (LAS float*)(F.lds + 32768);
    const float* c = A.in[1]; const float* w_ada = A.in[3]; const float* b_ada = A.in[4];
    float* mod = (float*)(ws + WS_MOD);
    { float cv[16];
#pragma unroll
      for (int i = 0; i < 16; ++i) cv[i] = GCP(float, c)[F.tid + i * NTHR];
#pragma unroll
      for (int i = 0; i < 16; ++i) sc[F.tid + i * NTHR] = siluf_(cv[i]); }
    __syncthreads();
    for (int cb = F.blk; cb < 256; cb += F.G) {
        const int n0 = cb * 24, col = F.tid % 24, kg = F.tid / 24;
        if (F.tid < 504) {
            float acc[8];
#pragma unroll
            for (int b = 0; b < 8; ++b) acc[b] = 0.f;
#pragma unroll 7
            for (int k = kg; k < 1024; k += 21) { const float w = GCP(float, w_ada)[(size_t)k * MODW + n0 + col];
#pragma unroll
                for (int b = 0; b < 8; ++b) acc[b] += sc[b * 1024 + k] * w; }
#pragma unroll
            for (int b = 0; b < 8; ++b) red[(kg * 24 + col) * 8 + b] = acc[b];
        }
        __syncthreads();
        if (F.tid < 192) { const int cc = F.tid % 24, b = F.tid / 24; float s = b_ada[n0 + cc];
            for (int g = 0; g < 21; ++g) s += red[(g * 24 + cc) * 8 + b];
            mod[b * MODW + n0 + cc] = s; }
        __syncthreads();
    }
    __syncthreads();
}
__device__ __forceinline__ void phase0b(const Frame& F) {
    const ArgsV A = args_view(F); unsigned char* ws = A.ws;
    LAS float* scr = (LAS float*)(F.lds + F.wave * 16384);
    const int gw = F.blk * NWAVES + F.wave, NGW = F.G * NWAVES;
    constexpr int I_IN = 16 * 105, I_OUT = 16 * 32, I_UP = 16 * 176, I_DN = 44 * 32, I_C1 = 32 * 8;
    constexpr int NITEMS = I_IN + I_OUT + I_UP + I_DN + 2 * I_C1;
    for (int it = gw; it < NITEMS; it += NGW) {
        int r = it;
        if (r < I_IN) { p0_transpose_item<false>(A.in[6], 1024, NZ, (bf16*)(ws + WS_WIN), scr, r, 105, F.lane); continue; } r -= I_IN;
        if (r < I_OUT) { p0_transpose_item<false>(A.in[14], 1024, 1024, (bf16*)(ws + WS_WOUT), scr, r, 32, F.lane); continue; } r -= I_OUT;
        if (r < I_UP) { p0_transpose_item<true>(A.in[16], 1024, FF2, (bf16*)(ws + WS_WUP), scr, r, 176, F.lane); continue; } r -= I_UP;
        if (r < I_DN) { p0_transpose_item<false>(A.in[19], FF, 1024, (bf16*)(ws + WS_WDN), scr, r, 32, F.lane); continue; } r -= I_DN;
        if (r < I_C1) { p0_transpose_item<false>(A.in[12], 2048, 256, (bf16*)(ws + WS_WC1), scr, r, 8, F.lane); continue; } r -= I_C1;
        p0_transpose_item<false>(A.in[12] + (size_t)2048 * 256, 2048, 256, (bf16*)(ws + WS_WC1) + (size_t)256 * 2048, scr, r, 8, F.lane);
    }
    { v4u* z = (v4u*)((bf16*)(ws + WS_WIN) + (size_t)3360 * 1024); const int n16 = 224 * 1024 * 2 / 16;
      for (int i = F.blk * NTHR + F.tid; i < n16; i += F.G * NTHR) z[i] = (v4u){0u, 0u, 0u, 0u}; }
}

__device__ __forceinline__ void phase_c1(const Frame& F, int blk0) {
    if (F.blk < blk0) return;
    const ArgsV A = args_view(F); unsigned char* ws = A.ws;
    const GASQ float* pe = GCP(float, A.in[11]); const GASQ float* w1 = GCP(float, A.in[12]); GASQ float* c1p = GP(float, ws + WS_C1);
    for (int it = (F.blk - blk0) * NWAVES + F.wave; it < 128; it += (F.G - blk0) * NWAVES) {
        const int ks = it >> 3, i = (it >> 2) & 1, j = (it & 3) * 64 + F.lane;
        float s = 0.f;
#pragma unroll 8
        for (int k = ks * 128; k < ks * 128 + 128; ++k) s += pe[i * 2048 + k] * w1[((size_t)i * 2048 + k) * 256 + j];
        c1p[(ks * 2 + i) * 256 + j] = s;
    }
}
__device__ __forceinline__ void norm_mod_rows(const Frame& F, const float* x, const float* g, int sh_off, int sc_off, bf16* H, int m_begin, int m_end, int m_step) {
    const float* mod = (const float*)((unsigned char*)argp(F, 21) + WS_MOD);
    for (int m0 = m_begin; m0 < m_end; m0 += 2 * m_step) {
        const int m1 = m0 + m_step; const bool two = m1 < m_end; const int mm[2] = {m0, two ? m1 : m0};
        f32x4 v[2][4]; float s[2] = {0.f, 0.f};
#pragma unroll
        for (int r = 0; r < 2; ++r) { const GASQ f32x4* xr = GCP(f32x4, x + (size_t)mm[r] * D) + F.lane;
#pragma unroll
            for (int j = 0; j < 4; ++j) v[r][j] = xr[64 * j]; }
#pragma unroll
        for (int r = 0; r < 2; ++r)
#pragma unroll
            for (int j = 0; j < 4; ++j) s[r] += (v[r][j].x * v[r][j].x + v[r][j].y * v[r][j].y) + (v[r][j].z * v[r][j].z + v[r][j].w * v[r][j].w);
#pragma unroll
        for (int r = 0; r < 2; ++r) {
            if (r == 1 && !two) break;
            const int m = mm[r], b = m / T;
            const float rstd = rsqrtf(wave_sum(s[r]) * (1.f / D) + EPS);
            GASQ v2u* o8 = GP(v2u, H + (size_t)m * D) + F.lane;
#pragma unroll
            for (int j = 0; j < 4; ++j) {
                const int k = (F.lane + 64 * j) * 4;
                const f32x4 gg = *GCP(f32x4, g + k), sc = *GCP(f32x4, mod + b * MODW + sc_off + k), sh = *GCP(f32x4, mod + b * MODW + sh_off + k);
                const f32x4 y = v[r][j] * rstd * gg * (sc + 1.f) + sh;
                v2u w; w.x = pk2(y.x, y.y); w.y = pk2(y.z, y.w); o8[64 * j] = w;
            }
        }
    }
}
__device__ __forceinline__ void phase_norm_mod(const Frame& F, const float* x, const float* g, int sh_off, int sc_off, bf16* H) {
    norm_mod_rows(F, x, g, sh_off, sc_off, H, F.blk * NWAVES + F.wave, M, F.G * NWAVES);
}
__device__ __forceinline__ void phase_nsa_prep(const Frame& F) {
    const ArgsV A = args_view(F); unsigned char* ws = A.ws;
    const GASQ bf16* Z = GCP(bf16, ws + WS_Z);
    const GASQ int* pos = GCP(int, A.in[2]);
    const int gw = F.blk * NWAVES + F.wave, NGW = F.G * NWAVES, lane = F.lane;
    const float invt[8] = {1.0f, 0.1939227432012558f, 0.03760603070259094f, 0.007292664609849453f, 0.0014142135623842478f, 0.00027424818836152554f, 5.3182957344688475e-05f, 1.0313385246263351e-05f};
    float inv = 0.f;
#pragma unroll
    for (int i = 0; i < 8; ++i) inv = ((lane & 7) == i) ? invt[i] : inv;
    const float gq = GCP(float, A.in[9])[lane], gk0 = GCP(float, A.in[10])[lane], gk1 = GCP(float, A.in[10])[64 + lane], gk2 = GCP(float, A.in[10])[128 + lane];
    for (int m = gw; m < M; m += NGW) {
        const int b = m / T, t = m % T;
        const GASQ bf16* zr = Z + (size_t)m * ZLD + ZC_NQ + lane;
        unsigned short zv[20];
#pragma unroll
        for (int v = 0; v < 20; ++v) zv[v] = (v == 14 || v == 15 || v == 18 || v == 19) ? (unsigned short)0 : zr[v * 64];
        const float rev = (float)pos[m] * inv * 0.15915494309189535f;
        const float fr = rev - floorf(rev);
        const float cs = __builtin_amdgcn_cosf(fr), sn = __builtin_amdgcn_sinf(fr);
#pragma unroll
        for (int v = 0; v < 20; ++v) {
            if (v == 14 || v == 15 || v == 18 || v == 19) continue;
            GASQ bf16* dst;
            if (v < 8) dst = GP(bf16, ws + WS_QN) + ((size_t)(b * 8 + v) * T + t) * 64;
            else { const size_t off = v < 10 ? WS_KC : v < 12 ? WS_VC : v < 14 ? WS_KS : WS_KW; dst = GP(bf16, ws + off) + ((size_t)(b * 2 + (v & 1)) * T + t) * 64; }
            if (v == 10 || v == 11) { dst[lane] = zv[v]; continue; }
            const float x = bf2f(zv[v]);
            const float ss = wave_sum(x * x);
            const float gsel = v < 8 ? gq : v < 10 ? gk0 : v < 14 ? gk1 : gk2;
            float y = x * rsqrtf(ss * (1.f / 64.f) + EPS) * gsel;
            const float partner = DPPF(y, 0x128);
            if (lane < 8) y = y * cs - partner * sn; else if (lane < 16) y = y * cs + partner * sn;
            dst[lane] = (bf16)f2bf(v < 8 ? y * 0.18033688011112042f   : y);
        }
    }
    for (int it = gw; it < BSZ * 2 * 2 * 32; it += NGW) {
        const int tb = it & 31, br = (it >> 5) & 1, gi = (it >> 6) & 1, b = it >> 7;
        const GASQ bf16* zr = Z + ((size_t)b * T + tb * 64) * ZLD + (br == 0 ? ZC_VS : ZC_VW) + gi * 64 + lane;
        GASQ bf16* dst = GP(bf16, ws + (br == 0 ? WS_VS : WS_VW)) + ((size_t)(b * 2 + gi) * 64 + lane) * T + tb * 64;
#pragma unroll
        for (int c8 = 0; c8 < 8; ++c8) {
            unsigned w[4];
#pragma unroll
            for (int e = 0; e < 4; ++e) { const unsigned lo = zr[(size_t)(c8 * 8 + 2 * e) * ZLD], hi = zr[(size_t)(c8 * 8 + 2 * e + 1) * ZLD]; w[e] = lo | (hi << 16); }
            *(GASQ v4u*)(dst + c8 * 8) = (v4u){w[0], w[1], w[2], w[3]};
        }
    }
}

constexpr int HG_P = 0, HG_G = 17408, HG_GT = 34816, HG_AM = 53248, HG_ST = 72704  , HG_VT = 66816, HG_TOT = 69120, HG_VEC = 71168;
#define MFMA16(a, b, c) __builtin_amdgcn_mfma_f32_16x16x32_bf16((a), (b), (c), 0, 0, 0)
__device__ __forceinline__ void phase_hg_prep(const Frame& F, float* OUTB) {
    const ArgsV A = args_view(F); const GASQ bf16* Z = GCP(bf16, A.ws + WS_Z);
    const float* lbl = A.in[7];
    GASQ bf16* Pg = GP(bf16, A.ws + WS_H); GASQ bf16* Gg = Pg + (size_t)1024 * 8192;
    GASQ bf16* GTg = GP(bf16, A.ws + WS_HGT); GASQ float* VECg = GP(float, A.ws + WS_HVEC);
    const int tid = F.tid; LAS float* TOT = (LAS float*)(F.lds + HG_TOT);
    const int k = tid & 127, rg = tid >> 7;
    const float lb0 = 1.f / (1.f + expf(lbl[512 + k] - lbl[k])), lb1 = 1.f / (1.f + expf(lbl[640 + k] - lbl[128 + k])), lb2 = 1.f / (1.f + expf(lbl[768 + k] - lbl[256 + k])), lb3 = 1.f / (1.f + expf(lbl[896 + k] - lbl[384 + k]));
#pragma unroll 1
    for (int it = F.blk; it < 1024; it += F.G) {
        const int bh = it >> 5, c = it & 31, b = bh >> 2, h = bh & 3, ch = h * 128 + k;
        const float lb = (h == 0) ? lb0 : (h == 1) ? lb1 : (h == 2) ? lb2 : lb3;
        const GASQ bf16* zb = Z + ((size_t)b * T + c * 64 + rg * 16) * ZLD + ch;
        unsigned short zf[16], zq[16];
#pragma unroll
        for (int i = 0; i < 16; ++i) { zf[i] = zb[i * ZLD + ZC_HF]; zq[i] = zb[i * ZLD + ZC_HQ]; }
        float cum[16], qv[16], kv[16]; float run = 0.f;
#pragma unroll
        for (int i = 0; i < 16; ++i) {
            const float z1 = bf2f(zf[i]), z2 = bf2f(zq[i]);
            const float sg = __builtin_amdgcn_rcpf(1.f + ex2(-1.4426950408889634f * z1));
            const float f = lb + (1.f - lb) * sg;
            run += __builtin_amdgcn_logf(f); cum[i] = run; kv[i] = 1.f - f;
            qv[i] = z2 * __builtin_amdgcn_rcpf(1.f + ex2(-1.4426950408889634f * z2));
        }
        __syncthreads();
        TOT[rg * 128 + k] = run;
        __syncthreads();
        const float t0 = TOT[k], t1 = TOT[128 + k], t2 = TOT[256 + k], t3 = TOT[384 + k];
        const float e0 = t0 + t1, Bt = e0 + (t2 + t3);
        const float off = (rg == 0) ? 0.f : (rg == 1) ? t0 : (rg == 2) ? e0 : (e0 + t2);
        unsigned gt[8];
#pragma unroll
        for (int i = 0; i < 16; ++i) {
            const float bt = off + cum[i];
            const float p = qv[i] * ex2(bt - e0), g = kv[i] * ex2(e0 - bt);
            const unsigned gb = f2bf(g);
            Pg[((size_t)it * 64 + rg * 16 + i) * 128 + k] = (bf16)f2bf(p);
            Gg[((size_t)it * 64 + rg * 16 + i) * 128 + k] = (bf16)gb;
            if (i & 1) gt[i >> 1] |= gb << 16; else gt[i >> 1] = gb;
        }
        *(GASQ v4u*)(GTg + ((size_t)it * 128 + k) * 64 + rg * 16) = (v4u){gt[0], gt[1], gt[2], gt[3]};
        *(GASQ v4u*)(GTg + ((size_t)it * 128 + k) * 64 + rg * 16 + 8) = (v4u){gt[4], gt[5], gt[6], gt[7]};
        if (rg == 0) { VECg[(size_t)it * 384 + k] = ex2(e0); VECg[(size_t)it * 384 + 128 + k] = ex2(Bt); VECg[(size_t)it * 384 + 256 + k] = ex2(Bt - e0); }
    }
    __syncthreads();
}
__device__ __forceinline__ void phase_hg_scan(const Frame& F, float* OHG) {
    const ArgsV A = args_view(F); const GASQ bf16* Z = GCP(bf16, A.ws + WS_Z);
    const GASQ bf16* Pg = GCP(bf16, A.ws + WS_H); const GASQ bf16* Gg = Pg + (size_t)1024 * 8192;
    const GASQ bf16* GTg = GCP(bf16, A.ws + WS_HGT); const GASQ float* VECg = GCP(float, A.ws + WS_HVEC);
    const int tid = F.tid, lane = F.lane, w = F.wave, fr = lane & 15, fq = lane >> 4;
    LAS unsigned char* L = F.lds;
    LAS float* VEC = (LAS float*)(L + HG_VEC);
#pragma unroll 1
    for (int item = F.blk; item < 256; item += F.G) {
        const int bh = (item & 7) * 4 + (item >> 6), vs = (item >> 3) & 7, b = bh >> 2, h = bh & 3, it0 = bh * 32, oitem = bh * 8 + vs;
        const GASQ bf16* zb = Z + (size_t)b * T * ZLD;
        const unsigned vo = (unsigned)((tid >> 4) * 2 * ZLD + ZC_HI + h * 128 + vs * 16 + (tid & 15));
        const int r0 = tid >> 4, c16 = tid & 15, k0 = tid >> 3, c8 = tid & 7;
        const unsigned pgo = (unsigned)(r0 * 128 + c16 * 8), gto = (unsigned)(k0 * 64 + c8 * 8);
        f32x4 S = {0.f, 0.f, 0.f, 0.f};
        v4u sp[2], sg[2], st[2]; f32x4 sv = {0.f, 0.f, 0.f, 0.f}; unsigned short vr[2];
#define HG_LOAD(cc) do { const size_t itc = (size_t)(it0 + (cc)); \
            sp[0] = *(const GASQ v4u*)(Pg + itc * 8192 + pgo); sp[1] = *(const GASQ v4u*)(Pg + itc * 8192 + 4096 + pgo); \
            sg[0] = *(const GASQ v4u*)(Gg + itc * 8192 + pgo); sg[1] = *(const GASQ v4u*)(Gg + itc * 8192 + 4096 + pgo); \
            st[0] = *(const GASQ v4u*)(GTg + itc * 8192 + gto); st[1] = *(const GASQ v4u*)(GTg + itc * 8192 + 4096 + gto); \
            if (tid < 96) sv = *(const GASQ f32x4*)(VECg + itc * 384 + tid * 4); \
            vr[0] = zb[(unsigned)((cc) * 64 * ZLD) + vo]; vr[1] = zb[(unsigned)((cc) * 64 * ZLD) + vo + ZLD]; } while (0)
        HG_LOAD(0);
#pragma unroll 1
        for (int c = 0; c < 32; ++c) {
            *(LAS v4u*)(L + HG_P + r0 * 272 + c16 * 16) = sp[0]; *(LAS v4u*)(L + HG_P + (r0 + 32) * 272 + c16 * 16) = sp[1];
            *(LAS v4u*)(L + HG_G + r0 * 272 + c16 * 16) = sg[0]; *(LAS v4u*)(L + HG_G + (r0 + 32) * 272 + c16 * 16) = sg[1];
            *(LAS v4u*)(L + HG_GT + k0 * 144 + c8 * 16) = st[0]; *(LAS v4u*)(L + HG_GT + (k0 + 64) * 144 + c8 * 16) = st[1];
            if (tid < 96) *(LAS f32x4*)(VEC + tid * 4) = sv;
            *(LAS unsigned*)(L + HG_VT + (tid & 15) * 144 + (tid >> 4) * 4) = (unsigned)vr[0] | ((unsigned)vr[1] << 16);
            if (c < 31) HG_LOAD(c + 1);
            __syncthreads();
            { const int kk = 16 * w + fq * 4; const f32x4 ev = *(const LAS f32x4*)(VEC + kk);
              v2u sw; sw.x = pk2(ev.x * S.x, ev.y * S.y); sw.y = pk2(ev.z * S.z, ev.w * S.w);
              *(LAS v2u*)(L + HG_ST + fr * 272 + kk * 2) = sw; }
#pragma unroll
            for (int q2 = 0; q2 < 2; ++q2) {
                const int tt = 2 * w + q2, ti = tt >> 2, tj = tt & 3;
                f32x4 acc = {0.f, 0.f, 0.f, 0.f};
#pragma unroll
                for (int ks = 0; ks < 4; ++ks) {
                    const bf16x8 pa = *(const LAS bf16x8*)(L + HG_P + (16 * ti + fr) * 272 + (ks * 32 + fq * 8) * 2);
                    const bf16x8 gb = *(const LAS bf16x8*)(L + HG_G + (16 * tj + fr) * 272 + (ks * 32 + fq * 8) * 2);
                    acc = MFMA16(pa, gb, acc);
                }
                asm volatile("s_nop 7\n\ts_nop 7" ::: "memory");
#pragma unroll
                for (int j = 0; j < 4; ++j) { const bool keep = (tj < ti) || ((tj == ti) && (fq * 4 + j >= fr)); acc[j] = keep ? acc[j] : 0.f; }
#pragma unroll
                for (int j = 0; j < 4; ++j) {
                    const unsigned ab = f2bf(acc[j]), ao = (unsigned)__builtin_amdgcn_update_dpp(0, (int)ab, 0xB1, 0xf, 0xf, false);
                    if ((j & 1) == (fr & 1)) *(LAS unsigned*)(L + HG_AM + (16 * ti + fq * 4 + j) * 144 + (16 * tj + (fr & ~1)) * 2) = (fr & 1) ? (ao | (ab << 16)) : (ab | (ao << 16));
                }
            }
            __syncthreads();
            {
                const int wr = w & 3;
                f32x4 o = {0.f, 0.f, 0.f, 0.f};
                if (w < 4) {
#pragma unroll
                    for (int ks = 0; ks < 4; ++ks) {
                        const bf16x8 pa = *(const LAS bf16x8*)(L + HG_P + (16 * wr + fr) * 272 + (ks * 32 + fq * 8) * 2);
                        const bf16x8 sb = *(const LAS bf16x8*)(L + HG_ST + fr * 272 + (ks * 32 + fq * 8) * 2);
                        o = MFMA16(pa, sb, o);
                    }
#pragma unroll
                    for (int ks = 0; ks < 2; ++ks) {
                        const bf16x8 aa = *(const LAS bf16x8*)(L + HG_AM + (16 * wr + fr) * 144 + (ks * 32 + fq * 8) * 2);
                        const bf16x8 vb = *(const LAS bf16x8*)(L + HG_VT + fr * 144 + (ks * 32 + fq * 8) * 2);
                        o = MFMA16(aa, vb, o);
                    }
                    asm volatile("s_nop 7\n\ts_nop 7" ::: "memory");
                    GASQ float* op = GP(float, OHG + ((size_t)oitem * T + c * 64 + 16 * wr + fq * 4) * 16 + fr);
#pragma unroll
                    for (int j = 0; j < 4; ++j) op[j * 16] = o[j];
                }
            }
            {
                f32x4 u = {0.f, 0.f, 0.f, 0.f};
#pragma unroll
                for (int ks = 0; ks < 2; ++ks) {
                    const bf16x8 ga = *(const LAS bf16x8*)(L + HG_GT + (16 * w + fr) * 144 + (ks * 32 + fq * 8) * 2);
                    const bf16x8 vb = *(const LAS bf16x8*)(L + HG_VT + fr * 144 + (ks * 32 + fq * 8) * 2);
                    u = MFMA16(ga, vb, u);
                }
                asm volatile("s_nop 7\n\ts_nop 7" ::: "memory");
                const int kk = 16 * w + fq * 4; const f32x4 eB = *(const LAS f32x4*)(VEC + 128 + kk), eD = *(const LAS f32x4*)(VEC + 256 + kk);
                S = eB * S + eD * u;
            }
            __syncthreads();
        }
#undef HG_LOAD
    }
}
__device__ __forceinline__ void phase_hg_scan_v1(const Frame& F, float* OHG) {
    const ArgsV A = args_view(F); const bf16* Z = (const bf16*)(A.ws + WS_Z);
    const float* lbl = A.in[7];
    LAS float* Fm = (LAS float*)F.lds;
    LAS float* Qm = (LAS float*)(F.lds + 32768);
    LAS float* Vm = (LAS float*)(F.lds + 65536);
    LAS float* Om = (LAS float*)(F.lds + 69632);
    const int tid = F.tid, lane = F.lane;
    for (int item = F.blk; item < 256; item += F.G) {
        const int b = item >> 5, h = (item >> 3) & 3, vs = item & 7;
        const int col = tid & 127; const int ch = h * 128 + col;
        const float lb = 1.f / (1.f + expf(lbl[512 + ch] - lbl[ch]));
        const int k0 = (lane & 31) * 4, vloc = F.wave * 2 + (lane >> 5);
        float S0 = 0.f, S1 = 0.f, S2 = 0.f, S3 = 0.f;
        for (int c = 0; c < 32; ++c) {
            __syncthreads();
            const size_t mbase = (size_t)b * T + c * 64;
#pragma unroll 4
            for (int i = 0; i < 16; ++i) { const int row = (tid >> 7) + 4 * i; const bf16* zr = Z + (mbase + row) * ZLD;
                const float zf = bf2f(zr[ZC_HF + ch]), zq = bf2f(zr[ZC_HQ + ch]);
                Fm[row * 128 + col] = lb + (1.f - lb) * sigmoidf_(zf); Qm[row * 128 + col] = siluf_(zq); }
#pragma unroll
            for (int i = 0; i < 2; ++i) { const int idx = tid + 512 * i, row = idx >> 4, vc = idx & 15; Vm[idx] = bf2f(Z[(mbase + row) * ZLD + ZC_HI + h * 128 + vs * 16 + vc]); }
            __syncthreads();
            for (int t = 0; t < 64; ++t) {
                const f32x4 f4 = *(const LAS f32x4*)(Fm + t * 128 + k0), q4 = *(const LAS f32x4*)(Qm + t * 128 + k0); const float vt = Vm[t * 16 + vloc];
                S0 = f4.x * S0 + (1.f - f4.x) * vt; S1 = f4.y * S1 + (1.f - f4.y) * vt; S2 = f4.z * S2 + (1.f - f4.z) * vt; S3 = f4.w * S3 + (1.f - f4.w) * vt;
                float p = (q4.x * S0 + q4.y * S1) + (q4.z * S2 + q4.w * S3);
                p += __shfl_xor(p, 1); p += __shfl_xor(p, 2); p += __shfl_xor(p, 4); p += __shfl_xor(p, 8); p += __shfl_xor(p, 16);
                if ((lane & 31) == 0) Om[t * 16 + vloc] = p;
            }
            __syncthreads();
#pragma unroll
            for (int i = 0; i < 2; ++i) { const int idx = tid + 512 * i, row = idx >> 4, vc = idx & 15; OHG[((size_t)item * T + c * 64 + row) * 16 + vc] = Om[idx]; }
        }
        __syncthreads();
    }
}
__device__ __forceinline__ void phase_hg_norm(const Frame& F, const float* OHG) {
    const ArgsV A = args_view(F); const bf16* Z = (const bf16*)(A.ws + WS_Z); bf16* MIX = (bf16*)(A.ws + WS_H);
    const int gw = F.blk * NWAVES + F.wave, NGW = F.G * NWAVES, lane = F.lane;
    const f32x2 ngv = *GCP(f32x2, A.in[8] + 2 * lane);
    for (int m = gw; m < M; m += NGW) {
        f32x2 o[4]; unsigned gz[4];
#pragma unroll
        for (int h = 0; h < 4; ++h) {
            o[h] = *GCP(f32x2, OHG + ((size_t)((m / T) * 32 + h * 8 + (lane >> 3)) * T + (m % T)) * 16 + 2 * (lane & 7));
            gz[h] = *GCP(unsigned, Z + (size_t)m * ZLD + ZC_HG + h * 128 + 2 * lane);
        }
#pragma unroll
        for (int h = 0; h < 4; ++h) {
            const float ss = wave_sum(o[h].x * o[h].x + o[h].y * o[h].y);
            const float r = rsqrtf(ss * (1.f / 128.f) + EPS);
            const float y0 = o[h].x * r * ngv.x * siluf_(bflo(gz[h])), y1 = o[h].y * r * ngv.y * siluf_(bfhi(gz[h]));
            *GP(unsigned, MIX + (size_t)m * D + h * 128 + 2 * lane) = pk2(y0, y1);
        }
    }
}

__device__ __forceinline__ void phase_cmp_finish(const Frame& F, const float* PART) {
    const ArgsV A = args_view(F); const float* c1 = (const float*)(A.ws + WS_C1); const float* w2 = A.in[13]; float* KV = (float*)(A.ws + WS_KVCMP);
    LAS float* hw = (LAS float*)(F.lds + F.wave * 2048);
    const int gw = F.blk * NWAVES + F.wave, NGW = F.G * NWAVES, lane = F.lane;
    GASQ bf16* KVb = GP(bf16, KV);
    for (int R = gw; R < 2048; R += NGW) {
        f32x4 s0 = {0.f, 0.f, 0.f, 0.f}, s1 = {0.f, 0.f, 0.f, 0.f};
#pragma unroll
        for (int kp = 0; kp < 16; ++kp) { s0 += *GCP(f32x4, c1 + (kp * 2 + 0) * 256 + lane * 4); s1 += *GCP(f32x4, c1 + (kp * 2 + 1) * 256 + lane * 4); }
#pragma unroll
        for (int ks = 0; ks < 8; ++ks) { s0 += *GCP(f32x4, PART + ((size_t)ks * 2048 + R) * 256 + lane * 4); s1 += *GCP(f32x4, PART + ((size_t)(8 + ks) * 2048 + R) * 256 + lane * 4); }
        f32x4 h0, h1;
        h0.x = siluf_(s0.x); h0.y = siluf_(s0.y); h0.z = siluf_(s0.z); h0.w = siluf_(s0.w);
        h1.x = siluf_(s1.x); h1.y = siluf_(s1.y); h1.z = siluf_(s1.z); h1.w = siluf_(s1.w);
        *(LAS f32x4*)(hw + lane * 4) = h0; *(LAS f32x4*)(hw + 256 + lane * 4) = h1;
        LDS_FENCE();
        const GASQ float* wp0 = GCP(float, w2 + lane); const GASQ float* wp1 = GCP(float, w2 + (size_t)256 * 64 + lane);
        f32x4 a0 = {0.f, 0.f, 0.f, 0.f}, a1 = {0.f, 0.f, 0.f, 0.f};
#pragma unroll 4
        for (int j4 = 0; j4 < 64; ++j4) {
            const f32x4 h0v = *(const LAS f32x4*)(hw + 4 * j4), h1v = *(const LAS f32x4*)(hw + 256 + 4 * j4);
            const f32x4 w0v = {wp0[(4 * j4) * 64], wp0[(4 * j4 + 1) * 64], wp0[(4 * j4 + 2) * 64], wp0[(4 * j4 + 3) * 64]};
            const f32x4 w1v = {wp1[(4 * j4) * 64], wp1[(4 * j4 + 1) * 64], wp1[(4 * j4 + 2) * 64], wp1[(4 * j4 + 3) * 64]};
            a0 += h0v * w0v; a1 += h1v * w1v;
        }
        float o0 = (a0.x + a0.y) + (a0.z + a0.w), o1 = (a1.x + a1.y) + (a1.z + a1.w);
        if ((R & 127) == 127) { o0 = 0.f; o1 = 0.f; }
        KVb[(size_t)R * 64 + lane] = (bf16)f2bf(o0);
        KVb[(size_t)2048 * 64 + ((size_t)(R >> 7) * 64 + lane) * 128 + (R & 127)] = (bf16)f2bf(o1);
        LDS_FENCE();
    }
}

typedef float f32x16 __attribute__((ext_vector_type(16)));
#define MFMA32(a, b, c) __builtin_amdgcn_mfma_f32_32x32x16_bf16((a), (b), (c), 0, 0, 0)
__device__ __forceinline__ unsigned cvtpk(float lo, float hi) { typedef float f2_t __attribute__((ext_vector_type(2))); typedef __bf16 b2_t __attribute__((ext_vector_type(2)));
    f2_t v = {lo, hi}; b2_t r = __builtin_convertvector(v, b2_t); return __builtin_bit_cast(unsigned, r); }
constexpr int AT_KB = 0, AT_VB = 18432, AT_IMP = 36864, AT_SEL = 69632, AT_OUT = 69888  , AT_ROW = 144;

template <int MM>
__device__ __forceinline__ void attn_block_mfma(const LAS unsigned char* Kb, const LAS unsigned char* Vb, const bf16x8 (&qf)[4], f32x16 (&O)[2], float& m, float& l, int lane, bool selbit, int tl) {
    const int r32 = lane & 31, h = lane >> 5;
    f32x16 S[2];
#pragma unroll
    for (int kt = 0; kt < 2; ++kt) {
#pragma unroll
        for (int i = 0; i < 16; ++i) S[kt][i] = 0.f;
#pragma unroll
        for (int ks = 0; ks < 4; ++ks) { const bf16x8 kf = *(const LAS bf16x8*)(Kb + (kt * 32 + r32) * AT_ROW + (ks * 16 + h * 8) * 2); S[kt] = MFMA32(kf, qf[ks], S[kt]); }
        __builtin_amdgcn_sched_barrier(0);
    }
    float mx = -INFINITY;
#pragma unroll
    for (int kt = 0; kt < 2; ++kt)
#pragma unroll
        for (int i = 0; i < 16; ++i) { const int kl = kt * 32 + 8 * (i >> 2) + 4 * h + (i & 3);
            bool ok = selbit; if (MM == 1) ok = ok && (kl <= tl); if (MM == 2) ok = ok && (kl > tl);
            const float s = ok ? S[kt][i] : -INFINITY; S[kt][i] = s; mx = fmaxf(mx, s); }
    mx = fmaxf(mx, xor32f(mx, lane));
    const float mn = fmaxf(m, mx), alpha = ex2(m - mn); m = mn;
    float rs = 0.f;
#pragma unroll
    for (int kt = 0; kt < 2; ++kt)
#pragma unroll
        for (int i = 0; i < 16; ++i) { const float p = ex2(S[kt][i] - mn); S[kt][i] = p; rs += p; }
    l = l * alpha + rs;
#pragma unroll
    for (int i = 0; i < 16; ++i) { O[0][i] *= alpha; O[1][i] *= alpha; }
    bf16x8 pf[4];
#pragma unroll
    for (int s = 0; s < 4; ++s) { const int kt = s >> 1, bb = 8 * (s & 1);
        v4u w; w.x = cvtpk(S[kt][bb + 0], S[kt][bb + 1]); w.y = cvtpk(S[kt][bb + 2], S[kt][bb + 3]); w.z = cvtpk(S[kt][bb + 4], S[kt][bb + 5]); w.w = cvtpk(S[kt][bb + 6], S[kt][bb + 7]);
        pf[s] = __builtin_bit_cast(bf16x8, w); }
#pragma unroll
    for (int dt = 0; dt < 2; ++dt)
#pragma unroll
        for (int s = 0; s < 4; ++s) { const LAS unsigned char* vp = Vb + (dt * 32 + r32) * AT_ROW + (16 * s + 4 * h) * 2;
            const v2u lo = *(const LAS v2u*)vp, hi = *(const LAS v2u*)(vp + 16);
            const v4u w = {lo.x, lo.y, hi.x, hi.y};
            O[dt] = MFMA32(__builtin_bit_cast(bf16x8, w), pf[s], O[dt]); if (s & 1) __builtin_amdgcn_sched_barrier(0); }
}

template <bool WIN>
__device__ __forceinline__ void attn_branch(const Frame& F, const bf16* Kx, const bf16* VTx, size_t bg, int qb, int jlo, int jhi, const bf16x8 (&qf)[4], f32x16 (&O)[2], float& m, float& l, unsigned mysel, int tl) {
    const int tid = F.tid, lane = F.lane, row = tid >> 3, ch = tid & 7;
    const GASQ bf16* kg = (const GASQ bf16*)(Kx + bg * T * 64); const GASQ bf16* vg = (const GASQ bf16*)(VTx + bg * 64 * T);
    const unsigned ko = (unsigned)(row * 64 + ch * 8), vo = (unsigned)(row * T + ch * 8);
    const int so = row * AT_ROW + ch * 16;
    v4u kr = *(const GASQ v4u*)(kg + (jlo * 4096 + ko)), vr = *(const GASQ v4u*)(vg + (jlo * 64 + vo));
    *(LAS v4u*)(F.lds + AT_KB + so) = kr; *(LAS v4u*)(F.lds + AT_VB + so) = vr;
    __syncthreads();
    int buf = 0;
    for (int jb = jlo; jb <= jhi; ++jb) {
        const bool more = jb < jhi;
        if (more) { kr = *(const GASQ v4u*)(kg + ((jb + 1) * 4096 + ko)); vr = *(const GASQ v4u*)(vg + ((jb + 1) * 64 + vo)); }
        const LAS unsigned char* Kb = F.lds + AT_KB + buf * 9216; const LAS unsigned char* Vb = F.lds + AT_VB + buf * 9216;
        const bool selbit = WIN ? true : (((mysel >> jb) & 1u) != 0u);
        if (jb == qb) attn_block_mfma<1>(Kb, Vb, qf, O, m, l, lane, selbit, tl);
        else if (WIN && jb == qb - 8) attn_block_mfma<2>(Kb, Vb, qf, O, m, l, lane, selbit, tl);
        else attn_block_mfma<0>(Kb, Vb, qf, O, m, l, lane, selbit, tl);
        buf ^= 1;
        if (more) { *(LAS v4u*)(F.lds + AT_KB + buf * 9216 + so) = kr; *(LAS v4u*)(F.lds + AT_VB + buf * 9216 + so) = vr; }
        __syncthreads();
    }
}

template <class Bar>
__device__ __forceinline__ void phase_nsa_attn(const Frame& F, const Bar* pending) {
    const ArgsV A = args_view(F); unsigned char* ws = A.ws;
    const bf16* Z = (const bf16*)(ws + WS_Z); const bf16* QN = (const bf16*)(ws + WS_QN);
    const bf16* KS = (const bf16*)(ws + WS_KS); const bf16* VST = (const bf16*)(ws + WS_VS); const bf16* KW = (const bf16*)(ws + WS_KW); const bf16* VWT = (const bf16*)(ws + WS_VW);
    const bf16* KC = (const bf16*)(ws + WS_KVCMP); const bf16* VCT = KC + (size_t)2048 * 64; bf16* MIX = (bf16*)(ws + WS_H);
    const int r = F.wave >> 1, tb = F.wave & 1;
    LAS float* IMP = (LAS float*)(F.lds + AT_IMP);
    LAS unsigned* SEL = (LAS unsigned*)(F.lds + AT_SEL);
    bool waiting = (pending != nullptr);
#pragma unroll 1
    for (int item = F.blk; item < 256; item += F.G) {
        const size_t bg = (size_t)((item & 7) * 2 + (item >> 7)); const int b = (int)(bg >> 1), g = (int)(bg & 1), pi = (item >> 3) & 15;
#pragma unroll 1
        for (int u2 = 0; u2 < 2; ++u2) {
            Frame Fu = F; Fu.lane = opaque_lane(); Fu.tid = F.wave * 64 + Fu.lane;
            const int tid = Fu.tid, lane = Fu.lane, r32 = lane & 31, h = lane >> 5, tl = tb * 32 + r32;
            const int qb = u2 ? (31 - pi) : pi;
            const int t = qb * 64 + tl; const size_t mrow = (size_t)b * T + t;
            bf16x8 qf[4];
            { const GASQ bf16* qp = (const GASQ bf16*)(QN + ((size_t)(b * 8 + g * 4 + r) * T + t) * 64 + h * 8);
#pragma unroll
              for (int ks = 0; ks < 4; ++ks) qf[ks] = *(const GASQ bf16x8*)(qp + ks * 16); }
            const GASQ bf16* gz = (const GASQ bf16*)(Z + mrow * ZLD + ZC_NG + (g * 4 + r) * 3);
            const float g0 = sigmoidf_(bf2f(gz[0])), g1 = sigmoidf_(bf2f(gz[1])), g2 = sigmoidf_(bf2f(gz[2]));
            LAS float* OL = (LAS float*)(F.lds + AT_OUT + F.wave * 8192) + lane;
            {
                f32x16 O[2]; float m = -1e30f, l = 0.f;
#pragma unroll
                for (int i = 0; i < 16; ++i) { O[0][i] = 0.f; O[1][i] = 0.f; }
                __syncthreads();
                attn_branch<true>(Fu, KW, VWT, bg, qb, qb >= 8 ? qb - 8 : 0, qb, qf, O, m, l, 0xffffffffu, tl);
                l += xor32f(l, lane);
                const float sc = g2 / l;
#pragma unroll
                for (int i = 0; i < 16; ++i) { OL[i * 64] = sc * O[0][i]; OL[(16 + i) * 64] = sc * O[1][i]; }
            }
            if (waiting) { xcd_wait(*pending); waiting = false; }
            __syncthreads();
            { const int row = tid >> 3, ch = tid & 7;
              const GASQ bf16* kcb = (const GASQ bf16*)(KC + bg * 8192); const GASQ bf16* vcb = (const GASQ bf16*)(VCT + bg * 8192);
#pragma unroll
              for (int i = 0; i < 2; ++i) { const v4u v = *(const GASQ v4u*)(kcb + (unsigned)((row + 64 * i) * 64 + ch * 8)); *(LAS v4u*)(F.lds + AT_KB + (row + 64 * i) * AT_ROW + ch * 16) = v; }
#pragma unroll
              for (int i = 0; i < 2; ++i) { const v4u v = *(const GASQ v4u*)(vcb + (unsigned)(row * 128 + (ch + 8 * i) * 8)); *(LAS v4u*)(F.lds + AT_VB + row * 272 + (ch + 8 * i) * 16) = v; } }
            __syncthreads();
            {
                const int nvalid = (t >= 31) ? (((t - 31) >> 4) + 1) : 0;
                float mx = -1e30f;
#pragma unroll
                for (int kt = 0; kt < 4; ++kt) {
                    f32x16 S;
#pragma unroll
                    for (int i = 0; i < 16; ++i) S[i] = 0.f;
#pragma unroll
                    for (int ks = 0; ks < 4; ++ks) { const bf16x8 kf = *(const LAS bf16x8*)(F.lds + AT_KB + (kt * 32 + r32) * AT_ROW + (ks * 16 + h * 8) * 2); S = MFMA32(kf, qf[ks], S); }
#pragma unroll
                    for (int i = 0; i < 16; ++i) { const int n = kt * 32 + 8 * (i >> 2) + 4 * h + (i & 3); mx = fmaxf(mx, (n < nvalid) ? S[i] : -INFINITY); }
                    __builtin_amdgcn_sched_barrier(0);
                }
                mx = fmaxf(mx, xor32f(mx, lane));
                f32x16 Oc[2];
#pragma unroll
                for (int i = 0; i < 16; ++i) { Oc[0][i] = 0.f; Oc[1][i] = 0.f; }
                float impv[16]; float rs = 0.f, yprev = 0.f;
#pragma unroll
                for (int kt = 0; kt < 4; ++kt) {
                    f32x16 S;
#pragma unroll
                    for (int i = 0; i < 16; ++i) S[i] = 0.f;
#pragma unroll
                    for (int ks = 0; ks < 4; ++ks) { const bf16x8 kf = *(const LAS bf16x8*)(F.lds + AT_KB + (kt * 32 + r32) * AT_ROW + (ks * 16 + h * 8) * 2); S = MFMA32(kf, qf[ks], S); }
#pragma unroll
                    for (int i = 0; i < 16; ++i) { const int n = kt * 32 + 8 * (i >> 2) + 4 * h + (i & 3); const float p = (n < nvalid) ? ex2(S[i] - mx) : 0.f; S[i] = p; rs += p; }
#pragma unroll
                    for (int a = 0; a < 4; ++a) {
                        const float x = S[4 * a + 3], y = xor32f(x, lane);
                        impv[kt * 4 + a] = (S[4 * a] + S[4 * a + 1] + S[4 * a + 2] + 0.5f * x) + 0.5f * (h ? y : yprev);
                        yprev = y;
                    }
#pragma unroll
                    for (int s2 = 0; s2 < 2; ++s2) { const int s = kt * 2 + s2, bb = 8 * s2;
                        v4u w; w.x = cvtpk(S[bb + 0], S[bb + 1]); w.y = cvtpk(S[bb + 2], S[bb + 3]); w.z = cvtpk(S[bb + 4], S[bb + 5]); w.w = cvtpk(S[bb + 6], S[bb + 7]);
                        const bf16x8 pf = __builtin_bit_cast(bf16x8, w);
#pragma unroll
                        for (int dt = 0; dt < 2; ++dt) { const LAS unsigned char* vp = F.lds + AT_VB + (dt * 32 + r32) * 272 + (16 * s + 4 * h) * 2;
                            const v2u lo = *(const LAS v2u*)vp, hi = *(const LAS v2u*)(vp + 16);
                            const v4u wv = {lo.x, lo.y, hi.x, hi.y};
                            Oc[dt] = MFMA32(__builtin_bit_cast(bf16x8, wv), pf, Oc[dt]); } }
                    __builtin_amdgcn_sched_barrier(0);
                }
                rs += xor32f(rs, lane);
                const float inv = rs > 0.f ? 1.f / rs : 0.f;
#pragma unroll
                for (int q = 0; q < 16; ++q) IMP[(r * 64 + tl) * 32 + 8 * (q >> 2) + 2 * (q & 3) + h] = impv[q] * inv;
                const float gi = g0 * inv;
#pragma unroll
                for (int i = 0; i < 16; ++i) { OL[i * 64] += gi * Oc[0][i]; OL[(16 + i) * 64] += gi * Oc[1][i]; }
            }
            __syncthreads();
#pragma unroll 1
            for (int i = 0; i < 4; ++i) {
                const int idx = tid + 512 * i, tok = idx >> 5, j = idx & 31;
                const float v = ((IMP[(0 * 64 + tok) * 32 + j] + IMP[(1 * 64 + tok) * 32 + j]) + IMP[(2 * 64 + tok) * 32 + j]) + IMP[(3 * 64 + tok) * 32 + j];
                const bool causal = j <= qb, forced = (j == 0) || (j == qb) || (j == qb - 1);
                const float val = causal ? (forced ? INFINITY : v) : -1.f;
                int rank = 0;
#pragma unroll
                for (int i2 = 0; i2 < 32; ++i2) { const int vb = __builtin_bit_cast(int, val); const float vlo = __builtin_bit_cast(float, __builtin_amdgcn_readlane(vb, i2)), vhi = __builtin_bit_cast(float, __builtin_amdgcn_readlane(vb, 32 + i2));
                    const float vi = (lane < 32) ? vlo : vhi; rank += ((vi > val) || (vi == val && i2 < j)) ? 1 : 0; }
                const unsigned long long bal = __ballot((rank < 16) && causal);
                if (lane == 0) SEL[tok] = (unsigned)bal;
                if (lane == 32) SEL[tok] = (unsigned)(bal >> 32);
            }
            __syncthreads();
            const unsigned mysel = SEL[tl];
            {
                f32x16 O[2]; float m = -1e30f, l = 0.f;
#pragma unroll
                for (int i = 0; i < 16; ++i) { O[0][i] = 0.f; O[1][i] = 0.f; }
                attn_branch<false>(Fu, KS, VST, bg, qb, 0, qb, qf, O, m, l, mysel, tl);
                l += xor32f(l, lane);
                const float sc = g1 / l;
                GASQ bf16* op = (GASQ bf16*)(MIX + mrow * D + 512 + (g * 4 + r) * 64 + 4 * h);
#pragma unroll
                for (int dt = 0; dt < 2; ++dt)
#pragma unroll
                    for (int a = 0; a < 4; ++a) { float o[4];
#pragma unroll
                        for (int c = 0; c < 4; ++c) o[c] = OL[(dt * 16 + 4 * a + c) * 64] + sc * O[dt][4 * a + c];
                        v2u w; w.x = cvtpk(o[0], o[1]); w.y = cvtpk(o[2], o[3]); *(GASQ v2u*)(op + dt * 32 + 8 * a) = w; }
            }
        }
    }
    if (waiting) xcd_wait(*pending);
}

__device__ __forceinline__ void conv_seam_rows(const Frame& F, int pm) {
    const ArgsV A = args_view(F); GASQ bf16* ACT = GP(bf16, A.ws + WS_U); const GASQ bf16* HEAD = GCP(bf16, A.ws + WS_HALO); const GASQ bf16* TAIL = HEAD + (size_t)64 * 2 * FF2;
    const GASQ float* cw = GCP(float, A.in[17]); const GASQ float* cb = GCP(float, A.in[18]);
#pragma unroll
    for (int it6 = 0; it6 < 6; ++it6) {
        const int c = F.tid + it6 * NTHR; if (c >= FF) break;
        const GASQ bf16* h0 = HEAD + ((size_t)pm * 2) * FF2; const GASQ bf16* h1 = h0 + FF2;
        const float a0 = bf2f(h0[c]), a1 = bf2f(h1[c]), v0 = bf2f(h0[FF + c]), v1 = bf2f(h1[FF + c]);
        float ta0 = 0.f, ta1 = 0.f, tv0 = 0.f, tv1 = 0.f;
        if (pm & 7) { const GASQ bf16* t0 = TAIL + ((size_t)(pm - 1) * 2) * FF2; const GASQ bf16* t1 = t0 + FF2; ta0 = bf2f(t0[c]); ta1 = bf2f(t1[c]); tv0 = bf2f(t0[FF + c]); tv1 = bf2f(t1[FF + c]); }
        const float wa0 = cw[c], wa1 = cw[FF2 + c], wa2 = cw[2 * FF2 + c], ba = cb[c], wv0 = cw[FF + c], wv1 = cw[FF2 + FF + c], wv2 = cw[2 * FF2 + FF + c], bv = cb[FF + c];
        const float ya0 = ba + wa0 * ta0 + wa1 * ta1 + wa2 * a0, yv0 = bv + wv0 * tv0 + wv1 * tv1 + wv2 * v0;
        const float ya1 = ba + wa0 * ta1 + wa1 * a0 + wa2 * a1, yv1 = bv + wv0 * tv1 + wv1 * v0 + wv2 * v1;
        ACT[((size_t)pm * 256) * FF + c] = (bf16)f2bf(siluf_(ya0) * yv0);
        ACT[((size_t)pm * 256 + 1) * FF + c] = (bf16)f2bf(siluf_(ya1) * yv1);
    }
    asm volatile("s_waitcnt vmcnt(0)" ::: "memory");
    __syncthreads();
}

#define XB_TMO      128
#define XB_XCNT(j)  (256  + 64 * (j))
#define XB_XSUB(j)  (1280 + 64 * (j))
#define XB_XGEN(j)  (2304 + 64 * (j))
#define XB_TOP      3328
#define XB_TOPGEN   3392
#define XCD_BAR_WORDS 3456
#define XB_SPIN_CAP (1u << 18)

__device__ __forceinline__ unsigned xb_ld(unsigned* p)              { return __hip_atomic_load(p, __ATOMIC_RELAXED, __HIP_MEMORY_SCOPE_AGENT); }
__device__ __forceinline__ unsigned xb_add(unsigned* p, unsigned v) { return __hip_atomic_fetch_add(p, v, __ATOMIC_RELAXED, __HIP_MEMORY_SCOPE_AGENT); }
__device__ __forceinline__ unsigned xb_xcc_id() { return (unsigned)__builtin_amdgcn_s_getreg((3 << 11) | 20) & 0xFu; }
#define XB_SPIN(cond, bar) do { unsigned _sp = 0; while (cond) { __builtin_amdgcn_s_sleep(1); \
    if ((++_sp & 255u) == 0u) { if (xb_ld(&(bar)[XB_TMO])) break; if (_sp > XB_SPIN_CAP) { atomicAdd(&(bar)[XB_TMO], 1u); break; } } } } while (0)

struct XcdBarrier {
    unsigned* bar; unsigned x;
    volatile LAS unsigned* st;
};

__device__ __forceinline__ XcdBarrier xcd_barrier_post(unsigned* bar, volatile LAS unsigned* st) {
    XcdBarrier b; b.bar = bar; b.x = xb_xcc_id(); b.st = st;
    if (threadIdx.x == 0) (void)xb_add(&bar[XB_XCNT(b.x)], 1u);
    return b;
}
__device__ __forceinline__ void xcd_barrier_complete(unsigned* bar, unsigned x, unsigned& nloc, unsigned& nx) {
    const unsigned G = gridDim.x * gridDim.y * gridDim.z;
    unsigned sum, cnt, mine, sp = 0u;
    for (;;) {
        sum = 0u; cnt = 0u; mine = 0u;
#pragma unroll
        for (unsigned j = 0; j < 16; ++j) { const unsigned c = xb_ld(&bar[XB_XCNT(j)]); sum += c; cnt += (c > 0u) ? 1u : 0u; mine = (j == x) ? c : mine; }
        if (sum == G) break;
        __builtin_amdgcn_s_sleep(1);
        if ((++sp & 255u) == 0u) { if (xb_ld(&bar[XB_TMO])) break; if (sp > XB_SPIN_CAP) { atomicAdd(&bar[XB_TMO], 1u); break; } }
    }
    nloc = mine > 0u ? mine : 1u; nx = cnt > 0u ? cnt : 1u;
}

__device__ __forceinline__ void xcd_arrive(const XcdBarrier& b) {
    asm volatile("s_waitcnt vmcnt(0)" ::: "memory");
    __syncthreads();
    if (threadIdx.x == 0) {
        unsigned* bar = b.bar;
        __builtin_amdgcn_s_waitcnt(0);
        unsigned nloc = b.st[0], nx = b.st[1];
        if (nloc == 0u) { xcd_barrier_complete(bar, b.x, nloc, nx); b.st[0] = nloc; b.st[1] = nx; }
        const unsigned old = xb_add(&bar[XB_XSUB(b.x)], 1u);
        const unsigned gen = old / nloc;
        if (old + 1u == (gen + 1u) * nloc) {
            __builtin_amdgcn_fence(__ATOMIC_RELEASE, "agent");
            asm volatile("s_waitcnt vmcnt(0)" ::: "memory");
            const unsigned og = xb_add(&bar[XB_TOP], 1u);
            const unsigned tg = og / nx;
            if (og + 1u == (tg + 1u) * nx) xb_add(&bar[XB_TOPGEN], 1u);
        }
        b.st[2] = gen;
    }
}
__device__ __forceinline__ void xcd_wait(const XcdBarrier& b) {
    if (threadIdx.x == 0) {
        unsigned* bar = b.bar; const unsigned gen = b.st[2];
        XB_SPIN(xb_ld(&bar[XB_TOPGEN]) == gen, bar);
        __builtin_amdgcn_fence(__ATOMIC_ACQUIRE, "agent");
        asm volatile("s_waitcnt vmcnt(0)" ::: "memory");
    }
    __syncthreads();
}
__device__ __forceinline__ void xcd_barrier(const XcdBarrier& b) { xcd_arrive(b); xcd_wait(b); }


__global__ void __launch_bounds__(NTHR, 2) fwd_megakernel(Args args) {
    extern __shared__ __attribute__((aligned(16))) unsigned char lds_raw[];
    cg::grid_group grid = cg::this_grid();
    Frame F;
    F.lds = (LAS unsigned char*)lds_raw;
    F.wave = __builtin_amdgcn_readfirstlane((int)(threadIdx.x >> 6)); F.lane = opaque_lane(); F.tid = F.wave * 64 + F.lane;
    F.G = gridDim.x; F.blk = blockIdx.x;
    if (F.tid < 22) { const unsigned long long p = (F.tid < 20) ? (unsigned long long)args.in[F.tid < 20 ? F.tid : 0] : (F.tid == 20 ? (unsigned long long)args.out : (unsigned long long)args.ws);
        LAS unsigned* tab = (LAS unsigned*)(F.lds + ARGTAB); tab[2 * F.tid] = (unsigned)p; tab[2 * F.tid + 1] = (unsigned)(p >> 32); }
    if (F.tid == 0) { ((LAS unsigned*)(F.lds + ARGTAB + 192))[0] = 0u; ((LAS unsigned*)(F.lds + ARGTAB + 192))[1] = 0u; ((LAS unsigned*)(F.lds + ARGTAB + 192))[2] = 0u; }
    __syncthreads();
    const XcdBarrier xbar = xcd_barrier_post((unsigned*)(args.ws + WS_BAR), (volatile LAS unsigned*)(F.lds + ARGTAB + 192));
#define WSP ((unsigned char*)argp(F, 21))
#define OUTP ((float*)argp(F, 20))
#define PARTP (OUTP + (size_t)8 * 1024 * 1024)
    LAS unsigned char* glds = (LAS unsigned char*)lds_raw;
#define GRID_SYNC_CG() do { __builtin_amdgcn_fence(__ATOMIC_RELEASE, "agent"); asm volatile("s_waitcnt vmcnt(0) lgkmcnt(0)" ::: "memory"); grid.sync(); \
        __builtin_amdgcn_fence(__ATOMIC_ACQUIRE, "agent"); asm volatile("s_waitcnt vmcnt(0)" ::: "memory"); } while (0)
#define GRID_SYNC() xcd_barrier(xbar)

    phase0(phase_frame(F));
    xcd_arrive(xbar);
    if (gridDim.x == 0x7fffffffu) GRID_SYNC_CG();
    phase0b(phase_frame(F));
    xcd_wait(xbar);
    phase_norm_mod(phase_frame(F), argp(F, 0), argp(F, 5), 0, 1024, (bf16*)(WSP + WS_H));
    GRID_SYNC();
    {
        unsigned char* ws = WSP;
        pg8::Gemm g{(const bf16*)(ws + WS_H), (const bf16*)(ws + WS_WIN), 1024, 1024, 1024, 0};
        pg8::StaticOrder S; S.init(64, 14, F.G, F.blk, (size_t)256 * 1024 * 2, (size_t)256 * 1024 * 2);
        pg8::EpiBf16 E{(bf16*)(ws + WS_Z), ZLD, nullptr};
        pg8::gemm_phase<pg8::EpiBf16, pg8::StaticOrder, true>(glds, g, S, E, F.wave);
    }
    phase_c1(phase_frame(F), (64 * 14) % F.G);
    GRID_SYNC();
    phase_nsa_prep(phase_frame(F));
    phase_hg_prep(phase_frame(F), OUTP);
    GRID_SYNC();
    phase_hg_scan(phase_frame(F), OUTP);
    __syncthreads();
    {
        unsigned char* ws = WSP;
        pg8::Gemm g{(const bf16*)(ws + WS_KC), (const bf16*)(ws + WS_WC1), 256, 1024, 2048, 0};
        pg8::CmpOrder S{F.G, F.blk, (size_t)(WS_VC - WS_KC)};
        pg8::EpiPart E{PARTP};
        pg8::gemm_phase<pg8::EpiPart, pg8::CmpOrder, false>(glds, g, S, E, F.wave);
    }
    GRID_SYNC();
    phase_hg_norm(phase_frame(F), OUTP);
    phase_cmp_finish(phase_frame(F), PARTP);
    xcd_arrive(xbar);
    phase_nsa_attn(phase_frame(F), &xbar);
    GRID_SYNC();
    {
        unsigned char* ws = WSP;
        pg8::Gemm g{(const bf16*)(ws + WS_H), (const bf16*)(ws + WS_WOUT), 1024, 1024, 1024, 0};
        pg8::StaticOrder S; S.init(64, 4, F.G, F.blk, (size_t)256 * 1024 * 2, (size_t)256 * 1024 * 2);
        pg8::EpiRes E{argp(F, 0), OUTP, (const float*)(ws + WS_MOD) + 2048};
        pg8::gemm_phase<pg8::EpiRes, pg8::StaticOrder, true>(glds, g, S, E, F.wave);
    }
    if (F.G == 256) {
        pg8::StaticOrder S; S.init(64, 4, F.G, F.blk, 0, 0); pg8::Unit u0; (void)S.next(0, u0);
        unsigned* pc = (unsigned*)(WSP + WS_BAR) + 4096 + 64 * u0.pm;
        asm volatile("s_waitcnt vmcnt(0)" ::: "memory");
        __syncthreads();
        if (F.tid == 0) {
            __builtin_amdgcn_fence(__ATOMIC_RELEASE, "agent"); asm volatile("s_waitcnt vmcnt(0)" ::: "memory");
            (void)__hip_atomic_fetch_add(pc, 1u, __ATOMIC_RELAXED, __HIP_MEMORY_SCOPE_AGENT);
            unsigned spins = 0;
            while (__hip_atomic_load(pc, __ATOMIC_RELAXED, __HIP_MEMORY_SCOPE_AGENT) < 4u && ++spins < (1u << 22)) __builtin_amdgcn_s_sleep(1);
            __builtin_amdgcn_fence(__ATOMIC_ACQUIRE, "agent"); asm volatile("s_waitcnt vmcnt(0)" ::: "memory");
        }
        __syncthreads();
        const Frame Fp = phase_frame(F);
        norm_mod_rows(Fp, OUTP, argp(F, 15), 3072, 4096, (bf16*)(WSP + WS_H), u0.pm * 256 + u0.pn * 64 + Fp.wave, u0.pm * 256 + u0.pn * 64 + 64, NWAVES);
    } else {
        GRID_SYNC();
        phase_norm_mod(phase_frame(F), OUTP, argp(F, 15), 3072, 4096, (bf16*)(WSP + WS_H));
    }
    GRID_SYNC();
    {
        unsigned char* ws = WSP;
        pg8::Gemm g{(const bf16*)(ws + WS_H), (const bf16*)(ws + WS_WUP), 1024, 1024, 1024, 0};
        pg8::StaticOrder S; S.init(64, 22, F.G, F.blk, (size_t)256 * 1024 * 2, (size_t)256 * 1024 * 2);
        pg8::EpiConv E{(bf16*)(ws + WS_U), (bf16*)(ws + WS_HALO), (bf16*)(ws + WS_HALO) + (size_t)64 * 2 * FF2, argp(F, 17), argp(F, 18), (LAS float*)(glds + 131072)};
        pg8::gemm_phase<pg8::EpiConv, pg8::StaticOrder, true>(glds, g, S, E, F.wave);
    }
    GRID_SYNC();
    {
        unsigned char* ws = WSP;
        pg8::Gemm g{(const bf16*)(ws + WS_U), (const bf16*)(ws + WS_WDN), FF, FF, FF, 0};
        pg8::StaticOrder S; S.init(64, 4, F.G, F.blk, (size_t)256 * FF * 2, (size_t)256 * FF * 2);
        { pg8::Unit u0; for (int i = 0; S.next(i, u0); ++i) conv_seam_rows(phase_frame(F), u0.pm); }
        pg8::EpiRes E{OUTP, OUTP, (const float*)(ws + WS_MOD) + 5120};
        pg8::gemm_phase<pg8::EpiRes, pg8::StaticOrder, true>(glds, g, S, E, F.wave);
    }
}

extern "C" void kernel_launch(void* const* d_in, const int* in_sizes, int n_in, void* d_out, int out_size, void* d_ws, size_t ws_size, hipStream_t stream) {
    static int grid = 0;
    if (grid == 0) {
        if (n_in != 20 || out_size != M * D || ws_size < WS_END) { fprintf(stderr, "kernel_launch: unexpected shapes (n_in %d out %d ws %zu)\n", n_in, out_size, ws_size); grid = -1; return; }
        int dev = 0, cus = 0, per_cu = 0;
        (void)hipGetDevice(&dev);
        (void)hipDeviceGetAttribute(&cus, hipDeviceAttributeMultiprocessorCount, dev);
        if (hipFuncSetAttribute((const void*)fwd_megakernel, hipFuncAttributeMaxDynamicSharedMemorySize, LDS_BYTES) != hipSuccess) { fprintf(stderr, "kernel_launch: hipFuncSetAttribute failed\n"); }
        if (hipOccupancyMaxActiveBlocksPerMultiprocessor(&per_cu, (const void*)fwd_megakernel, NTHR, LDS_BYTES) != hipSuccess || per_cu < 1) { fprintf(stderr, "kernel_launch: occupancy query says %d\n", per_cu); per_cu = 1; }
        (void)hipGetLastError();
        grid = cus * 1;
        if (grid > 256) grid = 256;
    }
    if (grid < 0) return;
    (void)hipMemsetAsync((char*)d_ws + WS_BAR, 0, 32768, stream);
    Args a{};
    for (int i = 0; i < 20; ++i) a.in[i] = (const float*)d_in[i];
    a.out = (float*)d_out; a.ws = (unsigned char*)d_ws;
    void* kargs[] = {&a};
    hipError_t e = hipLaunchCooperativeKernel((const void*)fwd_megakernel, dim3(grid), dim3(NTHR), kargs, LDS_BYTES, stream);
    if (e != hipSuccess) fprintf(stderr, "cooperative launch failed: %s (grid %d)\n", hipGetErrorString(e), grid);
}
```
